# Optimizing an MI355X kernel written in HIP

```python
import math
import jax, jax.numpy as jnp
from jax import lax
import numpy as np

D_MODEL = 1024
BATCH = 4
SEQ = 8192
DEPTH = 2

GRID_W = 64
CTX_LEN = 256
MLA_HEADS = 8
QK_NOPE = 64
QK_ROPE = 32
V_DIM = 64
Q_LORA = 256
KV_LORA = 128
ROPE_AXIS = QK_ROPE // 2
ROPE_BASE = 10000.0
Q_BLOCK = 128
ATTN_SCALE = (QK_NOPE + QK_ROPE) ** -0.5
POOL_WINDOWS = (2, 4, 8, 16)
POOL_GROUP = 64
POOL_WIDTH = POOL_GROUP * len(POOL_WINDOWS)
CONV_WIDTH = 256
CONV_K = 31
MLA_WIDTH = MLA_HEADS * V_DIM
MIX_WIDTH = MLA_WIDTH + POOL_WIDTH + CONV_WIDTH
OFF_KV = Q_LORA
OFF_KR = OFF_KV + KV_LORA
OFF_POOL = OFF_KR + QK_ROPE
OFF_CONV = OFF_POOL + POOL_WIDTH
IN_COLS = OFF_CONV + 2 * CONV_WIDTH
N_EXPERTS = 32
TOP_K = 4
N_GROUPS = 4
TOPK_GROUPS = 2
D_EXPERT = 256
D_SHARED = 256
ROUTED_SCALE = 2.5
ALPHA = (2 * DEPTH) ** 0.25
BETA = (8 * DEPTH) ** -0.25
EPS = 1e-6

kernel_name = 'hybrid_mla_pool_conv_moe_dit'


def _layernorm(x, g=None, b=None):
    x32 = x.astype(jnp.float32)
    mu = jnp.mean(x32, axis=-1, keepdims=True)
    var = jnp.mean(jnp.square(x32 - mu), axis=-1, keepdims=True)
    y = (x32 - mu) * lax.rsqrt(var + EPS)
    if g is not None:
        y = y * g + b
    return y.astype(x.dtype)


def _rmsnorm(x, g):
    x32 = x.astype(jnp.float32)
    y = x32 * lax.rsqrt(jnp.mean(jnp.square(x32), axis=-1, keepdims=True) + EPS)
    return (y * g).astype(x.dtype)


def _modulate(z, shift, scale):
    return _layernorm(z) * (1.0 + scale) + shift


def _post_norm(z, y, gate, g, b):
    return _layernorm(ALPHA * z + gate * y, g, b)


def _axial_tables(row, col):
    inv = ROPE_BASE ** (-jnp.arange(0, ROPE_AXIS, 2, dtype=jnp.float32) / ROPE_AXIS)
    ang_r = row.astype(jnp.float32)[:, None] * inv
    ang_c = col.astype(jnp.float32)[:, None] * inv
    return (jnp.cos(ang_r), jnp.sin(ang_r), jnp.cos(ang_c), jnp.sin(ang_c))


def _rotate(x, cos, sin):
    x1, x2 = jnp.split(x, 2, axis=-1)
    return jnp.concatenate([x1 * cos - x2 * sin, x2 * cos + x1 * sin], axis=-1)


def _rope_2d(x, tabs):
    cr, sr, cc, sc = (t.astype(x.dtype) for t in tabs)
    return jnp.concatenate([_rotate(x[..., :ROPE_AXIS], cr, sr),
                            _rotate(x[..., ROPE_AXIS:], cc, sc)], axis=-1)


def _mla_q(q_c, q_norm_g, w_uq):
    b, n, _ = q_c.shape
    q = (_rmsnorm(q_c, q_norm_g) @ w_uq).reshape(b, n, MLA_HEADS, QK_NOPE + QK_ROPE)
    return q[..., :QK_NOPE], q[..., QK_NOPE:]


def _mla_kv(kv_c, k_rope, kv_norm_g, w_ukv):
    b, n, _ = kv_c.shape
    kv = (_rmsnorm(kv_c, kv_norm_g) @ w_ukv).reshape(b, n, MLA_HEADS, QK_NOPE + V_DIM)
    return kv[..., :QK_NOPE], kv[..., QK_NOPE:], k_rope


def _latent_attention(qn, qr_rot, qr_raw, kn_all, v_all, kr_ctx, kr_lat):
    b, n, h, _ = qn.shape
    nb = n // Q_BLOCK

    def blocks(t):
        return jnp.swapaxes(t.reshape(b, nb, Q_BLOCK, h, t.shape[-1]), 0, 1)

    def one_block(args):
        qn_b, qrr_b, qr0_b = args
        s_nope = jnp.einsum('bqhd,bkhd->bhqk', qn_b, kn_all)
        s_rope = jnp.concatenate([
            jnp.einsum('bqhr,bkr->bhqk', qr0_b, kr_ctx),
            jnp.einsum('bqhr,bkr->bhqk', qrr_b, kr_lat)],
            axis=-1)
        p = jax.nn.softmax((s_nope + s_rope).astype(jnp.float32) * ATTN_SCALE, axis=-1)
        return jnp.einsum('bhqk,bkhd->bqhd', p.astype(v_all.dtype), v_all)

    o = lax.map(one_block, (blocks(qn), blocks(qr_rot), blocks(qr_raw)))
    return jnp.swapaxes(o, 0, 1).reshape(b, n, h * V_DIM)


def _context_attention(qn, qr, kn, kr, v):
    b, n = qn.shape[:2]
    s = jnp.einsum('bqhd,bkhd->bhqk', qn, kn) + jnp.einsum('bqhr,bkr->bhqk', qr, kr)
    p = jax.nn.softmax(s.astype(jnp.float32) * ATTN_SCALE, axis=-1)
    return jnp.einsum('bhqk,bkhd->bqhd', p.astype(v.dtype), v).reshape(b, n, MLA_WIDTH)


def _multiscale_pool(u, pool_w, pool_scale):
    b, n, ch = u.shape
    u32 = u.astype(jnp.float32)
    cs = jnp.concatenate([jnp.zeros((b, 1, ch), jnp.float32), jnp.cumsum(u32, axis=1)], axis=1)
    t = jnp.arange(n)
    outs = []
    for gi, w in enumerate(POOL_WINDOWS):
        lo = w // 2
        hi = w - 1 - lo
        start = jnp.clip(t - lo, 0, n)
        end = jnp.clip(t + hi + 1, 0, n)
        seg = cs[..., gi * POOL_GROUP:(gi + 1) * POOL_GROUP]
        mean = (jnp.take(seg, end, axis=1) - jnp.take(seg, start, axis=1)) / \
            (end - start).astype(jnp.float32)[None, :, None]
        diff = (mean - u32[..., gi * POOL_GROUP:(gi + 1) * POOL_GROUP]).astype(u.dtype)
        outs.append(diff @ pool_w[gi])
    return jnp.concatenate(outs, axis=-1) * pool_scale


def _conformer_conv(u2, conv_dw, conv_b, conv_ln_g, conv_ln_b, conv_pw):
    a, g = jnp.split(u2, 2, axis=-1)
    u = a * jax.nn.sigmoid(g)
    y = lax.conv_general_dilated(
        u, conv_dw[:, None, :], window_strides=(1,),
        padding=[(CONV_K // 2, CONV_K // 2)],
        dimension_numbers=('NWC', 'WIO', 'NWC'),
        feature_group_count=CONV_WIDTH) + conv_b
    y = jax.nn.silu(_layernorm(y, conv_ln_g, conv_ln_b))
    return y @ conv_pw


def _mix_out(att, p, pool_w, pool_scale, conv_dw, conv_b, conv_ln_g, conv_ln_b, conv_pw, w_out):
    pool = _multiscale_pool(p[..., OFF_POOL:OFF_CONV], pool_w, pool_scale)
    conv = _conformer_conv(p[..., OFF_CONV:], conv_dw, conv_b, conv_ln_g, conv_ln_b, conv_pw)
    return jnp.concatenate([att, pool, conv], axis=-1) @ w_out


def _swiglu(t, wg, wu, wd):
    return (jax.nn.silu(t @ wg) * (t @ wu)) @ wd


def _moe(h, router_w, router_bias, exp_wg, exp_wu, exp_wd, sh_wg, sh_wu, sh_wd):
    shape = h.shape
    t = h.reshape(-1, shape[-1])
    scores = jax.nn.sigmoid((t @ router_w).astype(jnp.float32))
    sel = scores + router_bias
    grp = sel.reshape(-1, N_GROUPS, N_EXPERTS // N_GROUPS)
    gscore = jnp.sum(lax.top_k(grp, 2)[0], axis=-1)
    _, gidx = lax.top_k(gscore, TOPK_GROUPS)
    gmask = jnp.sum(jax.nn.one_hot(gidx, N_GROUPS), axis=1) > 0
    emask = jnp.repeat(gmask, N_EXPERTS // N_GROUPS, axis=-1)
    _, eidx = lax.top_k(jnp.where(emask, sel, -jnp.inf), TOP_K)
    w = jnp.take_along_axis(scores, eidx, axis=-1)
    w = w / jnp.sum(w, axis=-1, keepdims=True) * ROUTED_SCALE
    gates = jnp.einsum('tk,tke->te', w, jax.nn.one_hot(eidx, N_EXPERTS)).astype(t.dtype)

    def add_expert(acc, xs):
        g_e, wg_e, wu_e, wd_e = xs
        return acc + g_e[:, None] * _swiglu(t, wg_e, wu_e, wd_e), None

    out, _ = lax.scan(add_expert, _swiglu(t, sh_wg, sh_wu, sh_wd),
                      (gates.T, exp_wg, exp_wu, exp_wd))
    return out.reshape(shape)


def setup_inputs(seed: int = 0) -> dict:
    key = jax.random.key(seed)
    ks = iter(jax.random.split(key, 40))
    L = DEPTH

    def nrm(shape, scale=1.0):
        return jax.random.normal(next(ks), shape, jnp.float32) * scale

    def gain(shape):
        return 1.0 + nrm(shape, 0.02)

    return {
        'x': nrm((BATCH, SEQ, D_MODEL)),
        'c': nrm((BATCH, D_MODEL)),
        'ctx': nrm((BATCH, CTX_LEN, D_MODEL)),
        'c_ctx': nrm((D_MODEL,)),
        'ada_w': nrm((L, D_MODEL, 6 * D_MODEL), 0.5 * D_MODEL ** -0.5),
        'ada_b': nrm((L, 6 * D_MODEL), 0.02),
        'w_in': nrm((L, D_MODEL, IN_COLS), D_MODEL ** -0.5),
        'q_norm_g': gain((L, Q_LORA)),
        'w_uq': nrm((L, Q_LORA, MLA_HEADS * (QK_NOPE + QK_ROPE)), Q_LORA ** -0.5),
        'kv_norm_g': gain((L, KV_LORA)),
        'w_ukv': nrm((L, KV_LORA, MLA_HEADS * (QK_NOPE + V_DIM)), KV_LORA ** -0.5),
        'pool_w': nrm((L, len(POOL_WINDOWS), POOL_GROUP, POOL_GROUP), POOL_GROUP ** -0.5),
        'pool_scale': gain((L, POOL_WIDTH)),
        'conv_dw': nrm((L, CONV_K, CONV_WIDTH), CONV_K ** -0.5),
        'conv_b': nrm((L, CONV_WIDTH), 0.02),
        'conv_ln_g': gain((L, CONV_WIDTH)),
        'conv_ln_b': nrm((L, CONV_WIDTH), 0.02),
        'conv_pw': nrm((L, CONV_WIDTH, CONV_WIDTH), CONV_WIDTH ** -0.5),
        'w_out': nrm((L, MIX_WIDTH, D_MODEL), BETA * MIX_WIDTH ** -0.5),
        'ln1_g': gain((L, D_MODEL)),
        'ln1_b': nrm((L, D_MODEL), 0.02),
        'router_w': nrm((L, D_MODEL, N_EXPERTS), D_MODEL ** -0.5),
        'router_bias': nrm((L, N_EXPERTS), 0.01),
        'exp_wg': nrm((L, N_EXPERTS, D_MODEL, D_EXPERT), D_MODEL ** -0.5),
        'exp_wu': nrm((L, N_EXPERTS, D_MODEL, D_EXPERT), D_MODEL ** -0.5),
        'exp_wd': nrm((L, N_EXPERTS, D_EXPERT, D_MODEL), BETA * D_EXPERT ** -0.5),
        'sh_wg': nrm((L, D_MODEL, D_SHARED), D_MODEL ** -0.5),
        'sh_wu': nrm((L, D_MODEL, D_SHARED), D_MODEL ** -0.5),
        'sh_wd': nrm((L, D_SHARED, D_MODEL), BETA * D_SHARED ** -0.5),
        'ln2_g': gain((L, D_MODEL)),
        'ln2_b': nrm((L, D_MODEL), 0.02),
    }


def reference(x, c, ctx, c_ctx, ada_w, ada_b, w_in, q_norm_g, w_uq, kv_norm_g, w_ukv,
              pool_w, pool_scale, conv_dw, conv_b, conv_ln_g, conv_ln_b, conv_pw, w_out,
              ln1_g, ln1_b, router_w, router_bias, exp_wg, exp_wu, exp_wd,
              sh_wg, sh_wu, sh_wd, ln2_g, ln2_b):
    n_lat = x.shape[1]
    n_rows = n_lat // GRID_W
    row = jnp.broadcast_to(jnp.arange(n_rows)[:, None], (n_rows, GRID_W)).reshape(-1)
    col = jnp.broadcast_to(jnp.arange(GRID_W)[None, :], (n_rows, GRID_W)).reshape(-1)
    tabs_k = _axial_tables(row, col)
    tabs_q = tuple(tb[:, None, :] for tb in tabs_k)

    zl, zc = x, ctx
    for l in range(DEPTH):
        last = l == DEPTH - 1
        mod_l = jnp.split((jax.nn.silu(c) @ ada_w[l] + ada_b[l])[:, None, :], 6, axis=-1)
        mod_c = jnp.split(jax.nn.silu(c_ctx) @ ada_w[l] + ada_b[l], 6, axis=-1)
        mix_p = (pool_w[l], pool_scale[l], conv_dw[l], conv_b[l], conv_ln_g[l],
                 conv_ln_b[l], conv_pw[l], w_out[l])
        moe_p = (router_w[l], router_bias[l], exp_wg[l], exp_wu[l], exp_wd[l],
                 sh_wg[l], sh_wu[l], sh_wd[l])

        pl = _modulate(zl, mod_l[0], mod_l[1]) @ w_in[l]
        hc = _modulate(zc, mod_c[0], mod_c[1])
        if last:
            pc_kv = hc @ w_in[l][:, OFF_KV:OFF_POOL]
        else:
            pc = hc @ w_in[l]
            pc_kv = pc[..., OFF_KV:OFF_POOL]
        kn_c, v_c, kr_c = _mla_kv(pc_kv[..., :KV_LORA], pc_kv[..., KV_LORA:],
                                  kv_norm_g[l], w_ukv[l])
        kn_l, v_l, kr_l = _mla_kv(pl[..., OFF_KV:OFF_KR], pl[..., OFF_KR:OFF_POOL],
                                  kv_norm_g[l], w_ukv[l])
        qn_l, qr_l = _mla_q(pl[..., :OFF_KV], q_norm_g[l], w_uq[l])
        att_l = _latent_attention(qn_l, _rope_2d(qr_l, tabs_q), qr_l,
                                  jnp.concatenate([kn_c, kn_l], axis=1),
                                  jnp.concatenate([v_c, v_l], axis=1),
                                  kr_c, _rope_2d(kr_l, tabs_k))
        zl = _post_norm(zl, _mix_out(att_l, pl, *mix_p), mod_l[2], ln1_g[l], ln1_b[l])
        zl = _post_norm(zl, _moe(_modulate(zl, mod_l[3], mod_l[4]), *moe_p),
                        mod_l[5], ln2_g[l], ln2_b[l])

        if not last:
            qn_c, qr_c = _mla_q(pc[..., :OFF_KV], q_norm_g[l], w_uq[l])
            att_c = _context_attention(qn_c, qr_c, kn_c, kr_c, v_c)
            zc = _post_norm(zc, _mix_out(att_c, pc, *mix_p), mod_c[2], ln1_g[l], ln1_b[l])
            zc = _post_norm(zc, _moe(_modulate(zc, mod_c[3], mod_c[4]), *moe_p),
                            mod_c[5], ln2_g[l], ln2_b[l])
    return zl
```

```cpp
#include <hip/hip_runtime.h>
#include <cstdio>
#include <cstdint>

#define LAS __attribute__((address_space(3)))
#define GAS __attribute__((address_space(1)))
typedef unsigned short bf16_t;
typedef short bf16x8 __attribute__((ext_vector_type(8)));
typedef float f32x4 __attribute__((ext_vector_type(4)));
typedef float f32x2 __attribute__((ext_vector_type(2)));
typedef unsigned u32x4 __attribute__((ext_vector_type(4)));
typedef unsigned u32x2 __attribute__((ext_vector_type(2)));

#ifndef DRYVAR
#define DRYVAR 0u
#endif
#ifndef N_PHASE_LAUNCH
#define N_PHASE_LAUNCH 0
#endif

constexpr int DM = 1024, NBATCH = 4, SEQ = 8192, CTXL = 256, DEPTH = 2;
constexpr int TL = NBATCH * SEQ, TC = NBATCH * CTXL, TT = TL + TC;
constexpr int KVS = SEQ + CTXL;
constexpr int NH = 8, QK_NOPE = 64, QK_ROPE = 32, VD = 64, QLORA = 256, KVLORA = 128;
constexpr int INC = 1184, PW = 1280;
constexpr int OFF_KV = 256, OFF_KR = 384, OFF_POOL = 416, OFF_CONV = 672;
constexpr int NE = 32, DEXP = 256, CONVK = 31;
constexpr float ALPHA = 1.4142135623730951f, EPS = 1e-6f, ROUTED_SCALE = 2.5f;
constexpr float ATTN_SCALE = 0.10206207261596575f;
constexpr int NWAVES = 8, NTHR = 512;

constexpr size_t MiB = 1u << 20;
constexpr size_t WS_CTL = 0, CTL_ZERO_BYTES = 1 * MiB;
constexpr int CW_BAR = 4096;
constexpr int CW_GCNT = 16384;
constexpr size_t WS_W = 1 * MiB;
constexpr size_t W_WIN = 0, W_WQ = W_WIN + (size_t)PW * DM * 2, W_WKV = W_WQ + (size_t)768 * 256 * 2, W_WO = W_WKV + (size_t)1024 * 256 * 2,
                 W_WGU = W_WO + (size_t)DM * DM * 2, W_WD = W_WGU + (size_t)33 * 512 * DM * 2, W_END = W_WD + (size_t)33 * DM * 256 * 2;
static_assert(W_END <= 56 * MiB, "weights region");
constexpr size_t WS_MISC = 61 * MiB;
constexpr size_t M_MOD = 0, M_ROPE = M_MOD + (size_t)DEPTH * 5 * 6144 * 4, M_RS = M_ROPE + 128 * 8 * 2 * 4, M_SELE = M_RS + (size_t)TT * 32,
                 M_SELR = M_SELE + (size_t)TT * 16, M_LIST = M_SELR + (size_t)TT * 16, M_LISTW = M_LIST + (size_t)NE * TT * 4, M_END = M_LISTW + (size_t)NE * TT * 4;
static_assert(M_END <= 12 * MiB, "misc region");
constexpr size_t WS_H = 73 * MiB;
constexpr size_t WS_X = 139 * MiB;
constexpr size_t WS_P = WS_X, WS_Q = 222 * MiB, WS_QR = 272 * MiB, WS_KV = 289 * MiB, WS_KR = 355 * MiB, WS_MIX = 358 * MiB, WS_Y1 = WS_X  ;
constexpr size_t WS_YS8 = 366 * MiB;
constexpr size_t WS_Z = 424 * MiB;
constexpr size_t WS_HB = WS_X, WS_YB = 226 * MiB, WS_END = 512 * MiB;
static_assert(WS_P + (size_t)TT * PW * 2 <= WS_Q && WS_Q + (size_t)TT * 768 * 2 <= WS_QR && WS_QR + (size_t)TT * 256 * 2 <= WS_KV && WS_KV + (size_t)TT * 2048 <= WS_KR &&
              WS_KR + (size_t)TT * 64 <= WS_MIX && WS_MIX + (size_t)TT * 2048 <= WS_Z && WS_Y1 + (size_t)TT * 2048 <= WS_Q && WS_Z + (size_t)TT * 2048 <= WS_END, "attention-time map");
static_assert(WS_HB + (size_t)(4 * TT + 32 * 255 + TT) * 512 <= WS_YB && WS_YB + (size_t)(4 * TT + 32 * 255) * 1024 <= WS_YS8 && WS_YS8 + (size_t)TT * 1024 <= WS_Z, "moe-time map");
constexpr int LDS_BYTES = 163840;
constexpr int LDS_XB = LDS_BYTES - 64;

__device__ __forceinline__ float bf2f(unsigned b) { return __uint_as_float(b << 16); }
__device__ __forceinline__ unsigned f2bf(float f) { unsigned u = __float_as_uint(f); return (u + 0x7fffu + ((u >> 16) & 1u)) >> 16; }
__device__ __forceinline__ unsigned pk2(float lo, float hi) { return f2bf(lo) | (f2bf(hi) << 16); }
template <int CTRL> __device__ __forceinline__ float dpp_f(float v) { return __builtin_bit_cast(float, __builtin_amdgcn_update_dpp(0, __builtin_bit_cast(int, v), CTRL, 0xF, 0xF, false)); }
#define DPP_X1 0xB1
#define DPP_X2 0x4E
#define DPP_HM 0x141
#define DPP_RM 0x140
__device__ __forceinline__ float swap16_f(float v, float& other) { auto r = __builtin_amdgcn_permlane16_swap(__float_as_uint(v), __float_as_uint(v), false, false); other = __uint_as_float(r[1]); return __uint_as_float(r[0]); }
__device__ __forceinline__ float sum16(float v) { v += dpp_f<DPP_X1>(v); v += dpp_f<DPP_X2>(v); v += dpp_f<DPP_HM>(v); v += dpp_f<DPP_RM>(v); return v; }
__device__ __forceinline__ float sum32(float v) { v = sum16(v); float o; const float a = swap16_f(v, o); return a + o; }
__device__ __forceinline__ float wave_sum(float v) {
    v = sum32(v);
    auto r = __builtin_amdgcn_permlane32_swap(__float_as_uint(v), __float_as_uint(v), false, false);
    return __uint_as_float(r[0]) + __uint_as_float(r[1]);
}
__device__ __forceinline__ float max8(float v) { v = fmaxf(v, dpp_f<DPP_X1>(v)); v = fmaxf(v, dpp_f<DPP_X2>(v)); v = fmaxf(v, dpp_f<DPP_HM>(v)); return v; }
__device__ __forceinline__ float max32(float v) { v = max8(v); v = fmaxf(v, dpp_f<DPP_RM>(v)); float o; const float a = swap16_f(v, o); return fmaxf(a, o); }
__device__ __forceinline__ float sigm(float x) { return 1.f / (1.f + __expf(-x)); }
__device__ __forceinline__ float silu(float x) { return x / (1.f + __expf(-x)); }
__device__ __forceinline__ int kvrow_of(int r) { return r < TL ? (r >> 13) * KVS + CTXL + (r & (SEQ - 1)) : ((r - TL) >> 8) * KVS + ((r - TL) & (CTXL - 1)); }
__device__ __forceinline__ int batch_of(int r) { return r < TL ? (r >> 13) : 4; }
#define LDS_WAIT() asm volatile("s_waitcnt lgkmcnt(0)" ::: "memory")
#define VM_WAIT() asm volatile("s_waitcnt vmcnt(0)" ::: "memory")

#define XB_TMO      128
#define XB_XCNT(j)  (256  + 64 * (j))
#define XB_XSUB(j)  (1280 + 64 * (j))
#define XB_XGEN(j)  (2304 + 64 * (j))
#define XB_TOP      3328
#define XB_TOPGEN   3392
#define XCD_BAR_WORDS 3456
#define XB_SPIN_CAP (1u << 22)
__device__ __forceinline__ unsigned xb_ld(unsigned* p)              { return __hip_atomic_load(p, __ATOMIC_RELAXED, __HIP_MEMORY_SCOPE_AGENT); }
__device__ __forceinline__ unsigned xb_add(unsigned* p, unsigned v) { return __hip_atomic_fetch_add(p, v, __ATOMIC_RELAXED, __HIP_MEMORY_SCOPE_AGENT); }
__device__ __forceinline__ unsigned xb_xcc_id() { return (unsigned)__builtin_amdgcn_s_getreg((3 << 11) | 20) & 0xFu; }
#define XB_SPIN(cond, bar) do { unsigned _sp = 0; while (cond) { __builtin_amdgcn_s_sleep(1); \
    if ((++_sp & 255u) == 0u) { if (xb_ld(&(bar)[XB_TMO])) break; if (_sp > XB_SPIN_CAP) { atomicAdd(&(bar)[XB_TMO], 1u); break; } } } } while (0)
struct XcdBarrier { unsigned* bar; unsigned x; volatile LAS unsigned* st; };
__device__ __forceinline__ XcdBarrier xcd_barrier_post(unsigned* bar, volatile LAS unsigned* st) {
    XcdBarrier b; b.bar = bar; b.x = xb_xcc_id(); b.st = st;
    if (threadIdx.x == 0) (void)xb_add(&bar[XB_XCNT(b.x)], 1u);
    return b;
}
__device__ __forceinline__ void xcd_barrier_complete(unsigned* bar, unsigned x, unsigned& nloc, unsigned& nx) {
    const unsigned G = gridDim.x * gridDim.y * gridDim.z;
    unsigned sum, cnt, mine, sp = 0u;
    for (;;) {
        sum = 0u; cnt = 0u; mine = 0u;
#pragma unroll
        for (unsigned j = 0; j < 16; ++j) { const unsigned c = xb_ld(&bar[XB_XCNT(j)]); sum += c; cnt += (c > 0u) ? 1u : 0u; mine = (j == x) ? c : mine; }
        if (sum == G) break;
        __builtin_amdgcn_s_sleep(1);
        if ((++sp & 255u) == 0u) { if (xb_ld(&bar[XB_TMO])) break; if (sp > XB_SPIN_CAP) { atomicAdd(&bar[XB_TMO], 1u); break; } }
    }
    nloc = mine > 0u ? mine : 1u; nx = cnt > 0u ? cnt : 1u;
}
__device__ __forceinline__ void xcd_barrier(const XcdBarrier& b) {
    asm volatile("s_waitcnt vmcnt(0)" ::: "memory");
    __syncthreads();
    if (threadIdx.x == 0) {
        unsigned* bar = b.bar;
        __builtin_amdgcn_s_waitcnt(0);
        unsigned nloc = b.st[0], nx = b.st[1];
        if (nloc == 0u) { xcd_barrier_complete(bar, b.x, nloc, nx); b.st[0] = nloc; b.st[1] = nx; }
        const unsigned old = xb_add(&bar[XB_XSUB(b.x)], 1u);
        const unsigned gen = old / nloc;
        if (old + 1u == (gen + 1u) * nloc) {
            __builtin_amdgcn_fence(__ATOMIC_RELEASE, "agent");
            asm volatile("s_waitcnt vmcnt(0)" ::: "memory");
            const unsigned og = xb_add(&bar[XB_TOP], 1u);
            const unsigned tg = og / nx;
            if (og + 1u == (tg + 1u) * nx) xb_add(&bar[XB_TOPGEN], 1u);
            else XB_SPIN(xb_ld(&bar[XB_TOPGEN]) == tg, bar);
            __builtin_amdgcn_fence(__ATOMIC_ACQUIRE, "agent");
            xb_add(&bar[XB_XGEN(b.x)], 1u);
            asm volatile("s_waitcnt vmcnt(0)" ::: "memory");
        } else {
            XB_SPIN(xb_ld(&bar[XB_XGEN(b.x)]) == gen, bar);
            __builtin_amdgcn_fence(__ATOMIC_ACQUIRE, "agent");
            asm volatile("s_waitcnt vmcnt(0)" ::: "memory");
        }
    }
    __syncthreads();
}

struct Args { const float* in[31]; float* out; unsigned char* ws; int ph_lo, ph_hi; };
struct Ctx {
    LAS unsigned char* lds; int tid, lane, wave, G, bid;
    const Args* a; float* out; unsigned char* ws;
};
template <class T> __device__ __forceinline__ T* launder_uniform(T* p) {
    unsigned lo, hi;
    asm volatile("v_mov_b32 %0, %2\n\tv_mov_b32 %1, %3" : "=&v"(lo), "=&v"(hi) : "s"((unsigned)(uintptr_t)p), "s"((unsigned)((uintptr_t)p >> 32)));
    lo = __builtin_amdgcn_readfirstlane(lo); hi = __builtin_amdgcn_readfirstlane(hi);
    return (T*)(((uintptr_t)hi << 32) | (uintptr_t)lo);
}
__device__ __forceinline__ Ctx fresh(const Ctx& F0) {
    Ctx F = F0; int bid = F0.bid, G = F0.G, wv = F0.wave;
    int lane = (int)__builtin_amdgcn_mbcnt_hi(~0u, __builtin_amdgcn_mbcnt_lo(~0u, 0u));
    asm volatile("" : "+v"(lane)); asm volatile("" : "+v"(bid)); asm volatile("" : "+v"(G)); asm volatile("" : "+v"(wv));
    bid = __builtin_amdgcn_readfirstlane(bid); G = __builtin_amdgcn_readfirstlane(G); wv = __builtin_amdgcn_readfirstlane(wv);
    F.tid = wv * 64 + lane; F.lane = lane; F.wave = wv; F.bid = bid; F.G = G; F.ws = launder_uniform(F0.ws); F.out = launder_uniform(F0.out); F.a = F0.a;
    { unsigned l = (unsigned)(uintptr_t)F0.lds; asm volatile("" : "+v"(l)); F.lds = (LAS unsigned char*)(uintptr_t)__builtin_amdgcn_readfirstlane(l); }
    return F;
}
enum { I_X = 0, I_C, I_CTX, I_CCTX, I_ADAW, I_ADAB, I_WIN, I_QG, I_WUQ, I_KVG, I_WUKV, I_POOLW, I_POOLS, I_CDW, I_CB, I_CLNG, I_CLNB, I_CPW, I_WOUT,
       I_LN1G, I_LN1B, I_RW, I_RB, I_EWG, I_EWU, I_EWD, I_SWG, I_SWU, I_SWD, I_LN2G, I_LN2B };

__device__ __forceinline__ int permd(int c) { return (c & ~255) + 128 * ((c >> 3) & 1) + 32 * ((c >> 6) & 3) + 8 * ((c >> 4) & 3) + (c & 7); }
__device__ __forceinline__ void xpose_item(const float* W, int N, const float* gain, bf16_t* WT, int ldk, int koff, int rmul, int radd, LAS float* scr, int kb, int nb, int lane, bool pd = false) {
    const int k0 = 64 * kb, n0 = 32 * nb;
    float v[32]; const float* wp = W + (size_t)(k0 + (lane >> 5)) * N + n0 + (lane & 31);
#pragma unroll
    for (int i = 0; i < 32; ++i) v[i] = wp[(size_t)(2 * i) * N];
    if (gain) {
#pragma unroll
        for (int i = 0; i < 32; ++i) v[i] *= gain[k0 + 2 * i + (lane >> 5)]; }
#pragma unroll
    for (int i = 0; i < 32; ++i) scr[(2 * i + (lane >> 5)) * 33 + (lane & 31)] = v[i];
    LDS_WAIT(); asm volatile("" ::: "memory");
    const int c = lane & 7;
#pragma unroll
    for (int j = 0; j < 4; ++j) { const int n = (lane >> 3) + 8 * j; const LAS float* s = scr + (8 * c) * 33 + n;
        u32x4 o; o.x = pk2(s[0 * 33], s[1 * 33]); o.y = pk2(s[2 * 33], s[3 * 33]); o.z = pk2(s[4 * 33], s[5 * 33]); o.w = pk2(s[6 * 33], s[7 * 33]);
        const int drow = pd ? permd(n0 + n) : (n0 + n) * rmul + radd;
        *(u32x4*)(WT + (size_t)drow * ldk + koff + k0 + 8 * c) = o; }
    LDS_WAIT(); asm volatile("" ::: "memory");
}
__device__ __forceinline__ void xpose64_item(const float* W, int N, bf16_t* WT, int ldk, int radd, bool pd, LAS float* scr, int kb, int nb, int lane) {
    const int k0 = 64 * kb, n0 = 64 * nb; f32x4 v[16];
    const float* wp = W + (size_t)(k0 + (lane >> 4)) * N + n0 + 4 * (lane & 15);
#pragma unroll
    for (int i = 0; i < 16; ++i) v[i] = *(const f32x4*)(wp + (size_t)(4 * i) * N);
#pragma unroll
    for (int i = 0; i < 16; ++i) *(LAS f32x4*)(scr + (4 * i + (lane >> 4)) * 68 + 4 * (lane & 15)) = v[i];
    LDS_WAIT(); asm volatile("" ::: "memory");
    const int c = lane & 7;
#pragma unroll
    for (int pass = 0; pass < 2; ++pass) { const int nq = (lane >> 3) + 8 * pass; f32x4 r[8];
#pragma unroll
        for (int q = 0; q < 8; ++q) r[q] = *(const LAS f32x4*)(scr + (8 * c + q) * 68 + 4 * nq);
#pragma unroll
        for (int x = 0; x < 4; ++x) { const int n = n0 + 4 * nq + x; const int drow = pd ? permd(n) : n + radd;
            u32x4 o; o.x = pk2(r[0][x], r[1][x]); o.y = pk2(r[2][x], r[3][x]); o.z = pk2(r[4][x], r[5][x]); o.w = pk2(r[6][x], r[7][x]);
            *(u32x4*)(WT + (size_t)drow * ldk + k0 + 8 * c) = o; } }
    LDS_WAIT(); asm volatile("" ::: "memory");
}
__device__ __forceinline__ void prep_layer(const Ctx& F0, int l, unsigned var = 0u) {
    const Ctx F = fresh(F0);
    LAS float* scr = (LAS float*)(F.lds + F.wave * 17408);
    const int gw = F.bid * NWAVES + F.wave, NGW = F.G * NWAVES, lane = F.lane;
    const float* w_in = F.a->in[I_WIN] + (size_t)l * DM * INC; const float* w_uq = F.a->in[I_WUQ] + (size_t)l * 256 * 768; const float* w_ukv = F.a->in[I_WUKV] + (size_t)l * 128 * 1024;
    const float* w_out = F.a->in[I_WOUT] + (size_t)l * DM * DM;
    constexpr int I1 = 16 * 37, I2 = 4 * 24, I3 = 2 * 32, I4 = 8 * 32, I5 = 33 * 2 * 64, I6 = 33 * 64, I7 = 1024  , I8 = 96   + 128  ;
    constexpr int NIT = I1 + I2 + I3 + I4 + I5 + I6 + I7 + I8;
    for (int it = gw; it < NIT; it += NGW) {
        int r = it;
        if (r < I1) { xpose_item(w_in, INC, nullptr, ((bf16_t*)(F.ws + WS_W + W_WIN)), DM, 0, 1, 0, scr, r / 37, r % 37, lane); continue; } r -= I1;
        if (r < I2) { xpose_item(w_uq, 768, F.a->in[I_QG] + l * 256, ((bf16_t*)(F.ws + WS_W + W_WQ)), 256, 0, 1, 0, scr, r / 24, r % 24, lane); continue; } r -= I2;
        if (r < I3) { xpose_item(w_ukv, 1024, F.a->in[I_KVG] + l * 128, ((bf16_t*)(F.ws + WS_W + W_WKV)), 256, 0, 1, 0, scr, r / 32, r % 32, lane); continue; } r -= I3;
        if (r < I4) { xpose_item(w_out, DM, nullptr, ((bf16_t*)(F.ws + WS_W + W_WO)), DM, 0, 1, 0, scr, r / 32, r % 32, lane, true); continue; } r -= I4;
        if (r < I5) { if (var & 8u) continue; const int e = r / 128, q = r % 128, which = q / 64, i2 = q % 64;
            const float* src = e < 32 ? (which ? F.a->in[I_EWU] : F.a->in[I_EWG]) + ((size_t)l * 32 + e) * DM * 256 : (which ? F.a->in[I_SWU] : F.a->in[I_SWG]) + (size_t)l * DM * 256;
            xpose64_item(src, 256, ((bf16_t*)(F.ws + WS_W + W_WGU)) + (size_t)e * 512 * DM, DM, ((i2 % 4) / 2) * 128 + which * 128, false, scr, i2 / 4, i2 % 4, lane); continue; } r -= I5;
        if (r < I6) { if (var & 16u) continue; const int e = r / 64, i2 = r % 64;
            const float* src = e < 32 ? F.a->in[I_EWD] + ((size_t)l * 32 + e) * 256 * DM : F.a->in[I_SWD] + (size_t)l * 256 * DM;
            xpose64_item(src, DM, ((bf16_t*)(F.ws + WS_W + W_WD)) + (size_t)e * DM * 256, 256, 0, true, scr, i2 / 16, i2 % 16, lane); continue; } r -= I6;
        if (r < I7) { if (var & 32u) continue;
            const int kg = r / 16, n = (r % 16) * 64 + lane; float acc[8];
#pragma unroll
            for (int i = 0; i < 8; ++i) acc[i] = 0.f;
            if (kg < 32) { const int g = kg / 8, i0 = (kg % 8) * 8; const float* pw = F.a->in[I_POOLW] + ((size_t)l * 4 + g) * 4096; const float* ps = F.a->in[I_POOLS] + l * 256 + g * 64;
                for (int jb = 0; jb < 64; jb += 16) { float wv[16];
#pragma unroll
                    for (int j = 0; j < 16; ++j) wv[j] = w_out[(size_t)(512 + g * 64 + jb + j) * DM + n];
#pragma unroll
                    for (int j = 0; j < 16; ++j) { const float wj = wv[j] * ps[jb + j];
#pragma unroll
                        for (int i = 0; i < 8; ++i) acc[i] += pw[(i0 + i) * 64 + jb + j] * wj; } } }
            else { const int i0 = (kg - 32) * 8; const float* cp = F.a->in[I_CPW] + (size_t)l * 65536;
                for (int jb = 0; jb < 256; jb += 16) { float wv[16];
#pragma unroll
                    for (int j = 0; j < 16; ++j) wv[j] = w_out[(size_t)(768 + jb + j) * DM + n];
#pragma unroll
                    for (int j = 0; j < 16; ++j) {
#pragma unroll
                        for (int i = 0; i < 8; ++i) acc[i] += cp[(i0 + i) * 256 + jb + j] * wv[j]; } } }
            u32x4 o; o.x = pk2(acc[0], acc[1]); o.y = pk2(acc[2], acc[3]); o.z = pk2(acc[4], acc[5]); o.w = pk2(acc[6], acc[7]);
            *(u32x4*)(((bf16_t*)(F.ws + WS_W + W_WO)) + (size_t)permd(n) * DM + 512 + kg * 8) = o; continue; } r -= I7;
        { unsigned zz = 0u; asm volatile("" : "+v"(zz)); const u32x4 z = {zz, zz, zz, zz};
          if (r < 96) { u32x4* d = (u32x4*)(((bf16_t*)(F.ws + WS_W + W_WIN)) + (size_t)(INC + r) * DM); d[lane] = z; d[64 + lane] = z; }
          else { const int n = (r - 96) * 8 + (lane >> 3); u32x4* d = (u32x4*)(((bf16_t*)(F.ws + WS_W + W_WKV)) + (size_t)n * 256 + 128); d[lane & 7] = z; d[8 + (lane & 7)] = z; } }
    }
}

__device__ __forceinline__ void mods_phase(const Ctx& F0) {
    const Ctx F = fresh(F0);
    LAS float* sv = (LAS float*)F.lds;
    LAS float* part = sv + 5 * 1024;
    for (int i = F.tid; i < 5 * 1024; i += NTHR) { const int j = i >> 10, k = i & 1023; const float c = j < 4 ? F.a->in[I_C][j * DM + k] : F.a->in[I_CCTX][k]; sv[i] = silu(c); }
    __syncthreads();
    for (int it = F.bid; it < DEPTH * 96; it += F.G) {
        const int l = it / 96, n = (it % 96) * 64 + F.lane; const float* aw = F.a->in[I_ADAW] + (size_t)l * DM * 6144 + n;
        float acc[5] = {0.f, 0.f, 0.f, 0.f, 0.f};
        const int kb = F.wave * 128;
#pragma unroll 8
        for (int k = 0; k < 128; ++k) { const float a = aw[(size_t)(kb + k) * 6144];
#pragma unroll
            for (int j = 0; j < 5; ++j) acc[j] += sv[j * 1024 + kb + k] * a; }
#pragma unroll
        for (int j = 0; j < 5; ++j) part[(F.wave * 5 + j) * 64 + F.lane] = acc[j];
        __syncthreads();
        if (F.wave < 5) { float s = F.a->in[I_ADAB][l * 6144 + n];
#pragma unroll
            for (int w = 0; w < 8; ++w) s += part[(w * 5 + F.wave) * 64 + F.lane];
            ((float*)(F.ws + WS_MISC + M_MOD))[((size_t)l * 5 + F.wave) * 6144 + n] = s; }
        __syncthreads();
    }
    if (F.bid == F.G - 1) {
        for (int i = F.tid; i < 1024; i += NTHR) { const int pos = i >> 3, j = i & 7;
            const double c1 = j == 0 ? 0.54030230586813977 : j == 1 ? 0.95041528025518285 : j == 2 ? 0.99500416527802582 : j == 3 ? 0.99950004166527784 : j == 4 ? 0.99995000041666526 : j == 5 ? 0.99999500000416663 : j == 6 ? 0.99999950000004167 : 0.99999995000000041;
            const double s1 = j == 0 ? 0.8414709848078965 : j == 1 ? 0.31098359290718575 : j == 2 ? 0.099833416646828155 : j == 3 ? 0.031617506402433708 : j == 4 ? 0.0099998333341666645 : j == 5 ? 0.0031622723897082477 : j == 6 ? 0.00099999983333334168 : 0.00031622776074637522;
            double c = 1.0, sn = 0.0;
            for (int q = 0; q < pos; ++q) { const double nc = c * c1 - sn * s1, ns = sn * c1 + c * s1; c = nc; sn = ns; }
            ((float*)(F.ws + WS_MISC + M_ROPE))[pos * 16 + j] = (float)c; ((float*)(F.ws + WS_MISC + M_ROPE))[pos * 16 + 8 + j] = (float)sn; }
    }
}

__device__ __forceinline__ void row_ln(f32x4 (&v)[4]) {
    float s = 0.f;
#pragma unroll
    for (int j = 0; j < 4; ++j) s += (v[j].x + v[j].y) + (v[j].z + v[j].w);
    const float mean = wave_sum(s) * (1.f / DM); float s2 = 0.f;
#pragma unroll
    for (int j = 0; j < 4; ++j) { v[j] = v[j] - mean; s2 += (v[j].x * v[j].x + v[j].y * v[j].y) + (v[j].z * v[j].z + v[j].w * v[j].w); }
    const float rstd = 1.f / sqrtf(wave_sum(s2) * (1.f / DM) + EPS);
#pragma unroll
    for (int j = 0; j < 4; ++j) v[j] = v[j] * rstd;
}
__device__ __forceinline__ void row_load(f32x4 (&v)[4], const float* row, int lane) {
#pragma unroll
    for (int j = 0; j < 4; ++j) v[j] = *(const f32x4*)(row + 4 * lane + 256 * j);
}
__device__ __forceinline__ void row_store(const f32x4 (&v)[4], float* row, int lane) {
#pragma unroll
    for (int j = 0; j < 4; ++j) *(f32x4*)(row + 4 * lane + 256 * j) = v[j];
}
__device__ __forceinline__ void row_store_bf(const f32x4 (&v)[4], bf16_t* row, int lane) {
#pragma unroll
    for (int j = 0; j < 4; ++j) { u32x2 o; o.x = pk2(v[j].x, v[j].y); o.y = pk2(v[j].z, v[j].w); *(u32x2*)(row + 4 * lane + 256 * j) = o; }
}
__device__ __forceinline__ void row_load_bf(f32x4 (&v)[4], const bf16_t* row, int lane) {
#pragma unroll
    for (int j = 0; j < 4; ++j) { const u32x2 o = *(const u32x2*)(row + 4 * lane + 256 * j); v[j] = (f32x4){bf2f(o.x & 0xffffu), bf2f(o.x >> 16), bf2f(o.y & 0xffffu), bf2f(o.y >> 16)}; }
}
__device__ __forceinline__ void row_mod(f32x4 (&v)[4], const float* shift, const float* scale, int lane) {
#pragma unroll
    for (int j = 0; j < 4; ++j) { const f32x4 sc = *(const f32x4*)(scale + 4 * lane + 256 * j), sh = *(const f32x4*)(shift + 4 * lane + 256 * j); v[j] = v[j] * (sc + 1.f) + sh; }
}
__device__ __forceinline__ void row_affine(f32x4 (&v)[4], const float* g, const float* b, int lane) {
#pragma unroll
    for (int j = 0; j < 4; ++j) { const f32x4 gg = *(const f32x4*)(g + 4 * lane + 256 * j), bb = *(const f32x4*)(b + 4 * lane + 256 * j); v[j] = v[j] * gg + bb; }
}

__device__ __forceinline__ void r0_phase(const Ctx& F0) {
    const Ctx F = fresh(F0);
    const int gw = F.bid * NWAVES + F.wave, NGW = F.G * NWAVES;
    for (int r = gw; r < TT; r += NGW) {
        const float* src = r < TL ? F.a->in[I_X] + (size_t)r * DM : F.a->in[I_CTX] + (size_t)(r - TL) * DM;
        const float* md = ((float*)(F.ws + WS_MISC + M_MOD)) + (size_t)batch_of(r) * 6144;
        f32x4 v[4]; row_load(v, src, F.lane); row_ln(v); row_mod(v, md, md + 1024, F.lane); row_store_bf(v, ((bf16_t*)(F.ws + WS_H)) + (size_t)r * DM, F.lane);
    }
}

#ifndef PG8_ALIGN_DEFAULT
#define PG8_ALIGN_DEFAULT true
#endif
namespace pg8 {
constexpr int BM = 256, BK = 64, HALF = 128, HTB = HALF * BK * 2, STAGE_BYTES = 8 * HTB, NXCD = 8, WGM = 8;
__device__ __forceinline__ int lds_byte(int r, int c) { const int st = (r >> 4) * 2 + (c >> 5), rr = r & 15, cc = c & 31, ob = rr * 64 + cc * 2; return st * 1024 + (ob ^ (((ob >> 9) & 1) << 5)); }
__device__ __forceinline__ void stage_rc(int b, int& R, int& C) { const int st = b / 1024, sb = b % 1024, swz = sb ^ (((sb >> 9) & 1) << 5); R = (st >> 1) * 16 + swz / 64; C = (st & 1) * 32 + (swz % 64) / 2; }
__device__ __forceinline__ int perm32(int rho) { const int n = rho >> 4, i = rho & 15; return 8 * (i >> 2) + 4 * n + (i & 3); }
struct Unit { int pm, pn, e, nvalid, base, idx; };
__device__ __forceinline__ int xcd_remap(int wgid, int nwg) { const int q = nwg / NXCD, r = nwg % NXCD, xcd = wgid % NXCD, off = wgid / NXCD; return (xcd < r ? xcd * (q + 1) : r * (q + 1) + (xcd - r) * q) + off; }
struct StaticOrder {
    int nM, nN, nwg, G, c;
    __device__ void init(int M, int N, int G_, int c_) { nM = M / BM; nN = N / BM; nwg = nM * nN; G = G_; c = c_; }
    __device__ void at(int L, int i, Unit& u) const {
        const int wgid = xcd_remap(L, nwg);
        const int nig = WGM * nN, gid = wgid / nig, fm = gid * WGM, gsz = (nM - fm) < WGM ? (nM - fm) : WGM;
        u.pm = fm + ((wgid % nig) % gsz); u.pn = (wgid % nig) / gsz; u.e = 0; u.nvalid = 256; u.base = 0; u.idx = i;
    }
    __device__ bool next(int i, Unit& u) const { const long L = (long)i * G + c; if (L >= nwg) return false; at((int)L, i, u); return true; }
};
struct DualOrder {
    StaticOrder A, B; int G, c;
    __device__ bool next(int i, Unit& u) const { const long L = (long)i * G + c; if (L >= A.nwg + B.nwg) return false;
        if (L < A.nwg) { A.at((int)L, i, u); u.e = 0; } else { B.at((int)L - A.nwg, i, u); u.e = 1; } return true; }
};
struct ExpertOrder {
    const LAS int* tl; const LAS int* cnt; const LAS int* te; int nN, nwg, G, c;
    __device__ void init(const LAS int* tl_, const LAS int* cnt_, const LAS int* te_, int nN_, int G_, int c_) { tl = tl_; cnt = cnt_; te = te_; nN = nN_; nwg = __builtin_amdgcn_readfirstlane(tl_[33]) * nN_; G = G_; c = c_; }
    __device__ bool next(int i, Unit& u) const {
        const long L = (long)i * G + c; if (L >= nwg) return false;
        const int wgid = xcd_remap((int)L, nwg), mt = wgid / nN;
        const int e = __builtin_amdgcn_readfirstlane(te[mt]);
        const int te_ = __builtin_amdgcn_readfirstlane(tl[e]), ce = __builtin_amdgcn_readfirstlane(cnt[e]);
        u.e = e; u.pm = mt - te_; u.pn = wgid % nN; u.nvalid = ce - u.pm * 256; u.base = te_ * 256; u.idx = i; return true;
    }
};
__device__ __forceinline__ unsigned cvt_pk_bf16(float lo, float hi) { unsigned r; asm volatile("v_cvt_pk_bf16_f32 %0, %1, %2" : "=v"(r) : "v"(lo), "v"(hi)); return r; }
__device__ __forceinline__ u32x4 pack8(const f32x4& v0, const f32x4& v1) { u32x4 w; w.x = cvt_pk_bf16(v0[0], v0[1]); w.y = cvt_pk_bf16(v0[2], v0[3]); w.z = cvt_pk_bf16(v1[0], v1[1]); w.w = cvt_pk_bf16(v1[2], v1[3]); return w; }

template <bool GATHER, bool ALIGN_EPI = PG8_ALIGN_DEFAULT, class Sched, class AOff, class BPtr, class Epi>
__device__ __forceinline__ void gemm256(LAS unsigned char* lds, int tid, const char* Abase, int pitch, int K, const Sched& S, const AOff& aoff, const BPtr& bptr, const Epi& E) {
    const int wid = __builtin_amdgcn_readfirstlane(tid >> 6), lane = tid & 63, wr = wid >> 2, wc = wid & 3, fr = lane & 15, fq = lane >> 4;
    const int nt = K / BK;
    int sR, sC; stage_rc(tid * 16, sR, sC);
    const unsigned voffB = (unsigned)(((sR & ~31) + perm32(sR & 31)) * K + sC) * 2u;
    const unsigned laneA = (unsigned)sR * (unsigned)pitch + (unsigned)sC * 2u;
    const size_t kstep = (size_t)(BK * 2);
    const size_t hstepB = (size_t)HALF * K * 2, pstepB = (size_t)64 * K * 2;
    const size_t hstepA = (size_t)HALF * pitch, pstepA = (size_t)64 * pitch;
    const unsigned ldsw = (unsigned)wid * 1024u;
    const int aoffl = lds_byte(wr * 64 + fr, fq * 8), boffl = lds_byte(wc * 32 + fr, fq * 8);
#define PG8_SA(b, h) (((b) * 2 + (h)) * HTB)
#define PG8_SB(b, h) ((4 + (b) * 2 + (h)) * HTB)
#define PG8_STAGEB(bufoff, gbase) do { _Pragma("unroll") for (int _i = 0; _i < 2; ++_i) \
        __builtin_amdgcn_global_load_lds((const unsigned*)((const char*)(gbase) + _i * pstepB + voffB), (LAS unsigned*)(lds + (bufoff) + ldsw + _i * 8192), 16, 0, 0); } while (0)
#define PG8_STAGEA(bufoff, TP, OFFS, h, kb) do { _Pragma("unroll") for (int _i = 0; _i < 2; ++_i) { \
        const char* _p; if constexpr (GATHER) _p = Abase + (size_t)(OFFS)[h][_i] + (kb); else _p = (TP) + ((h) * hstepA + _i * pstepA + (kb)) + laneA; \
        __builtin_amdgcn_global_load_lds((const unsigned*)_p, (LAS unsigned*)(lds + (bufoff) + ldsw + _i * 8192), 16, 0, 0); } } while (0)
#define PG8_LDA(dst, b, h) do { _Pragma("unroll") for (int m = 0; m < 4; ++m) _Pragma("unroll") for (int k = 0; k < 2; ++k) dst[m][k] = *(const LAS bf16x8*)(lds + PG8_SA(b, h) + aoffl + m * 2048 + k * 1024); } while (0)
#define PG8_LDB(dst, b, h) do { _Pragma("unroll") for (int n = 0; n < 2; ++n) _Pragma("unroll") for (int k = 0; k < 2; ++k) dst[n][k] = *(const LAS bf16x8*)(lds + PG8_SB(b, h) + boffl + n * 2048 + k * 1024); } while (0)
#define PG8_MMA(ai, bj, At, Bt) do { __builtin_amdgcn_s_setprio(1); _Pragma("unroll") for (int m = 0; m < 4; ++m) _Pragma("unroll") for (int n = 0; n < 2; ++n) _Pragma("unroll") for (int k = 0; k < 2; ++k) \
        acc[ai][bj][m][n] = __builtin_amdgcn_mfma_f32_16x16x32_bf16(Bt[n][k], At[m][k], acc[ai][bj][m][n], 0, 0, 0); __builtin_amdgcn_s_setprio(0); } while (0)
#define PG8_WAIT_V(n) asm volatile("s_waitcnt vmcnt(" #n ")" ::: "memory")
#define PG8_WAIT_L(n) asm volatile("s_waitcnt lgkmcnt(" #n ")" ::: "memory")
#define PG8_BAR __builtin_amdgcn_s_barrier()
#define PG8_SCHED __builtin_amdgcn_sched_barrier(0)
#define PG8_AOFFS(dst, tp, u) do { if constexpr (GATHER) { _Pragma("unroll") for (int _h = 0; _h < 2; ++_h) _Pragma("unroll") for (int _i = 0; _i < 2; ++_i) dst[_h][_i] = aoff(u, _h * 128 + _i * 64 + sR) + (unsigned)sC * 2u; } \
        else tp = aoff(u); } while (0)
    Unit cur, nxt; int ui = 0;
    if (!S.next(0, cur)) return;
    f32x4 acc[2][2][4][2];
#pragma unroll
    for (int a = 0; a < 2; ++a)
#pragma unroll
        for (int b = 0; b < 2; ++b)
#pragma unroll
            for (int m = 0; m < 4; ++m)
#pragma unroll
                for (int n = 0; n < 2; ++n) acc[a][b][m][n] = (f32x4){0.f, 0.f, 0.f, 0.f};
    bf16x8 At[4][2], B0[2][2], B1[2][2];
    unsigned cA[2][2] = {{0u, 0u}, {0u, 0u}}, nA[2][2] = {{0u, 0u}, {0u, 0u}}; const char* cTP = Abase; const char* nTP = Abase;
    PG8_AOFFS(cA, cTP, cur);
    const char* cB = bptr(cur);
    PG8_STAGEB(PG8_SB(0, 0), cB); PG8_STAGEB(PG8_SB(0, 1), cB + hstepB); PG8_STAGEA(PG8_SA(0, 0), cTP, cA, 0, 0); PG8_STAGEA(PG8_SA(0, 1), cTP, cA, 1, 0);
    if (wr == 1) PG8_BAR;
    PG8_WAIT_V(2); PG8_BAR;
    PG8_STAGEB(PG8_SB(1, 0), cB + kstep); PG8_STAGEA(PG8_SA(1, 0), cTP, cA, 0, kstep); PG8_STAGEB(PG8_SB(1, 1), cB + hstepB + kstep);
    PG8_WAIT_V(6); PG8_BAR;
    for (;;) {
        const bool has_next = S.next(ui + 1, nxt);
        const char* nB = cB; nTP = cTP;
        if (has_next) { PG8_AOFFS(nA, nTP, nxt); nB = bptr(nxt); }
        else { if constexpr (GATHER) {
#pragma unroll
            for (int h = 0; h < 2; ++h)
#pragma unroll
                for (int i = 0; i < 2; ++i) nA[h][i] = cA[h][i]; } }
        for (int t = 0; t < nt; t += 2) {
            const bool last = (t == nt - 2);
            const size_t k1 = (size_t)(t + 1) * kstep;
            unsigned a2o[2][2] = {{0u, 0u}, {0u, 0u}};
            if constexpr (GATHER) {
#pragma unroll
                for (int h = 0; h < 2; ++h)
#pragma unroll
                    for (int i = 0; i < 2; ++i) a2o[h][i] = last ? nA[h][i] : cA[h][i]; }
            const char* t2p = last ? nTP : cTP;
            const size_t k2 = last ? 0 : (size_t)(t + 2) * kstep, k3 = k2 + kstep;
            const char* b2 = last ? nB : cB + (size_t)(t + 2) * kstep; const char* b3 = b2 + kstep;
            PG8_LDB(B0, 0, 0); PG8_LDB(B1, 0, 1); PG8_SCHED; PG8_LDA(At, 0, 0); PG8_STAGEA(PG8_SA(1, 1), cTP, cA, 1, k1);
            PG8_WAIT_V(8); PG8_WAIT_L(0); PG8_BAR; PG8_MMA(0, 0, At, B0); PG8_MMA(0, 1, At, B1); PG8_BAR; PG8_SCHED;
            PG8_LDA(At, 0, 1); PG8_STAGEB(PG8_SB(0, 0), b2); PG8_STAGEB(PG8_SB(0, 1), b2 + hstepB); PG8_STAGEA(PG8_SA(0, 0), t2p, a2o, 0, k2);
            PG8_WAIT_V(8); PG8_WAIT_L(0); PG8_BAR; PG8_MMA(1, 0, At, B0); PG8_MMA(1, 1, At, B1); PG8_BAR; PG8_SCHED;
            PG8_LDB(B0, 1, 0); PG8_LDB(B1, 1, 1); PG8_SCHED; PG8_LDA(At, 1, 0); PG8_STAGEA(PG8_SA(0, 1), t2p, a2o, 1, k2);
            PG8_WAIT_V(8); PG8_WAIT_L(0); PG8_BAR; PG8_MMA(0, 0, At, B0); PG8_MMA(0, 1, At, B1); PG8_BAR; PG8_SCHED;
            PG8_LDA(At, 1, 1); PG8_STAGEB(PG8_SB(1, 0), b3); PG8_STAGEB(PG8_SB(1, 1), b3 + hstepB); PG8_STAGEA(PG8_SA(1, 0), t2p, a2o, 0, k3);
            PG8_WAIT_V(8); PG8_WAIT_L(0); PG8_BAR; PG8_MMA(1, 0, At, B0); PG8_MMA(1, 1, At, B1); PG8_BAR; PG8_SCHED;
        }
        if constexpr (ALIGN_EPI) { if (wr == 0) PG8_BAR; }
        { int l2 = lane; asm volatile("" : "+v"(l2)); E(acc, cur, wr, wc, l2 & 15, l2 >> 4); }
        if (!has_next) break;
#pragma unroll
        for (int a = 0; a < 2; ++a)
#pragma unroll
            for (int b = 0; b < 2; ++b)
#pragma unroll
                for (int m = 0; m < 4; ++m)
#pragma unroll
                    for (int n = 0; n < 2; ++n) acc[a][b][m][n] = (f32x4){0.f, 0.f, 0.f, 0.f};
        cur = nxt; cB = nB; cTP = nTP; ++ui;
        if constexpr (GATHER) {
#pragma unroll
            for (int h = 0; h < 2; ++h)
#pragma unroll
                for (int i = 0; i < 2; ++i) cA[h][i] = nA[h][i]; }
        if constexpr (ALIGN_EPI) { if (wr == 1) PG8_BAR; }
    }
    PG8_WAIT_V(0);
    if constexpr (!ALIGN_EPI) { if (wr == 0) PG8_BAR; }
    PG8_BAR;
#undef PG8_SA
#undef PG8_SB
#undef PG8_STAGEA
#undef PG8_STAGEB
#undef PG8_LDA
#undef PG8_LDB
#undef PG8_MMA
#undef PG8_WAIT_V
#undef PG8_WAIT_L
#undef PG8_BAR
#undef PG8_SCHED
#undef PG8_AOFFS
}
}

constexpr float YB_SCALE = 16.f, YB_INV = 1.f / 16.f;
#define FP8C(x) __builtin_amdgcn_fmed3f((x), -440.f, 440.f)
__device__ __forceinline__ u32x2 pack8_fp8(const f32x4& v0, const f32x4& v1) { u32x2 w; int p = __builtin_amdgcn_cvt_pk_fp8_f32(FP8C(v0[0]), FP8C(v0[1]), 0, false); p = __builtin_amdgcn_cvt_pk_fp8_f32(FP8C(v0[2]), FP8C(v0[3]), p, true); w.x = (unsigned)p;
    p = __builtin_amdgcn_cvt_pk_fp8_f32(FP8C(v1[0]), FP8C(v1[1]), 0, false); p = __builtin_amdgcn_cvt_pk_fp8_f32(FP8C(v1[2]), FP8C(v1[3]), p, true); w.y = (unsigned)p; return w; }
struct EpiStore { bf16_t* O; int ldc;
    __device__ __forceinline__ void operator()(const f32x4 (&acc)[2][2][4][2], const pg8::Unit& u, int wr, int wc, int fr, int fq) const {
        bf16_t* base = O + (size_t)(u.pm * 256 + wr * 64 + fr) * ldc + u.pn * 256 + wc * 32 + 8 * fq;
#pragma unroll
        for (int ai = 0; ai < 2; ++ai)
#pragma unroll
            for (int m = 0; m < 4; ++m) { bf16_t* rowp = base + (size_t)(ai * 128 + m * 16) * ldc;
#pragma unroll
                for (int bj = 0; bj < 2; ++bj) *(u32x4*)(rowp + bj * 128) = pg8::pack8(acc[ai][bj][m][0], acc[ai][bj][m][1]);
                asm volatile("" ::: "memory"); } } };
struct EpiG1 { bf16_t* P; float* rs; bf16_t* KR; const float* rope;
    __device__ __forceinline__ void operator()(const f32x4 (&acc)[2][2][4][2], const pg8::Unit& u, int wr, int wc, int fr, int fq) const {
        bf16_t* base = P + (size_t)(u.pm * 256 + wr * 64 + fr) * PW + u.pn * 256 + wc * 32 + 8 * fq;
#pragma unroll
        for (int ai = 0; ai < 2; ++ai)
#pragma unroll
            for (int m = 0; m < 4; ++m) { bf16_t* rowp = base + (size_t)(ai * 128 + m * 16) * PW;
#pragma unroll
                for (int bj = 0; bj < 2; ++bj) *(u32x4*)(rowp + bj * 128) = pg8::pack8(acc[ai][bj][m][0], acc[ai][bj][m][1]);
                asm volatile("" ::: "memory"); }
        if (u.pn < 2) {
#pragma unroll
            for (int ai = 0; ai < 2; ++ai)
#pragma unroll
                for (int m = 0; m < 4; ++m) { const int r = u.pm * 256 + ai * 128 + wr * 64 + m * 16 + fr;
                    const f32x4 a0 = acc[ai][0][m][0], a1 = acc[ai][0][m][1], b0 = acc[ai][1][m][0], b1 = acc[ai][1][m][1];
                    float ss = (a0[0] * a0[0] + a0[1] * a0[1]) + (a0[2] * a0[2] + a0[3] * a0[3]) + (a1[0] * a1[0] + a1[1] * a1[1]) + (a1[2] * a1[2] + a1[3] * a1[3]);
                    if (u.pn == 0) ss += (b0[0] * b0[0] + b0[1] * b0[1]) + (b0[2] * b0[2] + b0[3] * b0[3]) + (b1[0] * b1[0] + b1[1] * b1[1]) + (b1[2] * b1[2] + b1[3] * b1[3]);
                    { float o; const float a = swap16_f(ss, o); ss = a + o; }
                    { auto rr = __builtin_amdgcn_permlane32_swap(__float_as_uint(ss), __float_as_uint(ss), false, false); ss = __uint_as_float(rr[0]) + __uint_as_float(rr[1]); }
                    if (fq == 0) rs[(size_t)r * 8 + u.pn * 4 + wc] = ss;
                    if (u.pn == 1) {
                        f32x4 p0, p1;
#pragma unroll
                        for (int i = 0; i < 4; ++i) { float o; const float a = swap16_f(b0[i], o); p0[i] = (fq & 1) ? a : o; const float c = swap16_f(b1[i], o); p1[i] = (fq & 1) ? c : o; }
                        if (wc == 0) { f32x4 v0 = b0, v1 = b1;
                            if (r < TL) { const int sq = r & (SEQ - 1), pos = (fq & 2) ? (sq & 63) : (sq >> 6); const float* tb = rope + pos * 16;
                                const f32x4 cs0 = *(const f32x4*)tb, cs1 = *(const f32x4*)(tb + 4), sn0 = *(const f32x4*)(tb + 8), sn1 = *(const f32x4*)(tb + 12);
                                if (fq & 1) { v0 = v0 * cs0 + p0 * sn0; v1 = v1 * cs1 + p1 * sn1; } else { v0 = v0 * cs0 - p0 * sn0; v1 = v1 * cs1 - p1 * sn1; } }
                            *(u32x4*)(KR + (size_t)kvrow_of(r) * 32 + 8 * fq) = pg8::pack8(v0, v1); } }
                    asm volatile("" ::: "memory"); } } } };
__device__ __forceinline__ void g1_phase(const Ctx& F0) {
    const Ctx F = fresh(F0);
    pg8::StaticOrder S; S.init(TT, PW, F.G, F.bid);
    const char* Ab = (const char*)(F.ws + WS_H);
    auto aoff = [&](const pg8::Unit& u) { return Ab + (size_t)u.pm * 256 * DM * 2; };
    const char* Bt = (const char*)(F.ws + WS_W + W_WIN);
    auto bptr = [&](const pg8::Unit& u) { return Bt + (size_t)u.pn * 256 * DM * 2; };
    EpiG1 E{(bf16_t*)(F.ws + WS_P), (float*)(F.ws + WS_MISC + M_RS), (bf16_t*)(F.ws + WS_KR), (const float*)(F.ws + WS_MISC + M_ROPE)};
    pg8::gemm256<false>(F.lds, F.tid, Ab, DM * 2, DM, S, aoff, bptr, E);
}
struct EpiQ { bf16_t* Q; bf16_t* QR; const float* rs; const float* rope;
    __device__ __forceinline__ void operator()(const f32x4 (&acc)[2][2][4][2], const pg8::Unit& u, int wr, int wc, int fr, int fq) const {
        float rs8[2][4];
#pragma unroll
        for (int ai = 0; ai < 2; ++ai)
#pragma unroll
            for (int m = 0; m < 4; ++m) { const f32x4 q4 = *(const f32x4*)(rs + (size_t)(u.pm * 256 + ai * 128 + wr * 64 + m * 16 + fr) * 8); rs8[ai][m] = 1.f / sqrtf(((q4[0] + q4[1]) + (q4[2] + q4[3])) * (1.f / 256.f) + EPS); }
#pragma unroll
        for (int ai = 0; ai < 2; ++ai)
#pragma unroll
            for (int m = 0; m < 4; ++m) { const int r = u.pm * 256 + ai * 128 + wr * 64 + m * 16 + fr; const float sc = rs8[ai][m] * (ATTN_SCALE * 1.4426950408889634f); const int s = r & (SEQ - 1);
#pragma unroll
                for (int bj = 0; bj < 2; ++bj) { const int col0 = u.pn * 256 + bj * 128 + wc * 32 + 8 * fq, hh = col0 / 96, cw = col0 - hh * 96;
                    f32x4 v0 = acc[ai][bj][m][0] * sc, v1 = acc[ai][bj][m][1] * sc; f32x4 p0, p1;
#pragma unroll
                    for (int i = 0; i < 4; ++i) { p0[i] = __shfl_xor(v0[i], 16); p1[i] = __shfl_xor(v1[i], 16); }
                    if (cw >= 64 && r < TL) { const int c2 = cw - 64, pos = (c2 & 16) ? (s & 63) : (s >> 6); const bool second = (c2 & 8) != 0; const float* tb = rope + pos * 16;
                        *(u32x4*)(QR + (size_t)r * 256 + hh * 32 + c2) = pg8::pack8(v0, v1);
                        const f32x4 cs0 = *(const f32x4*)tb, cs1 = *(const f32x4*)(tb + 4), sn0 = *(const f32x4*)(tb + 8), sn1 = *(const f32x4*)(tb + 12);
                        if (second) { v0 = v0 * cs0 + p0 * sn0; v1 = v1 * cs1 + p1 * sn1; } else { v0 = v0 * cs0 - p0 * sn0; v1 = v1 * cs1 - p1 * sn1; } }
                    *(u32x4*)(Q + (size_t)r * 768 + col0) = pg8::pack8(v0, v1); }
                asm volatile("" ::: "memory"); } } };
struct EpiKV { bf16_t* KV; const float* rs;
    __device__ __forceinline__ void operator()(const f32x4 (&acc)[2][2][4][2], const pg8::Unit& u, int wr, int wc, int fr, int fq) const {
        float rs8[2][4];
#pragma unroll
        for (int ai = 0; ai < 2; ++ai)
#pragma unroll
            for (int m = 0; m < 4; ++m) { const f32x4 q4 = *(const f32x4*)(rs + (size_t)(u.pm * 256 + ai * 128 + wr * 64 + m * 16 + fr) * 8 + 4); rs8[ai][m] = 1.f / sqrtf(((q4[0] + q4[1]) + (q4[2] + q4[3])) * (1.f / 128.f) + EPS); }
#pragma unroll
        for (int ai = 0; ai < 2; ++ai)
#pragma unroll
            for (int m = 0; m < 4; ++m) { const int r = u.pm * 256 + ai * 128 + wr * 64 + m * 16 + fr; const float sc = rs8[ai][m]; bf16_t* rowp = KV + (size_t)kvrow_of(r) * 1024 + u.pn * 256 + wc * 32 + 8 * fq;
#pragma unroll
                for (int bj = 0; bj < 2; ++bj) *(u32x4*)(rowp + bj * 128) = pg8::pack8(acc[ai][bj][m][0] * sc, acc[ai][bj][m][1] * sc);
                asm volatile("" ::: "memory"); } } };
struct EpiQKV { EpiKV ekv; EpiQ eq;
    __device__ __forceinline__ void operator()(const f32x4 (&acc)[2][2][4][2], const pg8::Unit& u, int wr, int wc, int fr, int fq) const { if (u.e == 0) ekv(acc, u, wr, wc, fr, fq); else eq(acc, u, wr, wc, fr, fq); } };
__device__ __forceinline__ void g23_phase(const Ctx& F0) {
    const Ctx F = fresh(F0);
    pg8::DualOrder S; S.A.init(TT, 1024, F.G, F.bid); S.B.init(TT, 768, F.G, F.bid); S.G = F.G; S.c = F.bid;
    const char* Abq = (const char*)(F.ws + WS_P);
    auto aoff = [&](const pg8::Unit& u) { return Abq + (size_t)(u.e == 0 ? OFF_KV * 2 : 0) + (size_t)u.pm * 256 * PW * 2; };
    const char* Wb = (const char*)(F.ws + WS_W);
    auto bptr = [&](const pg8::Unit& u) { return Wb + (size_t)(u.e == 0 ? W_WKV : W_WQ) + (size_t)u.pn * 256 * 256 * 2; };
    EpiQKV E{EpiKV{(bf16_t*)(F.ws + WS_KV), (const float*)(F.ws + WS_MISC + M_RS)}, EpiQ{(bf16_t*)(F.ws + WS_Q), (bf16_t*)(F.ws + WS_QR), (const float*)(F.ws + WS_MISC + M_RS), (const float*)(F.ws + WS_MISC + M_ROPE)}};
    pg8::gemm256<false>(F.lds, F.tid, Abq, PW * 2, 256, S, aoff, bptr, E);
}
struct EpiStore8 { unsigned char* O;
    __device__ __forceinline__ void operator()(const f32x4 (&acc)[2][2][4][2], const pg8::Unit& u, int wr, int wc, int fr, int fq) const {
        unsigned char* base = O + (size_t)(u.pm * 256 + wr * 64 + fr) * DM + u.pn * 256 + wc * 64 + 16 * fq;
#pragma unroll
        for (int ai = 0; ai < 2; ++ai)
#pragma unroll
            for (int m = 0; m < 4; ++m) { const u32x2 lo = pack8_fp8(acc[ai][0][m][0] * YB_SCALE, acc[ai][0][m][1] * YB_SCALE), hi = pack8_fp8(acc[ai][1][m][0] * YB_SCALE, acc[ai][1][m][1] * YB_SCALE);
                *(u32x4*)(base + (size_t)(ai * 128 + m * 16) * DM) = (u32x4){lo.x, lo.y, hi.x, hi.y};
                asm volatile("" ::: "memory"); } } };
__device__ __forceinline__ void g4_phase(const Ctx& F0, int nrows) {
    const Ctx F = fresh(F0);
    pg8::StaticOrder S; S.init(nrows, DM, F.G, F.bid);
    const char* Ab = (const char*)(F.ws + WS_MIX);
    auto aoff = [&](const pg8::Unit& u) { return Ab + (size_t)u.pm * 256 * DM * 2; };
    const char* Bt = (const char*)(F.ws + WS_W + W_WO);
    auto bptr = [&](const pg8::Unit& u) { return Bt + (size_t)u.pn * 256 * DM * 2; };
    EpiStore8 E{(unsigned char*)(F.ws + WS_Y1)};
    pg8::gemm256<false>(F.lds, F.tid, Ab, DM * 2, DM, S, aoff, bptr, E);
}

constexpr int LDS_ET = 139264, LDS_TE = LDS_ET + 512, LDS_RT = LDS_TE + 3072;
static_assert(LDS_RT + 8192 <= LDS_XB, "LDS tables");
__device__ __forceinline__ void expert_tables(const Ctx& F, int l, int nrows) {
    LAS int* tl = (LAS int*)(F.lds + LDS_ET); LAS int* cnt = tl + 64; LAS int* te = (LAS int*)(F.lds + LDS_TE);
    if (F.tid == 0) { int acc = 0;
        for (int e = 0; e < 33; ++e) { const int c = e < 32 ? (int)__hip_atomic_load(((unsigned*)(F.ws + WS_CTL)) + CW_GCNT + l * 64 + e, __ATOMIC_RELAXED, __HIP_MEMORY_SCOPE_AGENT) : nrows; cnt[e] = c; tl[e] = acc; acc += (c + 255) / 256; }
        tl[33] = acc; }
    __syncthreads();
    const int nmt = tl[33];
    for (int mt = F.tid; mt < nmt && mt < 768; mt += NTHR) { int e = 0; while (e < 32 && mt >= tl[e + 1]) ++e; te[mt] = e; }
    __syncthreads();
}
struct EpiGU { bf16_t* HB;
    __device__ __forceinline__ void operator()(const f32x4 (&acc)[2][2][4][2], const pg8::Unit& u, int wr, int wc, int fr, int fq) const {
#pragma unroll
        for (int ai = 0; ai < 2; ++ai)
#pragma unroll
            for (int m = 0; m < 4; ++m) { const int rl = ai * 128 + wr * 64 + m * 16 + fr;
                if (rl < u.nvalid) { f32x4 h0, h1;
#pragma unroll
                    for (int i = 0; i < 4; ++i) { h0[i] = silu(acc[ai][0][m][0][i]) * acc[ai][1][m][0][i]; h1[i] = silu(acc[ai][0][m][1][i]) * acc[ai][1][m][1][i]; }
                    *(u32x4*)(HB + (size_t)(u.base + u.pm * 256 + rl) * 256 + u.pn * 128 + wc * 32 + 8 * fq) = pg8::pack8(h0, h1); }
                asm volatile("" ::: "memory"); } } };
__device__ __forceinline__ void g5_phase(const Ctx& F0, int l, int nrows) {
    const Ctx F = fresh(F0);
    expert_tables(F, l, nrows);
    const LAS int* tl = (const LAS int*)(F.lds + LDS_ET); const LAS int* cnt = tl + 64;
    pg8::ExpertOrder S; S.init(tl, cnt, (const LAS int*)(F.lds + LDS_TE), 2, F.G, F.bid);
    const int* list = (const int*)(F.ws + WS_MISC + M_LIST);
    LAS unsigned* rowtab = (LAS unsigned*)(F.lds + LDS_RT);
    { pg8::Unit u;
      for (int i = 0; i < 8 && S.next(i, u); ++i) if (F.tid < 256) { int r = u.pm * 256 + F.tid; const int lastv = u.pm * 256 + u.nvalid - 1; r = r < lastv ? r : lastv;
          const int tok = u.e < 32 ? list[(size_t)u.e * TT + r] : r; rowtab[i * 256 + F.tid] = (unsigned)tok * (unsigned)(DM * 2); }
      __syncthreads(); }
    auto aoff = [&](const pg8::Unit& u, int R) { return rowtab[(u.idx & 7) * 256 + R]; };
    const char* Bt = (const char*)(F.ws + WS_W + W_WGU);
    auto bptr = [&](const pg8::Unit& u) { return Bt + ((size_t)u.e * 512 + (size_t)u.pn * 256) * DM * 2; };
    EpiGU E{(bf16_t*)(F.ws + WS_HB)};
    pg8::gemm256<true>(F.lds, F.tid, (const char*)(F.ws + WS_H), DM * 2, DM, S, aoff, bptr, E);
}
struct EpiD { unsigned char* YB; unsigned char* YS8; const float* listw;
    __device__ __forceinline__ void operator()(const f32x4 (&acc)[2][2][4][2], const pg8::Unit& u, int wr, int wc, int fr, int fq) const {
        float g8[2][4];
#pragma unroll
        for (int ai = 0; ai < 2; ++ai)
#pragma unroll
            for (int m = 0; m < 4; ++m) { const int rl = ai * 128 + wr * 64 + m * 16 + fr; g8[ai][m] = (u.e < 32 && rl < u.nvalid) ? listw[(size_t)u.e * TT + u.pm * 256 + rl] : 1.f; }
#pragma unroll
        for (int ai = 0; ai < 2; ++ai)
#pragma unroll
            for (int m = 0; m < 4; ++m) { const int rl = ai * 128 + wr * 64 + m * 16 + fr;
                if (rl < u.nvalid) { const int i = u.pm * 256 + rl; const int co = u.pn * 256 + wc * 64 + 16 * fq;
                    if (u.e < 32) { const float g = g8[ai][m] * YB_SCALE; const u32x2 lo = pack8_fp8(acc[ai][0][m][0] * g, acc[ai][0][m][1] * g), hi = pack8_fp8(acc[ai][1][m][0] * g, acc[ai][1][m][1] * g);
                        *(u32x4*)(YB + (size_t)(u.base + i) * DM + co) = (u32x4){lo.x, lo.y, hi.x, hi.y}; }
                    else { const u32x2 lo = pack8_fp8(acc[ai][0][m][0] * YB_SCALE, acc[ai][0][m][1] * YB_SCALE), hi = pack8_fp8(acc[ai][1][m][0] * YB_SCALE, acc[ai][1][m][1] * YB_SCALE);
                        *(u32x4*)(YS8 + (size_t)i * DM + co) = (u32x4){lo.x, lo.y, hi.x, hi.y}; } }
                asm volatile("" ::: "memory"); } } };
__device__ __forceinline__ void g6_phase(const Ctx& F0, int l, int nrows) {
    const Ctx F = fresh(F0);
    expert_tables(F, l, nrows);
    const LAS int* tl = (const LAS int*)(F.lds + LDS_ET); const LAS int* cnt = tl + 64;
    pg8::ExpertOrder S; S.init(tl, cnt, (const LAS int*)(F.lds + LDS_TE), 4, F.G, F.bid);
    const char* Ab = (const char*)(F.ws + WS_HB);
    auto aoff = [&](const pg8::Unit& u) { return Ab + (size_t)(u.base + u.pm * 256) * 512; };
    const char* Bt = (const char*)(F.ws + WS_W + W_WD);
    auto bptr = [&](const pg8::Unit& u) { return Bt + ((size_t)u.e * DM + (size_t)u.pn * 256) * 256 * 2; };
    EpiD E{(unsigned char*)(F.ws + WS_YB), (unsigned char*)(F.ws + WS_YS8), (const float*)(F.ws + WS_MISC + M_LISTW)};
    pg8::gemm256<false>(F.lds, F.tid, Ab, 512, 256, S, aoff, bptr, E);
}

namespace att2 {
typedef float f32x16 __attribute__((ext_vector_type(16)));
typedef short s16x4 __attribute__((ext_vector_type(4)));
constexpr int NW = 8, QBLK = 32, QB = 256, KVBLK = 64;
__device__ __forceinline__ int crow(int r, int hi) { return (r & 3) + 8 * (r >> 2) + 4 * hi; }
#define SBAR() __builtin_amdgcn_sched_barrier(0)
constexpr int SLOTB = 8192, RSLOTB = 4096;
constexpr int LDS_K = 0, LDS_V = 4 * SLOTB, LDS_R = 8 * SLOTB, LDS_WS = LDS_R + 4 * RSLOTB, LDS_OST = LDS_WS + NW * 64 * 4, LDS_BYTES_ATT = LDS_OST + NW * 4096;
static_assert(LDS_BYTES_ATT <= 131072, "attention LDS");
__device__ __forceinline__ void glds16s(const void* sbase, unsigned voff, unsigned lds_dst) { unsigned keep;
  asm volatile("s_mov_b32 %0, m0\n\ts_mov_b32 m0, %3\n\ts_nop 0\n\tglobal_load_lds_dwordx4 %1, %2\n\ts_mov_b32 m0, %0" : "=&s"(keep) : "v"(voff), "s"(sbase), "s"(lds_dst) : "memory"); }
__device__ __forceinline__ float max3f(float a, float b, float c) { float r; asm("v_max3_f32 %0, %1, %2, %3" : "=v"(r) : "v"(a), "v"(b), "v"(c)); return r; }
__device__ __forceinline__ float max2f(float a, float b) { float r; asm("v_max_f32_e32 %0, %1, %2" : "=v"(r) : "v"(a), "v"(b)); return r; }
__device__ __forceinline__ float fadd_s(float a, float b) { float r; asm("v_add_f32_e32 %0, %1, %2" : "=v"(r) : "v"(a), "v"(b)); return r; }
__device__ __forceinline__ float fsub_s(float a, float b) { float r; asm("v_sub_f32_e32 %0, %1, %2" : "=v"(r) : "v"(a), "v"(b)); return r; }
typedef float f32x2_t __attribute__((ext_vector_type(2))); typedef __bf16 bf16x2_t __attribute__((ext_vector_type(2)));
__device__ __forceinline__ unsigned cvtpk_s(float lo, float hi) { f32x2_t v = {lo, hi}; bf16x2_t b = __builtin_convertvector(v, bf16x2_t); return __builtin_bit_cast(unsigned, b); }
#define WAIT_BAR(N) asm volatile("s_waitcnt vmcnt(" #N ") lgkmcnt(0)\n\ts_barrier" ::: "memory")
#define WAIT_T() do { if (wid < 4) { WAIT_BAR(3); } else { WAIT_BAR(2); } } while (0)
typedef __attribute__((address_space(3))) const char* lds_cptr;
typedef short v4i16_t __attribute__((ext_vector_type(4)));
#define LDSF(p) (*(const __attribute__((address_space(3))) bf16x8*)(p))
#define KFRAG(kp, rp, j) ((j) < 8 ? LDSF((kp) + ((j) >> 1) * 2048 + ((j) & 1) * 512) : LDSF((rp) + (((j) - 8) >> 1) * 2048 + ((j) & 1) * 512))
__device__ __forceinline__ void qkt0(f32x16& p0, f32x16& p1, lds_cptr kp, lds_cptr rp, const bf16x8* qr, const f32x16& negm) {
#pragma unroll
  for (int d0 = 0; d0 < 6; ++d0) {
    const bf16x8 b0 = KFRAG(kp, rp, 2 * d0), b1 = KFRAG(kp, rp, 2 * d0 + 1);
    if (d0 == 0) { p0 = __builtin_amdgcn_mfma_f32_32x32x16_bf16(b0, qr[0], negm, 0, 0, 0); p1 = __builtin_amdgcn_mfma_f32_32x32x16_bf16(b1, qr[0], negm, 0, 0, 0); }
    else { p0 = __builtin_amdgcn_mfma_f32_32x32x16_bf16(b0, qr[d0], p0, 0, 0, 0); p1 = __builtin_amdgcn_mfma_f32_32x32x16_bf16(b1, qr[d0], p1, 0, 0, 0); } }
}
__device__ __forceinline__ s16x4 vtr(lds_cptr p) { return __builtin_bit_cast(s16x4, __builtin_amdgcn_ds_read_tr16_b64_v4i16((__attribute__((address_space(3))) v4i16_t*)p)); }
__device__ __forceinline__ float rowmax(const f32x16& p0, const f32x16& p1) {
  float a = max3f(p0[0], p0[1], p1[0]), b = max3f(p0[2], p0[3], p1[1]); a = max3f(a, p1[2], p1[3]);
#pragma unroll
  for (int r = 4; r < 16; r += 4) { a = max3f(a, p0[r], p0[r + 1]); b = max3f(b, p0[r + 2], p0[r + 3]); a = max3f(a, p1[r], p1[r + 1]); b = max3f(b, p1[r + 2], p1[r + 3]); }
  const float m = max2f(a, b);
  auto rr = __builtin_amdgcn_permlane32_swap(__float_as_uint(m), __float_as_uint(m), false, false);
  return max2f(__uint_as_float(rr[0]), __uint_as_float(rr[1]));
}
__device__ __forceinline__ void pv(f32x16* o, int vb, bf16x8 pa0, bf16x8 pa1, bf16x8 pa2, bf16x8 pa3) {
#pragma unroll
  for (int d0 = 0; d0 < 2; ++d0) { s16x4 lo[4], hi[4];
#pragma unroll
    for (int ks = 0; ks < 4; ++ks) {
      asm volatile("ds_read_b64_tr_b16 %0,%1 offset:%c2" : "=&v"(lo[ks]) : "v"(vb), "i"(d0 * 4096 + ks * 1024) : "memory");
      asm volatile("ds_read_b64_tr_b16 %0,%1 offset:%c2" : "=&v"(hi[ks]) : "v"(vb), "i"(d0 * 4096 + ks * 1024 + 512) : "memory"); }
    asm volatile("s_waitcnt lgkmcnt(0)" ::: "memory"); SBAR();
#define PK(k) (bf16x8){lo[k][0], lo[k][1], lo[k][2], lo[k][3], hi[k][0], hi[k][1], hi[k][2], hi[k][3]}
    o[d0] = __builtin_amdgcn_mfma_f32_32x32x16_bf16(pa0, PK(0), o[d0], 0, 0, 0);
    o[d0] = __builtin_amdgcn_mfma_f32_32x32x16_bf16(pa1, PK(1), o[d0], 0, 0, 0);
    o[d0] = __builtin_amdgcn_mfma_f32_32x32x16_bf16(pa2, PK(2), o[d0], 0, 0, 0);
    o[d0] = __builtin_amdgcn_mfma_f32_32x32x16_bf16(pa3, PK(3), o[d0], 0, 0, 0);
#undef PK
  }
}
template <int THRL, unsigned VAR = 0u> __device__ __forceinline__ void attn_unit(const bf16_t* Q, const bf16_t* QRb, const bf16_t* __restrict__ KV, const bf16_t* __restrict__ KR, bf16_t* O,
                                                             int qrow0, int h, int kvb, int NT, int NRAW, char* shm, int tid) {
  const int lane = tid & 63, r32 = lane & 31, hi = lane >> 5; const int wid = __builtin_amdgcn_readfirstlane(tid >> 6);
  const bf16_t* Qw = Q + (size_t)(qrow0 + wid * QBLK) * 768 + h * 96;
  const bf16_t* Kh = KV + (size_t)kvb * 1024 + h * 128; const bf16_t* Rh = KR + (size_t)kvb * 32;
  const unsigned lds0 = (unsigned)(uintptr_t)shm;
  float* wsf = (float*)(shm + LDS_WS) + wid * 64;
  const unsigned koff = (unsigned)(lane * 1024 + wid * 8) * 2u, voff = (unsigned)((16 * (wid & 3) + (lane >> 2)) * 1024 + 64 + (wid >> 2) * 32 + (lane & 3) * 8) * 2u, roff = (unsigned)(lane * 32 + (wid & 3) * 8) * 2u;
  const unsigned kdst = lds0 + LDS_K + wid * 1024, vdst = lds0 + LDS_V + wid * 1024, rdst = lds0 + LDS_R + (wid & 3) * 1024;
#define DMA_T(t) do { const char* kb_ = (const char*)Kh + (size_t)(t) * (KVBLK * 2048); const char* rb_ = (const char*)Rh + (size_t)(t) * (KVBLK * 64); \
                      glds16s(kb_, koff, (unsigned)__builtin_amdgcn_readfirstlane(kdst + ((t) & 3) * SLOTB)); \
                      if (wid < 4) glds16s(rb_, roff, (unsigned)__builtin_amdgcn_readfirstlane(rdst + ((t) & 3) * RSLOTB)); \
                      glds16s(kb_, voff, (unsigned)__builtin_amdgcn_readfirstlane(vdst + ((t) & 3) * SLOTB)); } while (0)
  const int vb0 = (int)(lds0 + LDS_V) + ((lane >> 4) & 1) * 32 + (lane & 3) * 8 + (4 * hi + ((lane & 15) >> 2)) * 64;
  const lds_cptr shm3 = (lds_cptr)shm; const lds_cptr kp0 = shm3 + LDS_K + hi * 1024 + r32 * 16; const lds_cptr rp0 = shm3 + LDS_R + hi * 1024 + r32 * 16;
  const lds_cptr vp0 = shm3 + LDS_V + ((lane >> 4) & 1) * 32 + (lane & 3) * 8 + (4 * hi + ((lane & 15) >> 2)) * 64;
  bf16x8 qr[6];
#pragma unroll
  for (int d0 = 0; d0 < 4; ++d0) qr[d0] = *reinterpret_cast<const bf16x8*>(&Qw[(size_t)r32 * 768 + d0 * 16 + hi * 8]);
  { const bf16_t* qp = NRAW > 0 ? QRb + (size_t)(qrow0 + wid * QBLK + r32) * 256 + h * 32 + hi * 8 : Qw + (size_t)r32 * 768 + 64 + hi * 8;
    qr[4] = *reinterpret_cast<const bf16x8*>(qp); qr[5] = *reinterpret_cast<const bf16x8*>(qp + 16); }
  const lds_cptr qp0 = shm3 + LDS_OST + wid * 4096 + lane * 16;
#pragma unroll
  for (int d0 = 0; d0 < 4; ++d0) *(__attribute__((address_space(3))) bf16x8*)(shm3 + LDS_OST + wid * 4096 + lane * 16 + d0 * 1024) = qr[d0];
#define QF(d0) LDSF(qp0 + (d0) * 1024)
  DMA_T(0); DMA_T(1);
  float mhat = 0.f, l_reg = 0.f; f32x16 o[2], negm; { float z0 = 0.f; asm volatile("" : "+v"(z0));
#pragma unroll
    for (int r = 0; r < 16; ++r) { o[0][r] = z0; o[1][r] = z0; negm[r] = z0; } }
  asm volatile("" : "+v"(negm));
  bool resc = false;
#define START(P0, P1) do { const float rm = rowmax(P0, P1); resc = false; \
    { const float dl = rm; mhat = fadd_s(mhat, dl); \
      _Pragma("unroll") for (int r = 0; r < 16; ++r) { P0[r] = fsub_s(P0[r], dl); P1[r] = fsub_s(P1[r], dl); } \
      _Pragma("unroll") for (int r = 0; r < 16; ++r) negm[r] = -mhat; asm volatile("" : "+v"(negm)); } \
    _Pragma("unroll") for (int r = 0; r < 16; ++r) P0[r] = __builtin_amdgcn_exp2f(P0[r]); } while (0)
#define RESC() do { if (resc) { asm volatile("s_waitcnt lgkmcnt(0)" ::: "memory"); \
      _Pragma("unroll") for (int d_ = 0; d_ < 2; ++d_) _Pragma("unroll") for (int r = 0; r < 16; ++r) o[d_][r] *= wsf[crow(r, hi)]; } } while (0)
  f32x16 pA0, pA1, pB0, pB1;
  WAIT_T();
  qkt0(pA0, pA1, kp0, rp0, qr, negm); asm volatile("s_nop 15\n\ts_nop 7" : "+v"(pA0), "+v"(pA1));
  START(pA0, pA1);
  _Pragma("unroll") for (int r = 0; r < 16; ++r) pA1[r] = __builtin_amdgcn_exp2f(pA1[r]);
  DMA_T(2);
  WAIT_T();
  s16x4 vl0, vh0, vl1, vh1, vl2, vh2, vl3, vh3; u32x4 pw0, pw1, pw2, pw3; bf16x8 fa, fb, fc, fd;
#define PKW(P, B) cvtpk_s(P[B], P[B + 1])
#define PAF(k) __builtin_bit_cast(bf16x8, pw##k)
#define VFS(s) (bf16x8){vl##s[0], vl##s[1], vl##s[2], vl##s[3], vh##s[0], vh##s[1], vh##s[2], vh##s[3]}
#define PIN(x) asm volatile("" : "+v"(x))
#define MX3(a, b, c) __builtin_fmaxf(__builtin_fmaxf((a), (b)), (c))
#define GAPA(MF, A0, A1, A2, A3, W0, W1, PW) do { MF; if constexpr (!(VAR & 4u)) { sacc += A0; sacc += A1; sacc += A2; sacc += A3; PIN(sacc); W0; W1; PIN(PW); } SBAR(); } while (0)
#define GAPR(MF) do { MF; SBAR(); } while (0)
#define EX(v) ((VAR & 2u) ? (v) : __builtin_amdgcn_exp2f(v))
#define GAPB(MF, X, B) do { MF; X[B] = EX(X[B]); X[B + 1] = EX(X[B + 1]); X[B + 2] = EX(X[B + 2]); X[B + 3] = EX(X[B + 3]); PIN(X); SBAR(); } while (0)
#define VRD(s, i) do { vl##s = vtr(vp_ + (((i) >> 2) * 4096 + ((i) & 3) * 1024)); vh##s = vtr(vp_ + (((i) >> 2) * 4096 + ((i) & 3) * 1024 + 512)); } while (0)
#define MF32(A, B, C) ((VAR & 16u) ? (C) : __builtin_amdgcn_mfma_f32_32x32x16_bf16(A, B, C, 0, 0, 0))
#define STEP(C0, C1, P0, P1, t, GD) do { SBAR(); \
    const lds_cptr vp_ = vp0 + (((t) - 1) & 3) * SLOTB; const lds_cptr kp_ = kp0 + ((t) & 3) * SLOTB; const lds_cptr rp_ = rp0 + ((t) & 3) * RSLOTB; \
    fa = KFRAG(kp_, rp_, 0); fb = KFRAG(kp_, rp_, 1); fc = KFRAG(kp_, rp_, 2); fd = KFRAG(kp_, rp_, 3); \
    VRD(0, 0); SBAR(); float sacc = (P0[0] + P0[1]); \
    GAPA(C0 = MF32(fa, qr[0], negm), P0[2], P0[3], P0[4], P0[5],     pw0[0] = PKW(P0, 0), pw0[1] = PKW(P0, 2), pw0); fa = KFRAG(kp_, rp_, 4); \
    VRD(1, 4); SBAR(); GAPA(C1 = MF32(fb, qr[0], negm), P0[6], P0[7], P0[8], P0[9],     pw0[2] = PKW(P0, 4), pw0[3] = PKW(P0, 6), pw0); fb = KFRAG(kp_, rp_, 5); \
    VRD(2, 1); SBAR(); GAPA(C0 = MF32(fc, qr[1], C0),   P0[10], P0[11], P0[12], P0[13], pw1[0] = PKW(P0, 8), pw1[1] = PKW(P0, 10), pw1); fc = KFRAG(kp_, rp_, 6); \
    VRD(3, 5); SBAR(); GAPA(C1 = MF32(fd, qr[1], C1),   P0[14], P0[15], P1[0], P1[1],   pw1[2] = PKW(P0, 12), pw1[3] = PKW(P0, 14), pw1); fd = KFRAG(kp_, rp_, 7); \
    SBAR(); GAPA(C0 = MF32(fa, qr[2], C0),   P1[2], P1[3], P1[4], P1[5],     pw2[0] = PKW(P1, 0), pw2[1] = PKW(P1, 2), pw2); fa = KFRAG(kp_, rp_, 8); \
    SBAR(); GAPA(C1 = MF32(fb, qr[2], C1),   P1[6], P1[7], P1[8], P1[9],     pw2[2] = PKW(P1, 4), pw2[3] = PKW(P1, 6), pw2); fb = KFRAG(kp_, rp_, 9); \
    SBAR(); GAPA(C0 = MF32(fc, qr[3], C0),   P1[10], P1[11], P1[12], P1[13], pw3[0] = PKW(P1, 8), pw3[1] = PKW(P1, 10), pw3); fc = KFRAG(kp_, rp_, 10); \
    SBAR(); GAPA(C1 = MF32(fd, qr[3], C1),   P1[14], P1[15], 0.f, 0.f,       pw3[2] = PKW(P1, 12), pw3[3] = PKW(P1, 14), pw3); fd = KFRAG(kp_, rp_, 11); \
    SBAR(); GAPR(C0 = MF32(fa, qr[4], C0)); GAPR(C1 = MF32(fb, qr[4], C1)); GAPR(C0 = MF32(fc, qr[5], C0)); GAPR(C1 = MF32(fd, qr[5], C1)); \
    l_reg += sacc; \
    if constexpr (!(VAR & 1u)) { if (GD) { DMA_T((t) + 2); } } \
    { float a = MX3(C0[0], C0[1], C1[0]), b = MX3(C0[2], C0[3], C1[1]); a = MX3(a, C1[2], C1[3]); \
      _Pragma("unroll") for (int r = 4; r < 16; r += 4) { a = MX3(a, C0[r], C0[r + 1]); b = MX3(b, C0[r + 2], C0[r + 3]); a = MX3(a, C1[r], C1[r + 1]); b = MX3(b, C1[r + 2], C1[r + 3]); } \
      float rm = __builtin_fmaxf(a, b); { auto rr = __builtin_amdgcn_permlane32_swap(__float_as_uint(rm), __float_as_uint(rm), false, false); rm = __builtin_fmaxf(__uint_as_float(rr[0]), __uint_as_float(rr[1])); } \
      resc = false; \
      if (__builtin_expect(__any(rm > (float)THRL), 0)) { const float dl = __builtin_fmaxf(rm, 0.f); mhat += dl; \
        _Pragma("unroll") for (int r = 0; r < 16; ++r) { C0[r] -= dl; C1[r] -= dl; } \
        _Pragma("unroll") for (int r = 0; r < 16; ++r) negm[r] = -mhat; asm volatile("" : "+v"(negm)); \
        const float f = __builtin_amdgcn_exp2f(-dl); l_reg *= f; if (hi == 0) wsf[r32] = f; resc = true; } } \
    SBAR(); \
    GAPB(o[0] = MF32(PAF(0), VFS(0), o[0]), C0, 0); \
    GAPB(o[1] = MF32(PAF(0), VFS(1), o[1]), C0, 4); VRD(0, 2); VRD(1, 6); SBAR(); \
    GAPB(o[0] = MF32(PAF(1), VFS(2), o[0]), C0, 8); \
    GAPB(o[1] = MF32(PAF(1), VFS(3), o[1]), C0, 12); VRD(2, 3); VRD(3, 7); SBAR(); \
    GAPB(o[0] = MF32(PAF(2), VFS(0), o[0]), C1, 0); \
    GAPB(o[1] = MF32(PAF(2), VFS(1), o[1]), C1, 4); \
    GAPB(o[0] = MF32(PAF(3), VFS(2), o[0]), C1, 8); \
    GAPB(o[1] = MF32(PAF(3), VFS(3), o[1]), C1, 12); \
    } while (0)
#define QSW(tt) do { if ((tt) == NRAW) { qr[4] = *reinterpret_cast<const bf16x8*>(&Qw[(size_t)r32 * 768 + 64 + hi * 8]); qr[5] = *reinterpret_cast<const bf16x8*>(&Qw[(size_t)r32 * 768 + 80 + hi * 8]); } } while (0)
#define ENDW(tt) do { if ((tt) + 2 < NT) { WAIT_T(); } else { WAIT_BAR(0); } } while (0)
  int t = 1;
  for (; t + 3 < NT; t += 2) {
    STEP(pB0, pB1, pA0, pA1, t, true);     if constexpr (VAR & 8u) { asm volatile("s_waitcnt vmcnt(3) lgkmcnt(0)" ::: "memory"); } else { WAIT_T(); } RESC(); QSW(t + 1);
    STEP(pA0, pA1, pB0, pB1, t + 1, true); if constexpr (VAR & 8u) { asm volatile("s_waitcnt vmcnt(3) lgkmcnt(0)" ::: "memory"); } else { WAIT_T(); } RESC(); QSW(t + 2);
  }
  for (; t + 1 < NT; t += 2) {
    STEP(pB0, pB1, pA0, pA1, t, (t + 2 < NT));     ENDW(t);     RESC(); QSW(t + 1);
    STEP(pA0, pA1, pB0, pB1, t + 1, (t + 3 < NT)); ENDW(t + 1); RESC(); QSW(t + 2);
  }
  STEP(pB0, pB1, pA0, pA1, NT - 1, false); WAIT_BAR(0); RESC();
  { float sacc = pB0[0] + pB0[1]; _Pragma("unroll") for (int r = 2; r < 16; ++r) sacc += pB0[r]; _Pragma("unroll") for (int r = 0; r < 16; ++r) sacc += pB1[r]; l_reg += sacc;
    pw0 = (u32x4){PKW(pB0, 0), PKW(pB0, 2), PKW(pB0, 4), PKW(pB0, 6)}; pw1 = (u32x4){PKW(pB0, 8), PKW(pB0, 10), PKW(pB0, 12), PKW(pB0, 14)}; pw2 = (u32x4){PKW(pB1, 0), PKW(pB1, 2), PKW(pB1, 4), PKW(pB1, 6)}; pw3 = (u32x4){PKW(pB1, 8), PKW(pB1, 10), PKW(pB1, 12), PKW(pB1, 14)};
    SBAR(); pv(o, vb0 + ((NT - 1) & 3) * SLOTB, PAF(0), PAF(1), PAF(2), PAF(3)); }
#undef PKW
#undef PAF
#undef VFS
#undef PIN
#undef MX3
#undef GAPA
#undef GAPR
#undef GAPB
#undef EX
#undef VRD
#undef MF32
#undef STEP
#undef ENDW
#undef QSW
  { auto rr = __builtin_amdgcn_permlane32_swap(__float_as_uint(l_reg), __float_as_uint(l_reg), false, false); l_reg = __uint_as_float(rr[0]) + __uint_as_float(rr[1]); }
  if (hi == 0) wsf[32 + r32] = l_reg; asm volatile("s_waitcnt lgkmcnt(0)" ::: "memory");
  float rli[16];
#pragma unroll
  for (int r = 0; r < 16; ++r) rli[r] = __builtin_amdgcn_rcpf(wsf[32 + crow(r, hi)]);
  bf16_t* Ow = O + (size_t)(qrow0 + wid * QBLK) * DM + h * 64;
  { bf16_t* stg = (bf16_t*)(shm + LDS_OST) + wid * 2048;
#pragma unroll
    for (int r = 0; r < 16; ++r) { const int orow = crow(r, hi);
#pragma unroll
      for (int d0 = 0; d0 < 2; ++d0) stg[orow * 64 + d0 * 32 + r32] = (bf16_t)f2bf(o[d0][r] * rli[r]); }
    asm volatile("s_waitcnt lgkmcnt(0)" ::: "memory");
#pragma unroll
    for (int i = 0; i < 4; ++i) { const int row = i * 8 + (lane >> 3), ch = lane & 7; const u32x4 v = *(const u32x4*)(stg + row * 64 + ch * 8); *(u32x4*)(Ow + (size_t)row * DM + ch * 8) = v; } }
  asm volatile("s_waitcnt vmcnt(0) lgkmcnt(0)\n\ts_barrier" ::: "memory");
#undef DMA_T
#undef START
#undef RESC
#undef QF
}
#undef SBAR
#undef WAIT_BAR
#undef WAIT_T
#undef LDSF
#undef KFRAG
}
template <unsigned VAR = 0u> __device__ __forceinline__ void attn_mfma_phase(const Ctx& F0, bool with_ctx_queries) {
    const Ctx F = fresh(F0);
    const bf16_t* Qp = (const bf16_t*)(F.ws + WS_Q); const bf16_t* QRp = (const bf16_t*)(F.ws + WS_QR); const bf16_t* KVp = (const bf16_t*)(F.ws + WS_KV); const bf16_t* KRp = (const bf16_t*)(F.ws + WS_KR);
    bf16_t* Op = (bf16_t*)(F.ws + WS_MIX);
    char* shm = (char*)(unsigned char*)F.lds;
    const int xg = F.bid & 7, slot = F.bid >> 3;
    if (F.G == 256) {
        for (int i = 0; i < 4; ++i) { const int bh = 8 * i + xg, b = bh >> 3, h = bh & 7;
            att2::attn_unit<8, VAR>(Qp, QRp, KVp, KRp, Op, b * SEQ + slot * 256, h, b * KVS, KVS / 64, CTXL / 64, shm, F.tid); }
    } else {
        for (int u = F.bid; u < 1024; u += F.G) { const int bh = u >> 5, b = bh >> 3, h = bh & 7;
            att2::attn_unit<8, VAR>(Qp, QRp, KVp, KRp, Op, b * SEQ + (u & 31) * 256, h, b * KVS, KVS / 64, CTXL / 64, shm, F.tid); }
    }
    if (with_ctx_queries) for (int u = F.bid; u < 32; u += F.G) { const int b = u >> 3, h = u & 7;
        att2::attn_unit<8, VAR>(Qp, QRp, KVp, KRp, Op, TL + b * CTXL, h, b * KVS, CTXL / 64, 0, shm, F.tid); }
    __syncthreads();
}

__device__ __forceinline__ void mixers_phase(const Ctx& F0, int l, int nrows, unsigned var = 0u) {
    const Ctx F = fresh(F0);
    LAS float* U = (LAS float*)F.lds;
    LAS float* Y = U + 62 * 256;
    const int c = F.tid & 255, hf = F.tid >> 8, tid = F.tid;
    const float* dwp = F.a->in[I_CDW] + (size_t)l * CONVK * 256 + c;
    float dw[CONVK];
#pragma unroll
    for (int k = 0; k < CONVK; ++k) dw[k] = dwp[k * 256];
    const float cb = F.a->in[I_CB][l * 256 + c];
    const bf16_t* Pp = (const bf16_t*)(F.ws + WS_P); bf16_t* MIXp = (bf16_t*)(F.ws + WS_MIX);
    const int nunits = nrows / 32, nfull = (nunits / F.G) * F.G, nrounds = (nunits + F.G - 1) / F.G;
    auto unit_of = [&](int i) { if (i * F.G < nfull) return i * F.G + F.bid; const int rem = nunits - nfull; if (F.G >= 64 && rem <= 32) return (F.bid >= 32 && F.bid < 32 + rem) ? nfull + F.bid - 32 : -1; const int u = i * F.G + F.bid; return u < nunits ? u : -1; };
    u32x4 ca[4], cg[4], pp[3];
    const u32x4 z4 = {0u, 0u, 0u, 0u};
#define MX_GEOM(u) const int r0 = (u) * 32; int rb, n; if (r0 < TL) { rb = r0 & ~(SEQ - 1); n = SEQ; } else { rb = TL + ((r0 - TL) & ~(CTXL - 1)); n = CTXL; } const int t0 = r0 - rb;
#define MX_ISSUE_CONV(u) do { MX_GEOM(u) _Pragma("unroll") for (int q = 0; q < 4; ++q) { const int i = tid + q * 512, tt = i >> 5, c8 = (i & 31) * 8, t = t0 - 15 + tt; ca[q] = z4; cg[q] = z4; \
        if (i < 62 * 32 && t >= 0 && t < n) { const bf16_t* p = Pp + (size_t)(rb + t) * PW + OFF_CONV + c8; ca[q] = *(const u32x4*)p; cg[q] = *(const u32x4*)(p + 256); } } } while (0)
#define MX_ISSUE_POOL(u) do { MX_GEOM(u) _Pragma("unroll") for (int q = 0; q < 3; ++q) { const int i = tid + q * 512, tt = i >> 5, c8 = (i & 31) * 8, t = t0 - 8 + tt; pp[q] = z4; \
        if (i < 47 * 32 && t >= 0 && t < n) pp[q] = *(const u32x4*)(Pp + (size_t)(rb + t) * PW + OFF_POOL + c8); } } while (0)
    int ucur = unit_of(0);
    if (ucur >= 0) { MX_ISSUE_CONV(ucur); MX_ISSUE_POOL(ucur); }
    for (int it = 0; it < nrounds; ++it) {
        if (ucur < 0) break;
        const int unext = (it + 1 < nrounds) ? unit_of(it + 1) : -1;
        MX_GEOM(ucur)
#pragma unroll
        for (int q = 0; q < 4; ++q) { const int i = tid + q * 512, tt = i >> 5, c8 = (i & 31) * 8;
            if (i < 62 * 32) { const unsigned aw[4] = {ca[q].x, ca[q].y, ca[q].z, ca[q].w}, gw[4] = {cg[q].x, cg[q].y, cg[q].z, cg[q].w}; float v[8];
#pragma unroll
                for (int x = 0; x < 4; ++x) { v[2 * x] = bf2f(aw[x] & 0xffffu) * sigm(bf2f(gw[x] & 0xffffu)); v[2 * x + 1] = bf2f(aw[x] >> 16) * sigm(bf2f(gw[x] >> 16)); }
                *(LAS f32x4*)(U + tt * 256 + c8) = (f32x4){v[0], v[1], v[2], v[3]}; *(LAS f32x4*)(U + tt * 256 + c8 + 4) = (f32x4){v[4], v[5], v[6], v[7]}; } }
        __syncthreads();
        if (unext >= 0) MX_ISSUE_CONV(unext);
        if (!(var & 1u)) { float acc[16];
#pragma unroll
          for (int j = 0; j < 16; ++j) acc[j] = cb;
#pragma unroll
          for (int i = 0; i < 46; ++i) { const float uv = U[(hf * 16 + i) * 256 + c];
#pragma unroll
              for (int j = 0; j < 16; ++j) if (i - j >= 0 && i - j < CONVK) acc[j] += uv * dw[i - j]; }
#pragma unroll
          for (int j = 0; j < 16; ++j) Y[(hf * 16 + j) * 256 + c] = acc[j]; }
        __syncthreads();
        if (!(var & 4u)) { const f32x4 gg = *(const f32x4*)(F.a->in[I_CLNG] + l * 256 + 4 * F.lane), bb = *(const f32x4*)(F.a->in[I_CLNB] + l * 256 + 4 * F.lane);
#pragma unroll
          for (int q = 0; q < 4; ++q) { const int tk = F.wave + 8 * q; f32x4 v = *(const LAS f32x4*)(Y + tk * 256 + 4 * F.lane);
              const float mean = wave_sum((v.x + v.y) + (v.z + v.w)) * (1.f / 256.f); v = v - mean;
              const float rstd = 1.f / sqrtf(wave_sum((v.x * v.x + v.y * v.y) + (v.z * v.z + v.w * v.w)) * (1.f / 256.f) + EPS);
              v = v * rstd * gg + bb; u32x2 o; o.x = pk2(silu(v.x), silu(v.y)); o.y = pk2(silu(v.z), silu(v.w));
              *(u32x2*)(MIXp + (size_t)(r0 + tk) * DM + 768 + 4 * F.lane) = o; } }
#pragma unroll
        for (int q = 0; q < 3; ++q) { const int i = tid + q * 512, tt = i >> 5, c8 = (i & 31) * 8;
            if (i < 47 * 32) { const unsigned aw[4] = {pp[q].x, pp[q].y, pp[q].z, pp[q].w};
                *(LAS f32x4*)(U + tt * 256 + c8) = (f32x4){bf2f(aw[0] & 0xffffu), bf2f(aw[0] >> 16), bf2f(aw[1] & 0xffffu), bf2f(aw[1] >> 16)};
                *(LAS f32x4*)(U + tt * 256 + c8 + 4) = (f32x4){bf2f(aw[2] & 0xffffu), bf2f(aw[2] >> 16), bf2f(aw[3] & 0xffffu), bf2f(aw[3] >> 16)}; } }
        __syncthreads();
        if (unext >= 0) MX_ISSUE_POOL(unext);
        if (!(var & 2u)) { const int c2 = (tid & 127) * 2, tq = tid >> 7;
          const int w = 2 << (c2 >> 6), lo = w >> 1, hi = w - 1 - lo; const int tl0 = tq * 8;
          const LAS float* up = U + (tl0 + 8) * 256 + c2;
          f32x2 sm = {0.f, 0.f};
          for (int d = -lo; d <= hi; ++d) sm = sm + *(const LAS f32x2*)(up + d * 256);
#pragma unroll
          for (int j = 0; j < 8; ++j) { const int t = t0 + tl0 + j; const int st = t - lo < 0 ? 0 : t - lo, en = t + hi + 1 > n ? n : t + hi + 1;
              const float rc = __builtin_amdgcn_rcpf((float)(en - st)); const f32x2 ctr = *(const LAS f32x2*)(up + j * 256);
              *(unsigned*)(MIXp + (size_t)(r0 + tl0 + j) * DM + 512 + c2) = pk2(sm.x * rc - ctr.x, sm.y * rc - ctr.y);
              if (j < 7) sm = sm + *(const LAS f32x2*)(up + (j + 1 + hi) * 256) - *(const LAS f32x2*)(up + (j - lo) * 256); } }
        __syncthreads();
        ucur = unext;
    }
#undef MX_GEOM
#undef MX_ISSUE_CONV
#undef MX_ISSUE_POOL
    __syncthreads();
}

constexpr int HS_LD = 1028;
__device__ __forceinline__ void r1_phase(const Ctx& F0, int l, int nrows, bool dry = false) {
    const Ctx F = fresh(F0);
    LAS float* Hs = (LAS float*)F.lds;
    LAS float* Part = (LAS float*)(F.lds + 65792);
    LAS float* Sc = (LAS float*)(F.lds + 82176);
    LAS int* lcount = (LAS int*)(F.lds + 84224); LAS int* gbase = lcount + 32; LAS int* tok_e = gbase + 32; LAS int* tok_r = tok_e + 136 * 4; LAS float* tok_w = (LAS float*)(tok_r + 136 * 4);
    const int lane = F.lane, w = F.wave, e = lane & 31;
    float Wm[32][2];
    { const float* rw = F.a->in[I_RW] + (size_t)l * DM * NE + (size_t)(128 * w + 32 * (lane >> 4)) * NE + (lane & 15);
#pragma unroll
      for (int s_ = 0; s_ < 32; ++s_) { Wm[s_][0] = rw[s_ * NE]; Wm[s_][1] = rw[s_ * NE + 16]; } }
    if (F.tid < 32) lcount[F.tid] = 0;
    __syncthreads();
    const int per = nrows / F.G, rbase = F.bid * per, nchunks = (per + 15) >> 4;
    const float bias_e = F.a->in[I_RB][l * NE + e];
    f32x4 zr[2][4]; u32x2 zb[2][4]; unsigned yr[2][4];
    bf16_t* const Zp = (bf16_t*)(F.ws + WS_Z);
#define R1_ISSUE(cc) do { _Pragma("unroll") for (int q = 0; q < 2; ++q) { const int i = (cc) * 16 + w * 2 + q; \
        if (i < per) { const int r = rbase + i; \
            const unsigned char* yin = ((const unsigned char*)(F.ws + WS_Y1)) + (size_t)r * DM; \
            if (l == 0) { const float* zin = r < TL ? F.a->in[I_X] + (size_t)r * DM : F.a->in[I_CTX] + (size_t)(r - TL) * DM; \
                _Pragma("unroll") for (int j = 0; j < 4; ++j) zr[q][j] = *(const f32x4*)(zin + 4 * lane + 256 * j); } \
            else { const bf16_t* zin = Zp + (size_t)r * DM; \
                _Pragma("unroll") for (int j = 0; j < 4; ++j) zb[q][j] = *(const u32x2*)(zin + 4 * lane + 256 * j); } \
            _Pragma("unroll") for (int j = 0; j < 4; ++j) yr[q][j] = *(const unsigned*)(yin + 4 * lane + 256 * j); } } } while (0)
    R1_ISSUE(0);
    for (int c = 0; c < nchunks; ++c) {
#pragma unroll
        for (int q = 0; q < 2; ++q) { const int i = c * 16 + w * 2 + q;
            if (i < per && !(dry && (DRYVAR & 4u))) { const int r = rbase + i;
                const float* md = ((float*)(F.ws + WS_MISC + M_MOD)) + ((size_t)l * 5 + batch_of(r)) * 6144;
                f32x4 z[4];
#pragma unroll
                for (int j = 0; j < 4; ++j) { const f32x2 ylo = __builtin_amdgcn_cvt_pk_f32_fp8((int)yr[q][j], false), yhi = __builtin_amdgcn_cvt_pk_f32_fp8((int)yr[q][j], true); const f32x4 y = (f32x4){ylo.x, ylo.y, yhi.x, yhi.y} * YB_INV;
                    const u32x2 zo = zb[q][j]; const f32x4 zv = (l == 0) ? zr[q][j] : (f32x4){bf2f(zo.x & 0xffffu), bf2f(zo.x >> 16), bf2f(zo.y & 0xffffu), bf2f(zo.y >> 16)};
                    const f32x4 g = *(const f32x4*)(md + 2048 + 4 * lane + 256 * j); z[j] = zv * ALPHA + g * y; }
                row_ln(z); row_affine(z, F.a->in[I_LN1G] + l * DM, F.a->in[I_LN1B] + l * DM, lane); if (!dry) row_store_bf(z, Zp + (size_t)r * DM, lane);
                row_ln(z); row_mod(z, md + 3072, md + 4096, lane); if (!dry) row_store_bf(z, ((bf16_t*)(F.ws + WS_H)) + (size_t)r * DM, lane);
#pragma unroll
                for (int j = 0; j < 4; ++j) *(LAS f32x4*)(Hs + (w * 2 + q) * HS_LD + 4 * lane + 256 * j) = z[j]; } }
        __syncthreads();
        if (c + 1 < nchunks) R1_ISSUE(c + 1);
        if (!(dry && (DRYVAR & 1u))) { f32x4 acc0 = {0.f, 0.f, 0.f, 0.f}, acc1 = {0.f, 0.f, 0.f, 0.f};
          const LAS float* hp = Hs + (lane & 15) * HS_LD + 128 * w + 32 * (lane >> 4);
#pragma unroll
          for (int s4 = 0; s4 < 8; ++s4) { const f32x4 hv = *(const LAS f32x4*)(hp + 4 * s4);
#pragma unroll
              for (int x = 0; x < 4; ++x) { acc0 = __builtin_amdgcn_mfma_f32_16x16x4f32(hv[x], Wm[4 * s4 + x][0], acc0, 0, 0, 0); acc1 = __builtin_amdgcn_mfma_f32_16x16x4f32(hv[x], Wm[4 * s4 + x][1], acc1, 0, 0, 0); } }
#pragma unroll
          for (int j = 0; j < 4; ++j) { const int row = 4 * (lane >> 4) + j; Part[(w * 16 + row) * 32 + (lane & 15)] = acc0[j]; Part[(w * 16 + row) * 32 + 16 + (lane & 15)] = acc1[j]; } }
        __syncthreads();
        { const int r16 = F.tid >> 5; float lg = 0.f;
#pragma unroll
          for (int w2 = 0; w2 < 8; ++w2) lg += Part[(w2 * 16 + r16) * 32 + e];
          Sc[r16 * 32 + e] = sigm(lg); }
        __syncthreads();
        if (!(dry && (DRYVAR & 2u))) { const int r16 = 2 * w + (lane >> 5), i = c * 16 + r16;
            const float sc = Sc[r16 * 32 + e], sel = sc + bias_e;
            const float m1 = max8(sel), m2 = max8(sel == m1 ? -INFINITY : sel), gs = m1 + m2;
            const float gA = dpp_f<DPP_RM>(gs);
            float t0, t1; t0 = swap16_f(gs, t1); const float gB = (lane & 16) ? t0 : t1; t0 = swap16_f(gA, t1); const float gC = (lane & 16) ? t0 : t1;
            const int g = e >> 3;
            const int rank = ((gA > gs || (gA == gs && (g ^ 1) < g)) ? 1 : 0) + ((gB > gs || (gB == gs && (g ^ 2) < g)) ? 1 : 0) + ((gC > gs || (gC == gs && (g ^ 3) < g)) ? 1 : 0);
            float cand = rank < 2 ? sel : -INFINITY;
            int ei[4]; float wv[4]; float wsum = 0.f;
#pragma unroll
            for (int k = 0; k < 4; ++k) { const float mx = max32(cand);
                const unsigned long long bal = __ballot(cand == mx); const unsigned hb = (lane & 32) ? (unsigned)(bal >> 32) : (unsigned)bal;
                const int widx = __ffs((int)hb) - 1; const bool win = (e == widx);
                const float wk = sum32(win ? sc : 0.f); cand = win ? -INFINITY : cand; ei[k] = widx; wv[k] = wk; wsum += wk; }
            if (e == 0 && i < per) {
#pragma unroll
                for (int k = 0; k < 4; ++k) { const int lr = __hip_atomic_fetch_add(lcount + ei[k], 1, __ATOMIC_RELAXED, __HIP_MEMORY_SCOPE_WORKGROUP); tok_e[i * 4 + k] = ei[k]; tok_r[i * 4 + k] = lr; tok_w[i * 4 + k] = wv[k] / wsum * ROUTED_SCALE; } }
        }
    }
#undef R1_ISSUE
    __syncthreads();
    if (dry) return;
    if (F.tid < 32) gbase[F.tid] = (int)atomicAdd(((unsigned*)(F.ws + WS_CTL)) + CW_GCNT + l * 64 + F.tid, (unsigned)lcount[F.tid]);
    __syncthreads();
    for (int i = F.tid; i < per * 4; i += NTHR) { const int ex = tok_e[i], rank = gbase[ex] + tok_r[i], r = rbase + (i >> 2);
        ((int*)(F.ws + WS_MISC + M_LIST))[(size_t)ex * TT + rank] = r; ((float*)(F.ws + WS_MISC + M_LISTW))[(size_t)ex * TT + rank] = tok_w[i]; ((int*)(F.ws + WS_MISC + M_SELE))[(size_t)r * 4 + (i & 3)] = ex; ((int*)(F.ws + WS_MISC + M_SELR))[(size_t)r * 4 + (i & 3)] = rank; }
    __syncthreads();
}

struct R2Raw { u32x2 z[4]; unsigned y[5][4]; };
__device__ __forceinline__ void r2_issue(R2Raw& w, const Ctx& F, const LAS int* tl, int r, int lane) {
    const bf16_t* zrow = ((const bf16_t*)(F.ws + WS_Z)) + (size_t)r * DM;
    const u32x4 ev = *(const u32x4*)(((int*)(F.ws + WS_MISC + M_SELE)) + (size_t)r * 4), rv = *(const u32x4*)(((int*)(F.ws + WS_MISC + M_SELR)) + (size_t)r * 4);
    const unsigned char* p0 = ((const unsigned char*)(F.ws + WS_YS8)) + (size_t)r * DM;
    const unsigned char* YB = (const unsigned char*)(F.ws + WS_YB);
    const unsigned char* p1 = YB + (size_t)(tl[ev.x] * 256 + (int)rv.x) * DM; const unsigned char* p2 = YB + (size_t)(tl[ev.y] * 256 + (int)rv.y) * DM;
    const unsigned char* p3 = YB + (size_t)(tl[ev.z] * 256 + (int)rv.z) * DM; const unsigned char* p4 = YB + (size_t)(tl[ev.w] * 256 + (int)rv.w) * DM;
#pragma unroll
    for (int j = 0; j < 4; ++j) { const int o = 4 * lane + 256 * j; w.z[j] = *(const u32x2*)(zrow + o); w.y[4][j] = *(const unsigned*)(p0 + o); w.y[0][j] = *(const unsigned*)(p1 + o); w.y[1][j] = *(const unsigned*)(p2 + o); w.y[2][j] = *(const unsigned*)(p3 + o); w.y[3][j] = *(const unsigned*)(p4 + o); }
}
__device__ __forceinline__ void r2_finish(const R2Raw& w, const Ctx& F, int l, int r, int lane, bool dry) {
    const bool last = (l == DEPTH - 1);
    const float* md = ((float*)(F.ws + WS_MISC + M_MOD)) + ((size_t)l * 5 + batch_of(r)) * 6144;
    f32x4 z[4];
#pragma unroll
    for (int j = 0; j < 4; ++j) { f32x4 yr = {0.f, 0.f, 0.f, 0.f};
#pragma unroll
        for (int q = 0; q < 5; ++q) { const f32x2 lo = __builtin_amdgcn_cvt_pk_f32_fp8((int)w.y[q][j], false), hi = __builtin_amdgcn_cvt_pk_f32_fp8((int)w.y[q][j], true); yr = yr + (f32x4){lo.x, lo.y, hi.x, hi.y}; }
        const f32x4 y = yr * YB_INV;
        const u32x2 zo = w.z[j]; const f32x4 zv = {bf2f(zo.x & 0xffffu), bf2f(zo.x >> 16), bf2f(zo.y & 0xffffu), bf2f(zo.y >> 16)};
        const f32x4 g = *(const f32x4*)(md + 5120 + 4 * lane + 256 * j); z[j] = zv * ALPHA + g * y; }
    row_ln(z); row_affine(z, F.a->in[I_LN2G] + l * DM, F.a->in[I_LN2B] + l * DM, lane);
    if (!dry) { if (last) row_store(z, F.out + (size_t)r * DM, lane); else row_store_bf(z, ((bf16_t*)(F.ws + WS_Z)) + (size_t)r * DM, lane); }
    if (!last) { const float* md2 = ((float*)(F.ws + WS_MISC + M_MOD)) + ((size_t)(l + 1) * 5 + batch_of(r)) * 6144; row_ln(z); row_mod(z, md2, md2 + 1024, lane); if (!dry) row_store_bf(z, ((bf16_t*)(F.ws + WS_H)) + (size_t)r * DM, lane); }
}
__device__ __forceinline__ void r2_phase(const Ctx& F0, int l, int nrows, bool dry = false) {
    const Ctx F = fresh(F0);
    expert_tables(F, l, nrows);
    const LAS int* tl = (const LAS int*)(F.lds + LDS_ET);
    const int gw = F.bid * NWAVES + F.wave, NGW = F.G * NWAVES, lane = F.lane;
    for (int r = gw; r < nrows; r += 2 * NGW) {
        const int r2 = r + NGW; const bool two = r2 < nrows;
        R2Raw a, b; r2_issue(a, F, tl, r, lane); r2_issue(b, F, tl, two ? r2 : r, lane);
        r2_finish(a, F, l, r, lane, dry); if (two) r2_finish(b, F, l, r2, lane, dry);
    }
}

constexpr int PH_PER_LAYER = 8, N_PHASES = 2 + DEPTH * PH_PER_LAYER;
__global__ void __launch_bounds__(NTHR, 2) fwd(Args args) {
    extern __shared__ __attribute__((aligned(16))) unsigned char lds_raw[];
    Ctx F;
    F.lds = (LAS unsigned char*)lds_raw; F.tid = threadIdx.x; F.lane = F.tid & 63; F.wave = __builtin_amdgcn_readfirstlane(F.tid >> 6); F.G = gridDim.x; F.bid = blockIdx.x;
    F.a = &args; F.out = args.out; F.ws = args.ws;
    if (F.tid < 16) ((LAS unsigned*)(F.lds + LDS_XB))[F.tid] = 0u;
    __syncthreads();
    XcdBarrier bar; bar.bar = ((unsigned*)(F.ws + WS_CTL)) + CW_BAR; bar.x = 0; bar.st = nullptr;
    if (N_PHASE_LAUNCH == 0) bar = xcd_barrier_post(((unsigned*)(F.ws + WS_CTL)) + CW_BAR, (volatile LAS unsigned*)(F.lds + LDS_XB));
    const int lo = args.ph_lo, hi = args.ph_hi;
#ifndef PH_MASK
#define PH_MASK 0xFFFFFFFFu
#endif
#define IN(k) (lo <= (k) && (k) < hi)
#define EN(b) ((PH_MASK >> (b)) & 1u)
#ifndef DUP_MASK
#define DUP_MASK 0u
#endif
#ifndef DRYVAR
#define DRYVAR 0u
#endif
#define REP(b) for (int _rep = 0; _rep < 1 + (int)((DUP_MASK >> (b)) & 1u); ++_rep)
#define SEAM(k) do { if (IN(k) && IN((k) + 1)) { XcdBarrier b2 = bar; b2.bar = launder_uniform(bar.bar); xcd_barrier(b2); } } while (0)
    if (EN(0) && IN(0)) REP(0) { prep_layer(F, 0); __syncthreads(); mods_phase(F); __syncthreads(); }
    SEAM(0);
    if (EN(1) && IN(1)) REP(1) r0_phase(F);
    SEAM(1);
    for (int l = 0; l < DEPTH; ++l) {
        const int p0 = 2 + l * PH_PER_LAYER; const bool last = (l == DEPTH - 1); const int nrows = last ? TL : TT;
        if (EN(2) && IN(p0 + 0)) REP(2) g1_phase(F);
        SEAM(p0 + 0);
        if (EN(4) && IN(p0 + 1)) REP(4) g23_phase(F);
        SEAM(p0 + 1);
        if (IN(p0 + 2)) { if (EN(5)) { if ((DUP_MASK >> 5) & 1u) mixers_phase(F, l, nrows, DRYVAR); mixers_phase(F, l, nrows); } if (EN(6)) { if ((DUP_MASK >> 6) & 1u) attn_mfma_phase<DRYVAR>(F, !last); attn_mfma_phase<0u>(F, !last); } }
        SEAM(p0 + 2);
        if (EN(7) && IN(p0 + 3)) REP(7) g4_phase(F, nrows);
        SEAM(p0 + 3);
        if (EN(8) && IN(p0 + 4)) { if ((DUP_MASK >> 8) & 1u) { r1_phase(F, l, nrows, args.ph_hi > 0); __syncthreads(); } r1_phase(F, l, nrows); }
        SEAM(p0 + 4);
        if (EN(9) && IN(p0 + 5)) REP(9) g5_phase(F, l, nrows);
        SEAM(p0 + 5);
        if (EN(10) && IN(p0 + 6)) REP(10) g6_phase(F, l, nrows);
        SEAM(p0 + 6);
        if (EN(11) && IN(p0 + 7)) { if ((DUP_MASK >> 11) & 1u) { r2_phase(F, l, nrows, args.ph_hi > 0); __syncthreads(); } r2_phase(F, l, nrows); if (!last) { if ((DUP_MASK >> 12) & 1u) { __syncthreads(); prep_layer(F, l + 1, DRYVAR); } __syncthreads(); prep_layer(F, l + 1); } }
        SEAM(p0 + 7);
    }
#undef IN
#undef SEAM
}

extern "C" void kernel_launch(void* const* d_in, const int* in_sizes, int n_in, void* d_out, int out_size, void* d_ws, size_t ws_size, hipStream_t stream) {
    static int grid = 0;
    if (grid == 0) {
        if (n_in != 31 || out_size != TL * DM || ws_size < WS_END) { fprintf(stderr, "kernel_launch: unexpected shapes (n_in %d out %d ws %zu)\n", n_in, out_size, ws_size); grid = -1; return; }
        int dev = 0, cus = 0, per_cu = 0;
        if (hipGetDevice(&dev) != hipSuccess || hipDeviceGetAttribute(&cus, hipDeviceAttributeMultiprocessorCount, dev) != hipSuccess) { grid = -1; return; }
        if (hipFuncSetAttribute((const void*)fwd, hipFuncAttributeMaxDynamicSharedMemorySize, LDS_BYTES) != hipSuccess) { fprintf(stderr, "kernel_launch: hipFuncSetAttribute failed\n"); grid = -1; return; }
        if (hipOccupancyMaxActiveBlocksPerMultiprocessor(&per_cu, (const void*)fwd, NTHR, LDS_BYTES) != hipSuccess || per_cu < 1) fprintf(stderr, "kernel_launch: occupancy query reports %d\n", per_cu);
        (void)hipGetLastError();
        grid = cus;
    }
    if (grid < 0) return;
    (void)hipMemsetAsync((char*)d_ws + WS_CTL, 0, CTL_ZERO_BYTES, stream);
    Args a{};
    for (int i = 0; i < 31; ++i) a.in[i] = (const float*)d_in[i];
    a.out = (float*)d_out; a.ws = (unsigned char*)d_ws;
    if (N_PHASE_LAUNCH == 0) { a.ph_lo = 0; a.ph_hi = N_PHASES; hipLaunchKernelGGL(fwd, dim3(grid), dim3(NTHR), LDS_BYTES, stream, a); }
    else for (int p = 0; p < N_PHASES; ++p) { a.ph_lo = p; a.ph_hi = p + 1; hipLaunchKernelGGL(fwd, dim3(grid), dim3(NTHR), LDS_BYTES, stream, a); }
}
```

```cpp
#include <hip/hip_runtime.h>
#include <cstdio>
#include <cstdint>

#define LAS __attribute__((address_space(3)))
#define GAS __attribute__((address_space(1)))
typedef unsigned short bf16_t;
typedef short bf16x8 __attribute__((ext_vector_type(8)));
typedef float f32x4 __attribute__((ext_vector_type(4)));
typedef float f32x2 __attribute__((ext_vector_type(2)));
typedef unsigned u32x4 __attribute__((ext_vector_type(4)));
typedef unsigned u32x2 __attribute__((ext_vector_type(2)));

#ifndef DRYVAR
#define DRYVAR 0u
#endif
#ifndef N_PHASE_LAUNCH
#define N_PHASE_LAUNCH 0
#endif

constexpr int DM = 1024, NBATCH = 4, SEQ = 8192, CTXL = 256, DEPTH = 2;
constexpr int TL = NBATCH * SEQ, TC = NBATCH * CTXL, TT = TL + TC;
constexpr int KVS = SEQ + CTXL;
constexpr int NH = 8, QK_NOPE = 64, QK_ROPE = 32, VD = 64, QLORA = 256, KVLORA = 128;
constexpr int INC = 1184, PW = 1280;
constexpr int OFF_KV = 256, OFF_KR = 384, OFF_POOL = 416, OFF_CONV = 672;
constexpr int NE = 32, DEXP = 256, CONVK = 31;
constexpr float ALPHA = 1.4142135623730951f, EPS = 1e-6f, ROUTED_SCALE = 2.5f;
constexpr float ATTN_SCALE = 0.10206207261596575f;
constexpr int NWAVES = 8, NTHR = 512;

constexpr size_t MiB = 1u << 20;
constexpr size_t WS_CTL = 0, CTL_ZERO_BYTES = 1 * MiB;
constexpr int CW_BAR = 4096;
constexpr int CW_GCNT = 16384;
constexpr size_t WS_W = 1 * MiB;
constexpr size_t W_WIN = 0, W_WQ = W_WIN + (size_t)PW * DM * 2, W_WKV = W_WQ + (size_t)768 * 256 * 2, W_WO = W_WKV + (size_t)1024 * 256 * 2,
                 W_WGU = W_WO + (size_t)DM * DM * 2, W_WD = W_WGU + (size_t)33 * 512 * DM * 2, W_END = W_WD + (size_t)33 * DM * 256 * 2;
static_assert(W_END <= 56 * MiB, "weights region");
constexpr size_t WS_MISC = 61 * MiB;
constexpr size_t M_MOD = 0, M_ROPE = M_MOD + (size_t)DEPTH * 5 * 6144 * 4, M_RS = M_ROPE + 128 * 8 * 2 * 4, M_SELE = M_RS + (size_t)TT * 32,
                 M_SELR = M_SELE + (size_t)TT * 16, M_LIST = M_SELR + (size_t)TT * 16, M_LISTW = M_LIST + (size_t)NE * TT * 4, M_END = M_LISTW + (size_t)NE * TT * 4;
static_assert(M_END <= 12 * MiB, "misc region");
constexpr size_t WS_H = 73 * MiB;
constexpr size_t WS_X = 139 * MiB;
constexpr size_t WS_P = WS_X, WS_Q = 222 * MiB, WS_QR = 272 * MiB, WS_KV = 289 * MiB, WS_KR = 355 * MiB, WS_MIX = 358 * MiB, WS_Y1 = WS_X  ;
constexpr size_t WS_YS8 = 366 * MiB;
constexpr size_t WS_Z = 424 * MiB;
constexpr size_t WS_HB = WS_X, WS_YB = 226 * MiB, WS_END = 512 * MiB;
static_assert(WS_P + (size_t)TT * PW * 2 <= WS_Q && WS_Q + (size_t)TT * 768 * 2 <= WS_QR && WS_QR + (size_t)TT * 256 * 2 <= WS_KV && WS_KV + (size_t)TT * 2048 <= WS_KR &&
              WS_KR + (size_t)TT * 64 <= WS_MIX && WS_MIX + (size_t)TT * 2048 <= WS_Z && WS_Y1 + (size_t)TT * 2048 <= WS_Q && WS_Z + (size_t)TT * 2048 <= WS_END, "attention-time map");
static_assert(WS_HB + (size_t)(4 * TT + 32 * 255 + TT) * 512 <= WS_YB && WS_YB + (size_t)(4 * TT + 32 * 255) * 1024 <= WS_YS8 && WS_YS8 + (size_t)TT * 1024 <= WS_Z, "moe-time map");
constexpr int LDS_BYTES = 163840;
constexpr int LDS_XB = LDS_BYTES - 64;

__device__ __forceinline__ float bf2f(unsigned b) { return __uint_as_float(b << 16); }
__device__ __forceinline__ unsigned f2bf(float f) { unsigned u = __float_as_uint(f); return (u + 0x7fffu + ((u >> 16) & 1u)) >> 16; }
__device__ __forceinline__ unsigned pk2(float lo, float hi) { return f2bf(lo) | (f2bf(hi) << 16); }
template <int CTRL> __device__ __forceinline__ float dpp_f(float v) { return __builtin_bit_cast(float, __builtin_amdgcn_update_dpp(0, __builtin_bit_cast(int, v), CTRL, 0xF, 0xF, false)); }
#define DPP_X1 0xB1
#define DPP_X2 0x4E
#define DPP_HM 0x141
#define DPP_RM 0x140
__device__ __forceinline__ float swap16_f(float v, float& other) { auto r = __builtin_amdgcn_permlane16_swap(__float_as_uint(v), __float_as_uint(v), false, false); other = __uint_as_float(r[1]); return __uint_as_float(r[0]); }
__device__ __forceinline__ float sum16(float v) { v += dpp_f<DPP_X1>(v); v += dpp_f<DPP_X2>(v); v += dpp_f<DPP_HM>(v); v += dpp_f<DPP_RM>(v); return v; }
__device__ __forceinline__ float sum32(float v) { v = sum16(v); float o; const float a = swap16_f(v, o); return a + o; }
__device__ __forceinline__ float wave_sum(float v) {
    v = sum32(v);
    auto r = __builtin_amdgcn_permlane32_swap(__float_as_uint(v), __float_as_uint(v), false, false);
    return __uint_as_float(r[0]) + __uint_as_float(r[1]);
}
__device__ __forceinline__ float max8(float v) { v = fmaxf(v, dpp_f<DPP_X1>(v)); v = fmaxf(v, dpp_f<DPP_X2>(v)); v = fmaxf(v, dpp_f<DPP_HM>(v)); return v; }
__device__ __forceinline__ float max32(float v) { v = max8(v); v = fmaxf(v, dpp_f<DPP_RM>(v)); float o; const float a = swap16_f(v, o); return fmaxf(a, o); }
__device__ __forceinline__ float sigm_exact(float x) { return 1.f / (1.f + __expf(-x)); }
__device__ __forceinline__ float sigm(float x) { return __builtin_amdgcn_rcpf(1.f + __expf(-x)); }
__device__ __forceinline__ float silu(float x) { return x * __builtin_amdgcn_rcpf(1.f + __expf(-x)); }
__device__ __forceinline__ int kvrow_of(int r) { return r < TL ? (r >> 13) * KVS + CTXL + (r & (SEQ - 1)) : ((r - TL) >> 8) * KVS + ((r - TL) & (CTXL - 1)); }
__device__ __forceinline__ int batch_of(int r) { return r < TL ? (r >> 13) : 4; }
#define LDS_WAIT() asm volatile("s_waitcnt lgkmcnt(0)" ::: "memory")
#define VM_WAIT() asm volatile("s_waitcnt vmcnt(0)" ::: "memory")

#define XB_TMO      128
#define XB_XCNT(j)  (256  + 64 * (j))
#define XB_XSUB(j)  (1280 + 64 * (j))
#define XB_XGEN(j)  (2304 + 64 * (j))
#define XB_TOP      3328
#define XB_TOPGEN   3392
#define XCD_BAR_WORDS 3456
#define XB_SPIN_CAP (1u << 22)
__device__ __forceinline__ unsigned xb_ld(unsigned* p)              { return __hip_atomic_load(p, __ATOMIC_RELAXED, __HIP_MEMORY_SCOPE_AGENT); }
__device__ __forceinline__ unsigned xb_add(unsigned* p, unsigned v) { return __hip_atomic_fetch_add(p, v, __ATOMIC_RELAXED, __HIP_MEMORY_SCOPE_AGENT); }
__device__ __forceinline__ unsigned xb_xcc_id() { return (unsigned)__builtin_amdgcn_s_getreg((3 << 11) | 20) & 0xFu; }
#define XB_SPIN(cond, bar) do { unsigned _sp = 0; while (cond) { __builtin_amdgcn_s_sleep(1); \
    if ((++_sp & 255u) == 0u) { if (xb_ld(&(bar)[XB_TMO])) break; if (_sp > XB_SPIN_CAP) { atomicAdd(&(bar)[XB_TMO], 1u); break; } } } } while (0)
struct XcdBarrier { unsigned* bar; unsigned x; volatile LAS unsigned* st; };
__device__ __forceinline__ XcdBarrier xcd_barrier_post(unsigned* bar, volatile LAS unsigned* st) {
    XcdBarrier b; b.bar = bar; b.x = xb_xcc_id(); b.st = st;
    if (threadIdx.x == 0) (void)xb_add(&bar[XB_XCNT(b.x)], 1u);
    return b;
}
__device__ __forceinline__ void xcd_barrier_complete(unsigned* bar, unsigned x, unsigned& nloc, unsigned& nx) {
    const unsigned G = gridDim.x * gridDim.y * gridDim.z;
    unsigned sum, cnt, mine, sp = 0u;
    for (;;) {
        sum = 0u; cnt = 0u; mine = 0u;
#pragma unroll
        for (unsigned j = 0; j < 16; ++j) { const unsigned c = xb_ld(&bar[XB_XCNT(j)]); sum += c; cnt += (c > 0u) ? 1u : 0u; mine = (j == x) ? c : mine; }
        if (sum == G) break;
        __builtin_amdgcn_s_sleep(1);
        if ((++sp & 255u) == 0u) { if (xb_ld(&bar[XB_TMO])) break; if (sp > XB_SPIN_CAP) { atomicAdd(&bar[XB_TMO], 1u); break; } }
    }
    nloc = mine > 0u ? mine : 1u; nx = cnt > 0u ? cnt : 1u;
}
__device__ __forceinline__ void xcd_barrier(const XcdBarrier& b) {
    asm volatile("s_waitcnt vmcnt(0)" ::: "memory");
    __syncthreads();
    if (threadIdx.x == 0) {
        unsigned* bar = b.bar;
        __builtin_amdgcn_s_waitcnt(0);
        unsigned nloc = b.st[0], nx = b.st[1];
        if (nloc == 0u) { xcd_barrier_complete(bar, b.x, nloc, nx); b.st[0] = nloc; b.st[1] = nx; }
        const unsigned old = xb_add(&bar[XB_XSUB(b.x)], 1u);
        const unsigned gen = old / nloc;
        if (old + 1u == (gen + 1u) * nloc) {
            __builtin_amdgcn_fence(__ATOMIC_RELEASE, "agent");
            asm volatile("s_waitcnt vmcnt(0)" ::: "memory");
            const unsigned og = xb_add(&bar[XB_TOP], 1u);
            const unsigned tg = og / nx;
            if (og + 1u == (tg + 1u) * nx) xb_add(&bar[XB_TOPGEN], 1u);
            else XB_SPIN(xb_ld(&bar[XB_TOPGEN]) == tg, bar);
            __builtin_amdgcn_fence(__ATOMIC_ACQUIRE, "agent");
            xb_add(&bar[XB_XGEN(b.x)], 1u);
            asm volatile("s_waitcnt vmcnt(0)" ::: "memory");
        } else {
            XB_SPIN(xb_ld(&bar[XB_XGEN(b.x)]) == gen, bar);
            __builtin_amdgcn_fence(__ATOMIC_ACQUIRE, "agent");
            asm volatile("s_waitcnt vmcnt(0)" ::: "memory");
        }
    }
    __syncthreads();
}

struct Args { const float* in[31]; float* out; unsigned char* ws; int ph_lo, ph_hi; };
struct Ctx {
    LAS unsigned char* lds; int tid, lane, wave, G, bid;
    const Args* a; float* out; unsigned char* ws;
};
template <class T> __device__ __forceinline__ T* launder_uniform(T* p) {
    unsigned lo, hi;
    asm volatile("v_mov_b32 %0, %2\n\tv_mov_b32 %1, %3" : "=&v"(lo), "=&v"(hi) : "s"((unsigned)(uintptr_t)p), "s"((unsigned)((uintptr_t)p >> 32)));
    lo = __builtin_amdgcn_readfirstlane(lo); hi = __builtin_amdgcn_readfirstlane(hi);
    return (T*)(((uintptr_t)hi << 32) | (uintptr_t)lo);
}
__device__ __forceinline__ Ctx fresh(const Ctx& F0) {
    Ctx F = F0; int bid = F0.bid, G = F0.G, wv = F0.wave;
    int lane = (int)__builtin_amdgcn_mbcnt_hi(~0u, __builtin_amdgcn_mbcnt_lo(~0u, 0u));
    asm volatile("" : "+v"(lane)); asm volatile("" : "+v"(bid)); asm volatile("" : "+v"(G)); asm volatile("" : "+v"(wv));
    bid = __builtin_amdgcn_readfirstlane(bid); G = __builtin_amdgcn_readfirstlane(G); wv = __builtin_amdgcn_readfirstlane(wv);
    F.tid = wv * 64 + lane; F.lane = lane; F.wave = wv; F.bid = bid; F.G = G; F.ws = launder_uniform(F0.ws); F.out = launder_uniform(F0.out); F.a = F0.a;
    { unsigned l = (unsigned)(uintptr_t)F0.lds; asm volatile("" : "+v"(l)); F.lds = (LAS unsigned char*)(uintptr_t)__builtin_amdgcn_readfirstlane(l); }
    return F;
}
enum { I_X = 0, I_C, I_CTX, I_CCTX, I_ADAW, I_ADAB, I_WIN, I_QG, I_WUQ, I_KVG, I_WUKV, I_POOLW, I_POOLS, I_CDW, I_CB, I_CLNG, I_CLNB, I_CPW, I_WOUT,
       I_LN1G, I_LN1B, I_RW, I_RB, I_EWG, I_EWU, I_EWD, I_SWG, I_SWU, I_SWD, I_LN2G, I_LN2B };

__device__ __forceinline__ int permd(int c) { return (c & ~255) + 128 * ((c >> 3) & 1) + 32 * ((c >> 6) & 3) + 8 * ((c >> 4) & 3) + (c & 7); }
__device__ __forceinline__ void xpose_item(const float* W, int N, const float* gain, bf16_t* WT, int ldk, int koff, int rmul, int radd, LAS float* scr, int kb, int nb, int lane, bool pd = false) {
    const int k0 = 64 * kb, n0 = 32 * nb;
    float v[32]; const float* wp = W + (size_t)(k0 + (lane >> 5)) * N + n0 + (lane & 31);
#pragma unroll
    for (int i = 0; i < 32; ++i) v[i] = wp[(size_t)(2 * i) * N];
    if (gain) {
#pragma unroll
        for (int i = 0; i < 32; ++i) v[i] *= gain[k0 + 2 * i + (lane >> 5)]; }
#pragma unroll
    for (int i = 0; i < 32; ++i) scr[(2 * i + (lane >> 5)) * 33 + (lane & 31)] = v[i];
    LDS_WAIT(); asm volatile("" ::: "memory");
    const int c = lane & 7;
#pragma unroll
    for (int j = 0; j < 4; ++j) { const int n = (lane >> 3) + 8 * j; const LAS float* s = scr + (8 * c) * 33 + n;
        u32x4 o; o.x = pk2(s[0 * 33], s[1 * 33]); o.y = pk2(s[2 * 33], s[3 * 33]); o.z = pk2(s[4 * 33], s[5 * 33]); o.w = pk2(s[6 * 33], s[7 * 33]);
        const int drow = pd ? permd(n0 + n) : (n0 + n) * rmul + radd;
        *(u32x4*)(WT + (size_t)drow * ldk + koff + k0 + 8 * c) = o; }
    LDS_WAIT(); asm volatile("" ::: "memory");
}
__device__ __forceinline__ void prep_layer(const Ctx& F0, int l, unsigned var = 0u) {
    const Ctx F = fresh(F0);
    LAS float* scr = (LAS float*)(F.lds + F.wave * 16384);
    const int gw = F.bid * NWAVES + F.wave, NGW = F.G * NWAVES, lane = F.lane;
    const float* w_in = F.a->in[I_WIN] + (size_t)l * DM * INC; const float* w_uq = F.a->in[I_WUQ] + (size_t)l * 256 * 768; const float* w_ukv = F.a->in[I_WUKV] + (size_t)l * 128 * 1024;
    const float* w_out = F.a->in[I_WOUT] + (size_t)l * DM * DM;
    constexpr int I1 = 16 * 37, I2 = 4 * 24, I3 = 2 * 32, I4 = 8 * 32, I5 = 33 * 2 * 128, I6 = 33 * 128, I7 = 1024  , I8 = 96   + 128  ;
    constexpr int NIT = I1 + I2 + I3 + I4 + I5 + I6 + I7 + I8;
    for (int it = gw; it < NIT; it += NGW) {
        int r = it;
        if (r < I1) { xpose_item(w_in, INC, nullptr, ((bf16_t*)(F.ws + WS_W + W_WIN)), DM, 0, 1, 0, scr, r / 37, r % 37, lane); continue; } r -= I1;
        if (r < I2) { xpose_item(w_uq, 768, F.a->in[I_QG] + l * 256, ((bf16_t*)(F.ws + WS_W + W_WQ)), 256, 0, 1, 0, scr, r / 24, r % 24, lane); continue; } r -= I2;
        if (r < I3) { xpose_item(w_ukv, 1024, F.a->in[I_KVG] + l * 128, ((bf16_t*)(F.ws + WS_W + W_WKV)), 256, 0, 1, 0, scr, r / 32, r % 32, lane); continue; } r -= I3;
        if (r < I4) { xpose_item(w_out, DM, nullptr, ((bf16_t*)(F.ws + WS_W + W_WO)), DM, 0, 1, 0, scr, r / 32, r % 32, lane, true); continue; } r -= I4;
        if (r < I5) { if (var & 8u) continue; const int e = r / 256, q = r % 256, which = q / 128, i2 = q % 128;
            const float* src = e < 32 ? (which ? F.a->in[I_EWU] : F.a->in[I_EWG]) + ((size_t)l * 32 + e) * DM * 256 : (which ? F.a->in[I_SWU] : F.a->in[I_SWG]) + (size_t)l * DM * 256;
            xpose_item(src, 256, nullptr, ((bf16_t*)(F.ws + WS_W + W_WGU)) + (size_t)e * 512 * DM, DM, 0, 1, ((i2 % 8) / 4) * 128 + which * 128, scr, i2 / 8, i2 % 8, lane); continue; } r -= I5;
        if (r < I6) { if (var & 16u) continue; const int e = r / 128, i2 = r % 128;
            const float* src = e < 32 ? F.a->in[I_EWD] + ((size_t)l * 32 + e) * 256 * DM : F.a->in[I_SWD] + (size_t)l * 256 * DM;
            xpose_item(src, DM, nullptr, ((bf16_t*)(F.ws + WS_W + W_WD)) + (size_t)e * DM * 256, 256, 0, 1, 0, scr, i2 / 32, i2 % 32, lane, true); continue; } r -= I6;
        if (r < I7) { if (var & 32u) continue;
            const int kg = r / 16, n = (r % 16) * 64 + lane; float acc[8];
#pragma unroll
            for (int i = 0; i < 8; ++i) acc[i] = 0.f;
            if (kg < 32) { const int g = kg / 8, i0 = (kg % 8) * 8; const float* pw = F.a->in[I_POOLW] + ((size_t)l * 4 + g) * 4096; const float* ps = F.a->in[I_POOLS] + l * 256 + g * 64;
                for (int jb = 0; jb < 64; jb += 16) { float wv[16];
#pragma unroll
                    for (int j = 0; j < 16; ++j) wv[j] = w_out[(size_t)(512 + g * 64 + jb + j) * DM + n];
#pragma unroll
                    for (int j = 0; j < 16; ++j) { const float wj = wv[j] * ps[jb + j];
#pragma unroll
                        for (int i = 0; i < 8; ++i) acc[i] += pw[(i0 + i) * 64 + jb + j] * wj; } } }
            else { const int i0 = (kg - 32) * 8; const float* cp = F.a->in[I_CPW] + (size_t)l * 65536;
                for (int jb = 0; jb < 256; jb += 16) { float wv[16];
#pragma unroll
                    for (int j = 0; j < 16; ++j) wv[j] = w_out[(size_t)(768 + jb + j) * DM + n];
#pragma unroll
                    for (int j = 0; j < 16; ++j) {
#pragma unroll
                        for (int i = 0; i < 8; ++i) acc[i] += cp[(i0 + i) * 256 + jb + j] * wv[j]; } } }
            u32x4 o; o.x = pk2(acc[0], acc[1]); o.y = pk2(acc[2], acc[3]); o.z = pk2(acc[4], acc[5]); o.w = pk2(acc[6], acc[7]);
            *(u32x4*)(((bf16_t*)(F.ws + WS_W + W_WO)) + (size_t)permd(n) * DM + 512 + kg * 8) = o; continue; } r -= I7;
        { unsigned zz = 0u; asm volatile("" : "+v"(zz)); const u32x4 z = {zz, zz, zz, zz};
          if (r < 96) { u32x4* d = (u32x4*)(((bf16_t*)(F.ws + WS_W + W_WIN)) + (size_t)(INC + r) * DM); d[lane] = z; d[64 + lane] = z; }
          else { const int n = (r - 96) * 8 + (lane >> 3); u32x4* d = (u32x4*)(((bf16_t*)(F.ws + WS_W + W_WKV)) + (size_t)n * 256 + 128); d[lane & 7] = z; d[8 + (lane & 7)] = z; } }
    }
}

__device__ __forceinline__ void mods_phase(const Ctx& F0) {
    const Ctx F = fresh(F0);
    LAS float* sv = (LAS float*)F.lds;
    LAS float* part = sv + 5 * 1024;
    for (int i = F.tid; i < 5 * 1024; i += NTHR) { const int j = i >> 10, k = i & 1023; const float c = j < 4 ? F.a->in[I_C][j * DM + k] : F.a->in[I_CCTX][k]; sv[i] = silu(c); }
    __syncthreads();
    for (int it = F.bid; it < DEPTH * 96; it += F.G) {
        const int l = it / 96, n = (it % 96) * 64 + F.lane; const float* aw = F.a->in[I_ADAW] + (size_t)l * DM * 6144 + n;
        float acc[5] = {0.f, 0.f, 0.f, 0.f, 0.f};
        const int kb = F.wave * 128;
#pragma unroll 8
        for (int k = 0; k < 128; ++k) { const float a = aw[(size_t)(kb + k) * 6144];
#pragma unroll
            for (int j = 0; j < 5; ++j) acc[j] += sv[j * 1024 + kb + k] * a; }
#pragma unroll
        for (int j = 0; j < 5; ++j) part[(F.wave * 5 + j) * 64 + F.lane] = acc[j];
        __syncthreads();
        if (F.wave < 5) { float s = F.a->in[I_ADAB][l * 6144 + n];
#pragma unroll
            for (int w = 0; w < 8; ++w) s += part[(w * 5 + F.wave) * 64 + F.lane];
            ((float*)(F.ws + WS_MISC + M_MOD))[((size_t)l * 5 + F.wave) * 6144 + n] = s; }
        __syncthreads();
    }
    if (F.bid == F.G - 1) {
        for (int i = F.tid; i < 1024; i += NTHR) { const int pos = i >> 3, j = i & 7;
            const double c1 = j == 0 ? 0.54030230586813977 : j == 1 ? 0.95041528025518285 : j == 2 ? 0.99500416527802582 : j == 3 ? 0.99950004166527784 : j == 4 ? 0.99995000041666526 : j == 5 ? 0.99999500000416663 : j == 6 ? 0.99999950000004167 : 0.99999995000000041;
            const double s1 = j == 0 ? 0.8414709848078965 : j == 1 ? 0.31098359290718575 : j == 2 ? 0.099833416646828155 : j == 3 ? 0.031617506402433708 : j == 4 ? 0.0099998333341666645 : j == 5 ? 0.0031622723897082477 : j == 6 ? 0.00099999983333334168 : 0.00031622776074637522;
            double c = 1.0, sn = 0.0;
            for (int q = 0; q < pos; ++q) { const double nc = c * c1 - sn * s1, ns = sn * c1 + c * s1; c = nc; sn = ns; }
            ((float*)(F.ws + WS_MISC + M_ROPE))[pos * 16 + j] = (float)c; ((float*)(F.ws + WS_MISC + M_ROPE))[pos * 16 + 8 + j] = (float)sn; }
    }
}

__device__ __forceinline__ void row_ln(f32x4 (&v)[4]) {
    float s = 0.f;
#pragma unroll
    for (int j = 0; j < 4; ++j) s += (v[j].x + v[j].y) + (v[j].z + v[j].w);
    const float mean = wave_sum(s) * (1.f / DM); float s2 = 0.f;
#pragma unroll
    for (int j = 0; j < 4; ++j) { v[j] = v[j] - mean; s2 += (v[j].x * v[j].x + v[j].y * v[j].y) + (v[j].z * v[j].z + v[j].w * v[j].w); }
    const float rstd = 1.f / sqrtf(wave_sum(s2) * (1.f / DM) + EPS);
#pragma unroll
    for (int j = 0; j < 4; ++j) v[j] = v[j] * rstd;
}
__device__ __forceinline__ void row_load(f32x4 (&v)[4], const float* row, int lane) {
#pragma unroll
    for (int j = 0; j < 4; ++j) v[j] = *(const f32x4*)(row + 4 * lane + 256 * j);
}
__device__ __forceinline__ void row_store(const f32x4 (&v)[4], float* row, int lane) {
#pragma unroll
    for (int j = 0; j < 4; ++j) *(f32x4*)(row + 4 * lane + 256 * j) = v[j];
}
__device__ __forceinline__ void row_store_bf(const f32x4 (&v)[4], bf16_t* row, int lane) {
#pragma unroll
    for (int j = 0; j < 4; ++j) { u32x2 o; o.x = pk2(v[j].x, v[j].y); o.y = pk2(v[j].z, v[j].w); *(u32x2*)(row + 4 * lane + 256 * j) = o; }
}
__device__ __forceinline__ void row_load_bf(f32x4 (&v)[4], const bf16_t* row, int lane) {
#pragma unroll
    for (int j = 0; j < 4; ++j) { const u32x2 o = *(const u32x2*)(row + 4 * lane + 256 * j); v[j] = (f32x4){bf2f(o.x & 0xffffu), bf2f(o.x >> 16), bf2f(o.y & 0xffffu), bf2f(o.y >> 16)}; }
}
__device__ __forceinline__ void row_mod(f32x4 (&v)[4], const float* shift, const float* scale, int lane) {
#pragma unroll
    for (int j = 0; j < 4; ++j) { const f32x4 sc = *(const f32x4*)(scale + 4 * lane + 256 * j), sh = *(const f32x4*)(shift + 4 * lane + 256 * j); v[j] = v[j] * (sc + 1.f) + sh; }
}
__device__ __forceinline__ void row_affine(f32x4 (&v)[4], const float* g, const float* b, int lane) {
#pragma unroll
    for (int j = 0; j < 4; ++j) { const f32x4 gg = *(const f32x4*)(g + 4 * lane + 256 * j), bb = *(const f32x4*)(b + 4 * lane + 256 * j); v[j] = v[j] * gg + bb; }
}

__device__ __forceinline__ void r0_phase(const Ctx& F0) {
    const Ctx F = fresh(F0);
    const int gw = F.bid * NWAVES + F.wave, NGW = F.G * NWAVES;
    for (int r = gw; r < TT; r += NGW) {
        const float* src = r < TL ? F.a->in[I_X] + (size_t)r * DM : F.a->in[I_CTX] + (size_t)(r - TL) * DM;
        const float* md = ((float*)(F.ws + WS_MISC + M_MOD)) + (size_t)batch_of(r) * 6144;
        f32x4 v[4]; row_load(v, src, F.lane); row_ln(v); row_mod(v, md, md + 1024, F.lane); row_store_bf(v, ((bf16_t*)(F.ws + WS_H)) + (size_t)r * DM, F.lane);
    }
}

#ifndef PG8_ALIGN_DEFAULT
#define PG8_ALIGN_DEFAULT true
#endif
namespace pg8 {
constexpr int BM = 256, BK = 64, HALF = 128, HTB = HALF * BK * 2, STAGE_BYTES = 8 * HTB, NXCD = 8, WGM = 8;
__device__ __forceinline__ int lds_byte(int r, int c) { const int st = (r >> 4) * 2 + (c >> 5), rr = r & 15, cc = c & 31, ob = rr * 64 + cc * 2; return st * 1024 + (ob ^ (((ob >> 9) & 1) << 5)); }
__device__ __forceinline__ void stage_rc(int b, int& R, int& C) { const int st = b / 1024, sb = b % 1024, swz = sb ^ (((sb >> 9) & 1) << 5); R = (st >> 1) * 16 + swz / 64; C = (st & 1) * 32 + (swz % 64) / 2; }
__device__ __forceinline__ int perm32(int rho) { const int n = rho >> 4, i = rho & 15; return 8 * (i >> 2) + 4 * n + (i & 3); }
struct Unit { int pm, pn, e, nvalid, base, idx; };
__device__ __forceinline__ int xcd_remap(int wgid, int nwg) { const int q = nwg / NXCD, r = nwg % NXCD, xcd = wgid % NXCD, off = wgid / NXCD; return (xcd < r ? xcd * (q + 1) : r * (q + 1) + (xcd - r) * q) + off; }
struct StaticOrder {
    int nM, nN, nwg, G, c;
    __device__ void init(int M, int N, int G_, int c_) { nM = M / BM; nN = N / BM; nwg = nM * nN; G = G_; c = c_; }
    __device__ void at(int L, int i, Unit& u) const {
        const int wgid = xcd_remap(L, nwg);
        const int nig = WGM * nN, gid = wgid / nig, fm = gid * WGM, gsz = (nM - fm) < WGM ? (nM - fm) : WGM;
        u.pm = fm + ((wgid % nig) % gsz); u.pn = (wgid % nig) / gsz; u.e = 0; u.nvalid = 256; u.base = 0; u.idx = i;
    }
    __device__ bool next(int i, Unit& u) const { const long L = (long)i * G + c; if (L >= nwg) return false; at((int)L, i, u); return true; }
};
struct DualOrder {
    StaticOrder A, B; int G, c;
    __device__ bool next(int i, Unit& u) const { const long L = (long)i * G + c; if (L >= A.nwg + B.nwg) return false;
        if (L < A.nwg) { A.at((int)L, i, u); u.e = 0; } else { B.at((int)L - A.nwg, i, u); u.e = 1; } return true; }
};
struct ExpertOrder {
    const LAS int* tl; const LAS int* cnt; const LAS int* te; int nN, nwg, G, c;
    __device__ void init(const LAS int* tl_, const LAS int* cnt_, const LAS int* te_, int nN_, int G_, int c_) { tl = tl_; cnt = cnt_; te = te_; nN = nN_; nwg = __builtin_amdgcn_readfirstlane(tl_[33]) * nN_; G = G_; c = c_; }
    __device__ bool next(int i, Unit& u) const {
        const long L = (long)i * G + c; if (L >= nwg) return false;
        const int wgid = xcd_remap((int)L, nwg), mt = wgid / nN;
        const int e = __builtin_amdgcn_readfirstlane(te[mt]);
        const int te_ = __builtin_amdgcn_readfirstlane(tl[e]), ce = __builtin_amdgcn_readfirstlane(cnt[e]);
        u.e = e; u.pm = mt - te_; u.pn = wgid % nN; u.nvalid = ce - u.pm * 256; u.base = te_ * 256; u.idx = i; return true;
    }
};
__device__ __forceinline__ unsigned cvt_pk_bf16(float lo, float hi) { unsigned r; asm volatile("v_cvt_pk_bf16_f32 %0, %1, %2" : "=v"(r) : "v"(lo), "v"(hi)); return r; }
__device__ __forceinline__ u32x4 pack8(const f32x4& v0, const f32x4& v1) { u32x4 w; w.x = cvt_pk_bf16(v0[0], v0[1]); w.y = cvt_pk_bf16(v0[2], v0[3]); w.z = cvt_pk_bf16(v1[0], v1[1]); w.w = cvt_pk_bf16(v1[2], v1[3]); return w; }

template <bool GATHER, bool ALIGN_EPI = PG8_ALIGN_DEFAULT, class Sched, class AOff, class BPtr, class Epi>
__device__ __forceinline__ void gemm256(LAS unsigned char* lds, int tid, const char* Abase, int pitch, int K, const Sched& S, const AOff& aoff, const BPtr& bptr, const Epi& E) {
    const int wid = __builtin_amdgcn_readfirstlane(tid >> 6), lane = tid & 63, wr = wid >> 2, wc = wid & 3, fr = lane & 15, fq = lane >> 4;
    const int nt = K / BK;
    int sR, sC; stage_rc(tid * 16, sR, sC);
    const unsigned voffB = (unsigned)(((sR & ~31) + perm32(sR & 31)) * K + sC) * 2u;
    const unsigned laneA = (unsigned)sR * (unsigned)pitch + (unsigned)sC * 2u;
    const size_t kstep = (size_t)(BK * 2);
    const size_t hstepB = (size_t)HALF * K * 2, pstepB = (size_t)64 * K * 2;
    const size_t hstepA = (size_t)HALF * pitch, pstepA = (size_t)64 * pitch;
    const unsigned ldsw = (unsigned)wid * 1024u;
    const int aoffl = lds_byte(wr * 64 + fr, fq * 8), boffl = lds_byte(wc * 32 + fr, fq * 8);
#define PG8_SA(b, h) (((b) * 2 + (h)) * HTB)
#define PG8_SB(b, h) ((4 + (b) * 2 + (h)) * HTB)
#define PG8_STAGEB(bufoff, gbase) do { _Pragma("unroll") for (int _i = 0; _i < 2; ++_i) \
        __builtin_amdgcn_global_load_lds((const unsigned*)((const char*)(gbase) + _i * pstepB + voffB), (LAS unsigned*)(lds + (bufoff) + ldsw + _i * 8192), 16, 0, 0); } while (0)
#define PG8_STAGEA(bufoff, TP, OFFS, h, kb) do { _Pragma("unroll") for (int _i = 0; _i < 2; ++_i) { \
        const char* _p; if constexpr (GATHER) _p = Abase + (size_t)(OFFS)[h][_i] + (kb); else _p = (TP) + ((h) * hstepA + _i * pstepA + (kb)) + laneA; \
        __builtin_amdgcn_global_load_lds((const unsigned*)_p, (LAS unsigned*)(lds + (bufoff) + ldsw + _i * 8192), 16, 0, 0); } } while (0)
#define PG8_LDA(dst, b, h) do { _Pragma("unroll") for (int m = 0; m < 4; ++m) _Pragma("unroll") for (int k = 0; k < 2; ++k) dst[m][k] = *(const LAS bf16x8*)(lds + PG8_SA(b, h) + aoffl + m * 2048 + k * 1024); } while (0)
#define PG8_LDB(dst, b, h) do { _Pragma("unroll") for (int n = 0; n < 2; ++n) _Pragma("unroll") for (int k = 0; k < 2; ++k) dst[n][k] = *(const LAS bf16x8*)(lds + PG8_SB(b, h) + boffl + n * 2048 + k * 1024); } while (0)
#define PG8_MMA(ai, bj, At, Bt) do { __builtin_amdgcn_s_setprio(1); _Pragma("unroll") for (int m = 0; m < 4; ++m) _Pragma("unroll") for (int n = 0; n < 2; ++n) _Pragma("unroll") for (int k = 0; k < 2; ++k) \
        acc[ai][bj][m][n] = __builtin_amdgcn_mfma_f32_16x16x32_bf16(Bt[n][k], At[m][k], acc[ai][bj][m][n], 0, 0, 0); __builtin_amdgcn_s_setprio(0); } while (0)
#define PG8_WAIT_V(n) asm volatile("s_waitcnt vmcnt(" #n ")" ::: "memory")
#define PG8_WAIT_L(n) asm volatile("s_waitcnt lgkmcnt(" #n ")" ::: "memory")
#define PG8_BAR __builtin_amdgcn_s_barrier()
#define PG8_SCHED __builtin_amdgcn_sched_barrier(0)
#define PG8_AOFFS(dst, tp, u) do { if constexpr (GATHER) { _Pragma("unroll") for (int _h = 0; _h < 2; ++_h) _Pragma("unroll") for (int _i = 0; _i < 2; ++_i) dst[_h][_i] = aoff(u, _h * 128 + _i * 64 + sR) + (unsigned)sC * 2u; } \
        else tp = aoff(u); } while (0)
    Unit cur, nxt; int ui = 0;
    if (!S.next(0, cur)) return;
    f32x4 acc[2][2][4][2];
#pragma unroll
    for (int a = 0; a < 2; ++a)
#pragma unroll
        for (int b = 0; b < 2; ++b)
#pragma unroll
            for (int m = 0; m < 4; ++m)
#pragma unroll
                for (int n = 0; n < 2; ++n) acc[a][b][m][n] = (f32x4){0.f, 0.f, 0.f, 0.f};
    bf16x8 At[4][2], B0[2][2], B1[2][2];
    unsigned cA[2][2] = {{0u, 0u}, {0u, 0u}}, nA[2][2] = {{0u, 0u}, {0u, 0u}}; const char* cTP = Abase; const char* nTP = Abase;
    PG8_AOFFS(cA, cTP, cur);
    const char* cB = bptr(cur);
    PG8_STAGEB(PG8_SB(0, 0), cB); PG8_STAGEB(PG8_SB(0, 1), cB + hstepB); PG8_STAGEA(PG8_SA(0, 0), cTP, cA, 0, 0); PG8_STAGEA(PG8_SA(0, 1), cTP, cA, 1, 0);
    if (wr == 1) PG8_BAR;
    PG8_WAIT_V(2); PG8_BAR;
    PG8_STAGEB(PG8_SB(1, 0), cB + kstep); PG8_STAGEA(PG8_SA(1, 0), cTP, cA, 0, kstep); PG8_STAGEB(PG8_SB(1, 1), cB + hstepB + kstep);
    PG8_WAIT_V(6); PG8_BAR;
    for (;;) {
        const bool has_next = S.next(ui + 1, nxt);
        const char* nB = cB; nTP = cTP;
        if (has_next) { PG8_AOFFS(nA, nTP, nxt); nB = bptr(nxt); }
        else { if constexpr (GATHER) {
#pragma unroll
            for (int h = 0; h < 2; ++h)
#pragma unroll
                for (int i = 0; i < 2; ++i) nA[h][i] = cA[h][i]; } }
        for (int t = 0; t < nt; t += 2) {
            const bool last = (t == nt - 2);
            const size_t k1 = (size_t)(t + 1) * kstep;
            unsigned a2o[2][2] = {{0u, 0u}, {0u, 0u}};
            if constexpr (GATHER) {
#pragma unroll
                for (int h = 0; h < 2; ++h)
#pragma unroll
                    for (int i = 0; i < 2; ++i) a2o[h][i] = last ? nA[h][i] : cA[h][i]; }
            const char* t2p = last ? nTP : cTP;
            const size_t k2 = last ? 0 : (size_t)(t + 2) * kstep, k3 = k2 + kstep;
            const char* b2 = last ? nB : cB + (size_t)(t + 2) * kstep; const char* b3 = b2 + kstep;
            PG8_LDB(B0, 0, 0); PG8_LDB(B1, 0, 1); PG8_SCHED; PG8_LDA(At, 0, 0); PG8_STAGEA(PG8_SA(1, 1), cTP, cA, 1, k1);
            PG8_WAIT_V(8); PG8_WAIT_L(0); PG8_BAR; PG8_MMA(0, 0, At, B0); PG8_MMA(0, 1, At, B1); PG8_BAR; PG8_SCHED;
            PG8_LDA(At, 0, 1); PG8_STAGEB(PG8_SB(0, 0), b2); PG8_STAGEB(PG8_SB(0, 1), b2 + hstepB); PG8_STAGEA(PG8_SA(0, 0), t2p, a2o, 0, k2);
            PG8_WAIT_V(8); PG8_WAIT_L(0); PG8_BAR; PG8_MMA(1, 0, At, B0); PG8_MMA(1, 1, At, B1); PG8_BAR; PG8_SCHED;
            PG8_LDB(B0, 1, 0); PG8_LDB(B1, 1, 1); PG8_SCHED; PG8_LDA(At, 1, 0); PG8_STAGEA(PG8_SA(0, 1), t2p, a2o, 1, k2);
            PG8_WAIT_V(8); PG8_WAIT_L(0); PG8_BAR; PG8_MMA(0, 0, At, B0); PG8_MMA(0, 1, At, B1); PG8_BAR; PG8_SCHED;
            PG8_LDA(At, 1, 1); PG8_STAGEB(PG8_SB(1, 0), b3); PG8_STAGEB(PG8_SB(1, 1), b3 + hstepB); PG8_STAGEA(PG8_SA(1, 0), t2p, a2o, 0, k3);
            PG8_WAIT_V(8); PG8_WAIT_L(0); PG8_BAR; PG8_MMA(1, 0, At, B0); PG8_MMA(1, 1, At, B1); PG8_BAR; PG8_SCHED;
        }
        if constexpr (ALIGN_EPI) { if (wr == 0) PG8_BAR; }
        { int l2 = lane; asm volatile("" : "+v"(l2)); E(acc, cur, wr, wc, l2 & 15, l2 >> 4); }
        if (!has_next) break;
#pragma unroll
        for (int a = 0; a < 2; ++a)
#pragma unroll
            for (int b = 0; b < 2; ++b)
#pragma unroll
                for (int m = 0; m < 4; ++m)
#pragma unroll
                    for (int n = 0; n < 2; ++n) acc[a][b][m][n] = (f32x4){0.f, 0.f, 0.f, 0.f};
        cur = nxt; cB = nB; cTP = nTP; ++ui;
        if constexpr (GATHER) {
#pragma unroll
            for (int h = 0; h < 2; ++h)
#pragma unroll
                for (int i = 0; i < 2; ++i) cA[h][i] = nA[h][i]; }
        if constexpr (ALIGN_EPI) { if (wr == 1) PG8_BAR; }
    }
    PG8_WAIT_V(0);
    if constexpr (!ALIGN_EPI) { if (wr == 0) PG8_BAR; }
    PG8_BAR;
#undef PG8_SA
#undef PG8_SB
#undef PG8_STAGEA
#undef PG8_STAGEB
#undef PG8_LDA
#undef PG8_LDB
#undef PG8_MMA
#undef PG8_WAIT_V
#undef PG8_WAIT_L
#undef PG8_BAR
#undef PG8_SCHED
#undef PG8_AOFFS
}
}

constexpr float YB_SCALE = 16.f, YB_INV = 1.f / 16.f;
#define FP8C(x) __builtin_amdgcn_fmed3f((x), -440.f, 440.f)
__device__ __forceinline__ u32x2 pack8_fp8(const f32x4& v0, const f32x4& v1) { u32x2 w; int p = __builtin_amdgcn_cvt_pk_fp8_f32(FP8C(v0[0]), FP8C(v0[1]), 0, false); p = __builtin_amdgcn_cvt_pk_fp8_f32(FP8C(v0[2]), FP8C(v0[3]), p, true); w.x = (unsigned)p;
    p = __builtin_amdgcn_cvt_pk_fp8_f32(FP8C(v1[0]), FP8C(v1[1]), 0, false); p = __builtin_amdgcn_cvt_pk_fp8_f32(FP8C(v1[2]), FP8C(v1[3]), p, true); w.y = (unsigned)p; return w; }
struct EpiStore { bf16_t* O; int ldc;
    __device__ __forceinline__ void operator()(const f32x4 (&acc)[2][2][4][2], const pg8::Unit& u, int wr, int wc, int fr, int fq) const {
        bf16_t* base = O + (size_t)(u.pm * 256 + wr * 64 + fr) * ldc + u.pn * 256 + wc * 32 + 8 * fq;
#pragma unroll
        for (int ai = 0; ai < 2; ++ai)
#pragma unroll
            for (int m = 0; m < 4; ++m) { bf16_t* rowp = base + (size_t)(ai * 128 + m * 16) * ldc;
#pragma unroll
                for (int bj = 0; bj < 2; ++bj) *(u32x4*)(rowp + bj * 128) = pg8::pack8(acc[ai][bj][m][0], acc[ai][bj][m][1]);
                asm volatile("" ::: "memory"); } } };
struct EpiG1 { bf16_t* P; float* rs; bf16_t* KR; const float* rope;
    __device__ __forceinline__ void operator()(const f32x4 (&acc)[2][2][4][2], const pg8::Unit& u, int wr, int wc, int fr, int fq) const {
        bf16_t* base = P + (size_t)(u.pm * 256 + wr * 64 + fr) * PW + u.pn * 256 + wc * 32 + 8 * fq;
#pragma unroll
        for (int ai = 0; ai < 2; ++ai)
#pragma unroll
            for (int m = 0; m < 4; ++m) { bf16_t* rowp = base + (size_t)(ai * 128 + m * 16) * PW;
#pragma unroll
                for (int bj = 0; bj < 2; ++bj) *(u32x4*)(rowp + bj * 128) = pg8::pack8(acc[ai][bj][m][0], acc[ai][bj][m][1]);
                asm volatile("" ::: "memory"); }
        if (u.pn < 2) {
#pragma unroll
            for (int ai = 0; ai < 2; ++ai)
#pragma unroll
                for (int m = 0; m < 4; ++m) { const int r = u.pm * 256 + ai * 128 + wr * 64 + m * 16 + fr;
                    const f32x4 a0 = acc[ai][0][m][0], a1 = acc[ai][0][m][1], b0 = acc[ai][1][m][0], b1 = acc[ai][1][m][1];
                    float ss = (a0[0] * a0[0] + a0[1] * a0[1]) + (a0[2] * a0[2] + a0[3] * a0[3]) + (a1[0] * a1[0] + a1[1] * a1[1]) + (a1[2] * a1[2] + a1[3] * a1[3]);
                    if (u.pn == 0) ss += (b0[0] * b0[0] + b0[1] * b0[1]) + (b0[2] * b0[2] + b0[3] * b0[3]) + (b1[0] * b1[0] + b1[1] * b1[1]) + (b1[2] * b1[2] + b1[3] * b1[3]);
                    { float o; const float a = swap16_f(ss, o); ss = a + o; }
                    { auto rr = __builtin_amdgcn_permlane32_swap(__float_as_uint(ss), __float_as_uint(ss), false, false); ss = __uint_as_float(rr[0]) + __uint_as_float(rr[1]); }
                    if (fq == 0) rs[(size_t)r * 8 + u.pn * 4 + wc] = ss;
                    if (u.pn == 1) {
                        f32x4 p0, p1;
#pragma unroll
                        for (int i = 0; i < 4; ++i) { float o; const float a = swap16_f(b0[i], o); p0[i] = (fq & 1) ? a : o; const float c = swap16_f(b1[i], o); p1[i] = (fq & 1) ? c : o; }
                        if (wc == 0) { f32x4 v0 = b0, v1 = b1;
                            if (r < TL) { const int sq = r & (SEQ - 1), pos = (fq & 2) ? (sq & 63) : (sq >> 6); const float* tb = rope + pos * 16;
                                const f32x4 cs0 = *(const f32x4*)tb, cs1 = *(const f32x4*)(tb + 4), sn0 = *(const f32x4*)(tb + 8), sn1 = *(const f32x4*)(tb + 12);
                                if (fq & 1) { v0 = v0 * cs0 + p0 * sn0; v1 = v1 * cs1 + p1 * sn1; } else { v0 = v0 * cs0 - p0 * sn0; v1 = v1 * cs1 - p1 * sn1; } }
                            *(u32x4*)(KR + (size_t)kvrow_of(r) * 32 + 8 * fq) = pg8::pack8(v0, v1); } }
                    asm volatile("" ::: "memory"); } } } };
__device__ __forceinline__ void g1_phase(const Ctx& F0) {
    const Ctx F = fresh(F0);
    pg8::StaticOrder S; S.init(TT, PW, F.G, F.bid);
    const char* Ab = (const char*)(F.ws + WS_H);
    auto aoff = [&](const pg8::Unit& u) { return Ab + (size_t)u.pm * 256 * DM * 2; };
    const char* Bt = (const char*)(F.ws + WS_W + W_WIN);
    auto bptr = [&](const pg8::Unit& u) { return Bt + (size_t)u.pn * 256 * DM * 2; };
    EpiG1 E{(bf16_t*)(F.ws + WS_P), (float*)(F.ws + WS_MISC + M_RS), (bf16_t*)(F.ws + WS_KR), (const float*)(F.ws + WS_MISC + M_ROPE)};
    pg8::gemm256<false>(F.lds, F.tid, Ab, DM * 2, DM, S, aoff, bptr, E);
}
struct EpiQ { bf16_t* Q; bf16_t* QR; const float* rs; const float* rope;
    __device__ __forceinline__ void operator()(const f32x4 (&acc)[2][2][4][2], const pg8::Unit& u, int wr, int wc, int fr, int fq) const {
        float rs8[2][4];
#pragma unroll
        for (int ai = 0; ai < 2; ++ai)
#pragma unroll
            for (int m = 0; m < 4; ++m) { const f32x4 q4 = *(const f32x4*)(rs + (size_t)(u.pm * 256 + ai * 128 + wr * 64 + m * 16 + fr) * 8); rs8[ai][m] = __builtin_amdgcn_rsqf(((q4[0] + q4[1]) + (q4[2] + q4[3])) * (1.f / 256.f) + EPS); }
#pragma unroll
        for (int ai = 0; ai < 2; ++ai)
#pragma unroll
            for (int m = 0; m < 4; ++m) { const int r = u.pm * 256 + ai * 128 + wr * 64 + m * 16 + fr; const float sc = rs8[ai][m] * (ATTN_SCALE * 1.4426950408889634f); const int s = r & (SEQ - 1);
#pragma unroll
                for (int bj = 0; bj < 2; ++bj) { const int col0 = u.pn * 256 + bj * 128 + wc * 32 + 8 * fq, hh = col0 / 96, cw = col0 - hh * 96;
                    f32x4 v0 = acc[ai][bj][m][0] * sc, v1 = acc[ai][bj][m][1] * sc; f32x4 p0, p1;
#pragma unroll
                    for (int i = 0; i < 4; ++i) { p0[i] = __shfl_xor(v0[i], 16); p1[i] = __shfl_xor(v1[i], 16); }
                    if (cw >= 64 && r < TL) { const int c2 = cw - 64, pos = (c2 & 16) ? (s & 63) : (s >> 6); const bool second = (c2 & 8) != 0; const float* tb = rope + pos * 16;
                        *(u32x4*)(QR + (size_t)r * 256 + hh * 32 + c2) = pg8::pack8(v0, v1);
                        const f32x4 cs0 = *(const f32x4*)tb, cs1 = *(const f32x4*)(tb + 4), sn0 = *(const f32x4*)(tb + 8), sn1 = *(const f32x4*)(tb + 12);
                        if (second) { v0 = v0 * cs0 + p0 * sn0; v1 = v1 * cs1 + p1 * sn1; } else { v0 = v0 * cs0 - p0 * sn0; v1 = v1 * cs1 - p1 * sn1; } }
                    *(u32x4*)(Q + (size_t)r * 768 + col0) = pg8::pack8(v0, v1); }
                asm volatile("" ::: "memory"); } } };
struct EpiKV { bf16_t* KV; const float* rs;
    __device__ __forceinline__ void operator()(const f32x4 (&acc)[2][2][4][2], const pg8::Unit& u, int wr, int wc, int fr, int fq) const {
        float rs8[2][4];
#pragma unroll
        for (int ai = 0; ai < 2; ++ai)
#pragma unroll
            for (int m = 0; m < 4; ++m) { const f32x4 q4 = *(const f32x4*)(rs + (size_t)(u.pm * 256 + ai * 128 + wr * 64 + m * 16 + fr) * 8 + 4); rs8[ai][m] = __builtin_amdgcn_rsqf(((q4[0] + q4[1]) + (q4[2] + q4[3])) * (1.f / 128.f) + EPS); }
#pragma unroll
        for (int ai = 0; ai < 2; ++ai)
#pragma unroll
            for (int m = 0; m < 4; ++m) { const int r = u.pm * 256 + ai * 128 + wr * 64 + m * 16 + fr; const float sc = rs8[ai][m]; bf16_t* rowp = KV + (size_t)kvrow_of(r) * 1024 + u.pn * 256 + wc * 32 + 8 * fq;
#pragma unroll
                for (int bj = 0; bj < 2; ++bj) *(u32x4*)(rowp + bj * 128) = pg8::pack8(acc[ai][bj][m][0] * sc, acc[ai][bj][m][1] * sc);
                asm volatile("" ::: "memory"); } } };
struct EpiQKV { EpiKV ekv; EpiQ eq;
    __device__ __forceinline__ void operator()(const f32x4 (&acc)[2][2][4][2], const pg8::Unit& u, int wr, int wc, int fr, int fq) const { if (u.e == 0) ekv(acc, u, wr, wc, fr, fq); else eq(acc, u, wr, wc, fr, fq); } };
__device__ __forceinline__ void g23_phase(const Ctx& F0) {
    const Ctx F = fresh(F0);
    pg8::DualOrder S; S.A.init(TT, 1024, F.G, F.bid); S.B.init(TT, 768, F.G, F.bid); S.G = F.G; S.c = F.bid;
    const char* Abq = (const char*)(F.ws + WS_P);
    auto aoff = [&](const pg8::Unit& u) { return Abq + (size_t)(u.e == 0 ? OFF_KV * 2 : 0) + (size_t)u.pm * 256 * PW * 2; };
    const char* Wb = (const char*)(F.ws + WS_W);
    auto bptr = [&](const pg8::Unit& u) { return Wb + (size_t)(u.e == 0 ? W_WKV : W_WQ) + (size_t)u.pn * 256 * 256 * 2; };
    EpiQKV E{EpiKV{(bf16_t*)(F.ws + WS_KV), (const float*)(F.ws + WS_MISC + M_RS)}, EpiQ{(bf16_t*)(F.ws + WS_Q), (bf16_t*)(F.ws + WS_QR), (const float*)(F.ws + WS_MISC + M_RS), (const float*)(F.ws + WS_MISC + M_ROPE)}};
    pg8::gemm256<false>(F.lds, F.tid, Abq, PW * 2, 256, S, aoff, bptr, E);
}
struct EpiStore8 { unsigned char* O;
    __device__ __forceinline__ void operator()(const f32x4 (&acc)[2][2][4][2], const pg8::Unit& u, int wr, int wc, int fr, int fq) const {
        unsigned char* base = O + (size_t)(u.pm * 256 + wr * 64 + fr) * DM + u.pn * 256 + wc * 64 + 16 * fq;
#pragma unroll
        for (int ai = 0; ai < 2; ++ai)
#pragma unroll
            for (int m = 0; m < 4; ++m) { const u32x2 lo = pack8_fp8(acc[ai][0][m][0] * YB_SCALE, acc[ai][0][m][1] * YB_SCALE), hi = pack8_fp8(acc[ai][1][m][0] * YB_SCALE, acc[ai][1][m][1] * YB_SCALE);
                *(u32x4*)(base + (size_t)(ai * 128 + m * 16) * DM) = (u32x4){lo.x, lo.y, hi.x, hi.y};
                asm volatile("" ::: "memory"); } } };
__device__ __forceinline__ void g4_phase(const Ctx& F0, int nrows) {
    const Ctx F = fresh(F0);
    pg8::StaticOrder S; S.init(nrows, DM, F.G, F.bid);
    const char* Ab = (const char*)(F.ws + WS_MIX);
    auto aoff = [&](const pg8::Unit& u) { return Ab + (size_t)u.pm * 256 * DM * 2; };
    const char* Bt = (const char*)(F.ws + WS_W + W_WO);
    auto bptr = [&](const pg8::Unit& u) { return Bt + (size_t)u.pn * 256 * DM * 2; };
    EpiStore8 E{(unsigned char*)(F.ws + WS_Y1)};
    pg8::gemm256<false>(F.lds, F.tid, Ab, DM * 2, DM, S, aoff, bptr, E);
}

constexpr int LDS_ET = 139264, LDS_TE = LDS_ET + 512, LDS_RT = LDS_TE + 3072;
static_assert(LDS_RT + 8192 <= LDS_XB, "LDS tables");
__device__ __forceinline__ void expert_tables(const Ctx& F, int l, int nrows) {
    LAS int* tl = (LAS int*)(F.lds + LDS_ET); LAS int* cnt = tl + 64; LAS int* te = (LAS int*)(F.lds + LDS_TE);
    if (F.tid == 0) { int acc = 0;
        for (int e = 0; e < 33; ++e) { const int c = e < 32 ? (int)__hip_atomic_load(((unsigned*)(F.ws + WS_CTL)) + CW_GCNT + l * 64 + e, __ATOMIC_RELAXED, __HIP_MEMORY_SCOPE_AGENT) : nrows; cnt[e] = c; tl[e] = acc; acc += (c + 255) / 256; }
        tl[33] = acc; }
    __syncthreads();
    const int nmt = tl[33];
    for (int mt = F.tid; mt < nmt && mt < 768; mt += NTHR) { int e = 0; while (e < 32 && mt >= tl[e + 1]) ++e; te[mt] = e; }
    __syncthreads();
}
struct EpiGU { bf16_t* HB;
    __device__ __forceinline__ void operator()(const f32x4 (&acc)[2][2][4][2], const pg8::Unit& u, int wr, int wc, int fr, int fq) const {
#pragma unroll
        for (int ai = 0; ai < 2; ++ai)
#pragma unroll
            for (int m = 0; m < 4; ++m) { const int rl = ai * 128 + wr * 64 + m * 16 + fr;
                if (rl < u.nvalid) { f32x4 h0, h1;
#pragma unroll
                    for (int i = 0; i < 4; ++i) { h0[i] = silu(acc[ai][0][m][0][i]) * acc[ai][1][m][0][i]; h1[i] = silu(acc[ai][0][m][1][i]) * acc[ai][1][m][1][i]; }
                    *(u32x4*)(HB + (size_t)(u.base + u.pm * 256 + rl) * 256 + u.pn * 128 + wc * 32 + 8 * fq) = pg8::pack8(h0, h1); }
                asm volatile("" ::: "memory"); } } };
__device__ __forceinline__ void g5_phase(const Ctx& F0, int l, int nrows) {
    const Ctx F = fresh(F0);
    expert_tables(F, l, nrows);
    const LAS int* tl = (const LAS int*)(F.lds + LDS_ET); const LAS int* cnt = tl + 64;
    pg8::ExpertOrder S; S.init(tl, cnt, (const LAS int*)(F.lds + LDS_TE), 2, F.G, F.bid);
    const int* list = (const int*)(F.ws + WS_MISC + M_LIST);
    LAS unsigned* rowtab = (LAS unsigned*)(F.lds + LDS_RT);
    { pg8::Unit u;
      for (int i = 0; i < 8 && S.next(i, u); ++i) if (F.tid < 256) { int r = u.pm * 256 + F.tid; const int lastv = u.pm * 256 + u.nvalid - 1; r = r < lastv ? r : lastv;
          const int tok = u.e < 32 ? list[(size_t)u.e * TT + r] : r; rowtab[i * 256 + F.tid] = (unsigned)tok * (unsigned)(DM * 2); }
      __syncthreads(); }
    auto aoff = [&](const pg8::Unit& u, int R) { return rowtab[(u.idx & 7) * 256 + R]; };
    const char* Bt = (const char*)(F.ws + WS_W + W_WGU);
    auto bptr = [&](const pg8::Unit& u) { return Bt + ((size_t)u.e * 512 + (size_t)u.pn * 256) * DM * 2; };
    EpiGU E{(bf16_t*)(F.ws + WS_HB)};
    pg8::gemm256<true>(F.lds, F.tid, (const char*)(F.ws + WS_H), DM * 2, DM, S, aoff, bptr, E);
}
struct EpiD { unsigned char* YB; unsigned char* YS8; const float* listw;
    __device__ __forceinline__ void operator()(const f32x4 (&acc)[2][2][4][2], const pg8::Unit& u, int wr, int wc, int fr, int fq) const {
        float g8[2][4];
#pragma unroll
        for (int ai = 0; ai < 2; ++ai)
#pragma unroll
            for (int m = 0; m < 4; ++m) { const int rl = ai * 128 + wr * 64 + m * 16 + fr; g8[ai][m] = (u.e < 32 && rl < u.nvalid) ? listw[(size_t)u.e * TT + u.pm * 256 + rl] : 1.f; }
#pragma unroll
        for (int ai = 0; ai < 2; ++ai)
#pragma unroll
            for (int m = 0; m < 4; ++m) { const int rl = ai * 128 + wr * 64 + m * 16 + fr;
                if (rl < u.nvalid) { const int i = u.pm * 256 + rl; const int co = u.pn * 256 + wc * 64 + 16 * fq;
                    if (u.e < 32) { const float g = g8[ai][m] * YB_SCALE; const u32x2 lo = pack8_fp8(acc[ai][0][m][0] * g, acc[ai][0][m][1] * g), hi = pack8_fp8(acc[ai][1][m][0] * g, acc[ai][1][m][1] * g);
                        *(u32x4*)(YB + (size_t)(u.base + i) * DM + co) = (u32x4){lo.x, lo.y, hi.x, hi.y}; }
                    else { const u32x2 lo = pack8_fp8(acc[ai][0][m][0] * YB_SCALE, acc[ai][0][m][1] * YB_SCALE), hi = pack8_fp8(acc[ai][1][m][0] * YB_SCALE, acc[ai][1][m][1] * YB_SCALE);
                        *(u32x4*)(YS8 + (size_t)i * DM + co) = (u32x4){lo.x, lo.y, hi.x, hi.y}; } }
                asm volatile("" ::: "memory"); } } };
__device__ __forceinline__ void g6_phase(const Ctx& F0, int l, int nrows) {
    const Ctx F = fresh(F0);
    expert_tables(F, l, nrows);
    const LAS int* tl = (const LAS int*)(F.lds + LDS_ET); const LAS int* cnt = tl + 64;
    pg8::ExpertOrder S; S.init(tl, cnt, (const LAS int*)(F.lds + LDS_TE), 4, F.G, F.bid);
    const char* Ab = (const char*)(F.ws + WS_HB);
    auto aoff = [&](const pg8::Unit& u) { return Ab + (size_t)(u.base + u.pm * 256) * 512; };
    const char* Bt = (const char*)(F.ws + WS_W + W_WD);
    auto bptr = [&](const pg8::Unit& u) { return Bt + ((size_t)u.e * DM + (size_t)u.pn * 256) * 256 * 2; };
    EpiD E{(unsigned char*)(F.ws + WS_YB), (unsigned char*)(F.ws + WS_YS8), (const float*)(F.ws + WS_MISC + M_LISTW)};
    pg8::gemm256<false>(F.lds, F.tid, Ab, 512, 256, S, aoff, bptr, E);
}

namespace att2 {
typedef float f32x16 __attribute__((ext_vector_type(16)));
typedef short s16x4 __attribute__((ext_vector_type(4)));
constexpr int NW = 8, QBLK = 32, QB = 256, KVBLK = 64;
__device__ __forceinline__ int crow(int r, int hi) { return (r & 3) + 8 * (r >> 2) + 4 * hi; }
#define SBAR() __builtin_amdgcn_sched_barrier(0)
constexpr int SLOTB = 8192, RSLOTB = 4096;
constexpr int LDS_K = 0, LDS_V = 4 * SLOTB, LDS_R = 8 * SLOTB, LDS_WS = LDS_R + 4 * RSLOTB, LDS_OST = LDS_WS + NW * 64 * 4, LDS_BYTES_ATT = LDS_OST + NW * 4096;
static_assert(LDS_BYTES_ATT <= 131072, "attention LDS");
__device__ __forceinline__ void glds16s(const void* sbase, unsigned voff, unsigned lds_dst) { unsigned keep;
  asm volatile("s_mov_b32 %0, m0\n\ts_mov_b32 m0, %3\n\ts_nop 0\n\tglobal_load_lds_dwordx4 %1, %2\n\ts_mov_b32 m0, %0" : "=&s"(keep) : "v"(voff), "s"(sbase), "s"(lds_dst) : "memory"); }
__device__ __forceinline__ float max3f(float a, float b, float c) { float r; asm("v_max3_f32 %0, %1, %2, %3" : "=v"(r) : "v"(a), "v"(b), "v"(c)); return r; }
__device__ __forceinline__ float max2f(float a, float b) { float r; asm("v_max_f32_e32 %0, %1, %2" : "=v"(r) : "v"(a), "v"(b)); return r; }
__device__ __forceinline__ float fadd_s(float a, float b) { float r; asm("v_add_f32_e32 %0, %1, %2" : "=v"(r) : "v"(a), "v"(b)); return r; }
__device__ __forceinline__ float fsub_s(float a, float b) { float r; asm("v_sub_f32_e32 %0, %1, %2" : "=v"(r) : "v"(a), "v"(b)); return r; }
typedef float f32x2_t __attribute__((ext_vector_type(2))); typedef __bf16 bf16x2_t __attribute__((ext_vector_type(2)));
__device__ __forceinline__ unsigned cvtpk_s(float lo, float hi) { f32x2_t v = {lo, hi}; bf16x2_t b = __builtin_convertvector(v, bf16x2_t); return __builtin_bit_cast(unsigned, b); }
#define WAIT_BAR(N) asm volatile("s_waitcnt vmcnt(" #N ") lgkmcnt(0)\n\ts_barrier" ::: "memory")
#define WAIT_T() do { if (wid < 4) { WAIT_BAR(3); } else { WAIT_BAR(2); } } while (0)
typedef __attribute__((address_space(3))) const char* lds_cptr;
typedef short v4i16_t __attribute__((ext_vector_type(4)));
#define LDSF(p) (*(const __attribute__((address_space(3))) bf16x8*)(p))
#define KFRAG(kp, rp, j) ((j) < 8 ? LDSF((kp) + ((j) >> 1) * 2048 + ((j) & 1) * 512) : LDSF((rp) + (((j) - 8) >> 1) * 2048 + ((j) & 1) * 512))
__device__ __forceinline__ void qkt0(f32x16& p0, f32x16& p1, lds_cptr kp, lds_cptr rp, const bf16x8* qr, const f32x16& negm) {
#pragma unroll
  for (int d0 = 0; d0 < 6; ++d0) {
    const bf16x8 b0 = KFRAG(kp, rp, 2 * d0), b1 = KFRAG(kp, rp, 2 * d0 + 1);
    if (d0 == 0) { p0 = __builtin_amdgcn_mfma_f32_32x32x16_bf16(b0, qr[0], negm, 0, 0, 0); p1 = __builtin_amdgcn_mfma_f32_32x32x16_bf16(b1, qr[0], negm, 0, 0, 0); }
    else { p0 = __builtin_amdgcn_mfma_f32_32x32x16_bf16(b0, qr[d0], p0, 0, 0, 0); p1 = __builtin_amdgcn_mfma_f32_32x32x16_bf16(b1, qr[d0], p1, 0, 0, 0); } }
}
__device__ __forceinline__ s16x4 vtr(lds_cptr p) { return __builtin_bit_cast(s16x4, __builtin_amdgcn_ds_read_tr16_b64_v4i16((__attribute__((address_space(3))) v4i16_t*)p)); }
__device__ __forceinline__ float rowmax(const f32x16& p0, const f32x16& p1) {
  float a = max3f(p0[0], p0[1], p1[0]), b = max3f(p0[2], p0[3], p1[1]); a = max3f(a, p1[2], p1[3]);
#pragma unroll
  for (int r = 4; r < 16; r += 4) { a = max3f(a, p0[r], p0[r + 1]); b = max3f(b, p0[r + 2], p0[r + 3]); a = max3f(a, p1[r], p1[r + 1]); b = max3f(b, p1[r + 2], p1[r + 3]); }
  const float m = max2f(a, b);
  auto rr = __builtin_amdgcn_permlane32_swap(__float_as_uint(m), __float_as_uint(m), false, false);
  return max2f(__uint_as_float(rr[0]), __uint_as_float(rr[1]));
}
__device__ __forceinline__ void pv(f32x16* o, int vb, bf16x8 pa0, bf16x8 pa1, bf16x8 pa2, bf16x8 pa3) {
#pragma unroll
  for (int d0 = 0; d0 < 2; ++d0) { s16x4 lo[4], hi[4];
#pragma unroll
    for (int ks = 0; ks < 4; ++ks) {
      asm volatile("ds_read_b64_tr_b16 %0,%1 offset:%c2" : "=&v"(lo[ks]) : "v"(vb), "i"(d0 * 4096 + ks * 1024) : "memory");
      asm volatile("ds_read_b64_tr_b16 %0,%1 offset:%c2" : "=&v"(hi[ks]) : "v"(vb), "i"(d0 * 4096 + ks * 1024 + 512) : "memory"); }
    asm volatile("s_waitcnt lgkmcnt(0)" ::: "memory"); SBAR();
#define PK(k) (bf16x8){lo[k][0], lo[k][1], lo[k][2], lo[k][3], hi[k][0], hi[k][1], hi[k][2], hi[k][3]}
    o[d0] = __builtin_amdgcn_mfma_f32_32x32x16_bf16(pa0, PK(0), o[d0], 0, 0, 0);
    o[d0] = __builtin_amdgcn_mfma_f32_32x32x16_bf16(pa1, PK(1), o[d0], 0, 0, 0);
    o[d0] = __builtin_amdgcn_mfma_f32_32x32x16_bf16(pa2, PK(2), o[d0], 0, 0, 0);
    o[d0] = __builtin_amdgcn_mfma_f32_32x32x16_bf16(pa3, PK(3), o[d0], 0, 0, 0);
#undef PK
  }
}
template <int THRL, unsigned VAR = 0u> __device__ __forceinline__ void attn_unit(const bf16_t* Q, const bf16_t* QRb, const bf16_t* __restrict__ KV, const bf16_t* __restrict__ KR, bf16_t* O,
                                                             int qrow0, int h, int kvb, int NT, int NRAW, char* shm, int tid) {
  const int lane = tid & 63, r32 = lane & 31, hi = lane >> 5; const int wid = __builtin_amdgcn_readfirstlane(tid >> 6);
  const bf16_t* Qw = Q + (size_t)(qrow0 + wid * QBLK) * 768 + h * 96;
  const bf16_t* Kh = KV + (size_t)kvb * 1024 + h * 128; const bf16_t* Rh = KR + (size_t)kvb * 32;
  const unsigned lds0 = (unsigned)(uintptr_t)shm;
  float* wsf = (float*)(shm + LDS_WS) + wid * 64;
  const unsigned koff = (unsigned)(lane * 1024 + wid * 8) * 2u, voff = (unsigned)((16 * (wid & 3) + (lane >> 2)) * 1024 + 64 + (wid >> 2) * 32 + (lane & 3) * 8) * 2u, roff = (unsigned)(lane * 32 + (wid & 3) * 8) * 2u;
  const unsigned kdst = lds0 + LDS_K + wid * 1024, vdst = lds0 + LDS_V + wid * 1024, rdst = lds0 + LDS_R + (wid & 3) * 1024;
#define DMA_T(t) do { const char* kb_ = (const char*)Kh + (size_t)(t) * (KVBLK * 2048); const char* rb_ = (const char*)Rh + (size_t)(t) * (KVBLK * 64); \
                      glds16s(kb_, koff, (unsigned)__builtin_amdgcn_readfirstlane(kdst + ((t) & 3) * SLOTB)); \
                      if (wid < 4) glds16s(rb_, roff, (unsigned)__builtin_amdgcn_readfirstlane(rdst + ((t) & 3) * RSLOTB)); \
                      glds16s(kb_, voff, (unsigned)__builtin_amdgcn_readfirstlane(vdst + ((t) & 3) * SLOTB)); } while (0)
  const int vb0 = (int)(lds0 + LDS_V) + ((lane >> 4) & 1) * 32 + (lane & 3) * 8 + (4 * hi + ((lane & 15) >> 2)) * 64;
  const lds_cptr shm3 = (lds_cptr)shm; const lds_cptr kp0 = shm3 + LDS_K + hi * 1024 + r32 * 16; const lds_cptr rp0 = shm3 + LDS_R + hi * 1024 + r32 * 16;
  const lds_cptr vp0 = shm3 + LDS_V + ((lane >> 4) & 1) * 32 + (lane & 3) * 8 + (4 * hi + ((lane & 15) >> 2)) * 64;
  bf16x8 qr[6];
#pragma unroll
  for (int d0 = 0; d0 < 4; ++d0) qr[d0] = *reinterpret_cast<const bf16x8*>(&Qw[(size_t)r32 * 768 + d0 * 16 + hi * 8]);
  { const bf16_t* qp = NRAW > 0 ? QRb + (size_t)(qrow0 + wid * QBLK + r32) * 256 + h * 32 + hi * 8 : Qw + (size_t)r32 * 768 + 64 + hi * 8;
    qr[4] = *reinterpret_cast<const bf16x8*>(qp); qr[5] = *reinterpret_cast<const bf16x8*>(qp + 16); }
  const lds_cptr qp0 = shm3 + LDS_OST + wid * 4096 + lane * 16;
#pragma unroll
  for (int d0 = 0; d0 < 4; ++d0) *(__attribute__((address_space(3))) bf16x8*)(shm3 + LDS_OST + wid * 4096 + lane * 16 + d0 * 1024) = qr[d0];
#define QF(d0) LDSF(qp0 + (d0) * 1024)
  DMA_T(0); DMA_T(1);
  float mhat = 0.f, l_reg = 0.f; f32x16 o[2], negm; { float z0 = 0.f; asm volatile("" : "+v"(z0));
#pragma unroll
    for (int r = 0; r < 16; ++r) { o[0][r] = z0; o[1][r] = z0; negm[r] = z0; } }
  asm volatile("" : "+v"(negm));
  bool resc = false;
#define START(P0, P1) do { const float rm = rowmax(P0, P1); resc = false; \
    { const float dl = rm; mhat = fadd_s(mhat, dl); \
      _Pragma("unroll") for (int r = 0; r < 16; ++r) { P0[r] = fsub_s(P0[r], dl); P1[r] = fsub_s(P1[r], dl); } \
      _Pragma("unroll") for (int r = 0; r < 16; ++r) negm[r] = -mhat; asm volatile("" : "+v"(negm)); } \
    _Pragma("unroll") for (int r = 0; r < 16; ++r) P0[r] = __builtin_amdgcn_exp2f(P0[r]); } while (0)
#define RESC() do { if (resc) { asm volatile("s_waitcnt lgkmcnt(0)" ::: "memory"); \
      _Pragma("unroll") for (int d_ = 0; d_ < 2; ++d_) _Pragma("unroll") for (int r = 0; r < 16; ++r) o[d_][r] *= wsf[crow(r, hi)]; } } while (0)
  f32x16 pA0, pA1, pB0, pB1;
  WAIT_T();
  qkt0(pA0, pA1, kp0, rp0, qr, negm); asm volatile("s_nop 15\n\ts_nop 7" : "+v"(pA0), "+v"(pA1));
  START(pA0, pA1);
  _Pragma("unroll") for (int r = 0; r < 16; ++r) pA1[r] = __builtin_amdgcn_exp2f(pA1[r]);
  DMA_T(2);
  WAIT_T();
  s16x4 vl0, vh0, vl1, vh1, vl2, vh2, vl3, vh3; u32x4 pw0, pw1, pw2, pw3; bf16x8 fa, fb, fc, fd;
#define PKW(P, B) cvtpk_s(P[B], P[B + 1])
#define PAF(k) __builtin_bit_cast(bf16x8, pw##k)
#define VFS(s) (bf16x8){vl##s[0], vl##s[1], vl##s[2], vl##s[3], vh##s[0], vh##s[1], vh##s[2], vh##s[3]}
#define PIN(x) asm volatile("" : "+v"(x))
#define MX3(a, b, c) __builtin_fmaxf(__builtin_fmaxf((a), (b)), (c))
#define GAPA(MF, A0, A1, A2, A3, W0, W1, PW) do { MF; if constexpr (!(VAR & 4u)) { sacc += A0; sacc += A1; sacc += A2; sacc += A3; PIN(sacc); W0; W1; PIN(PW); } SBAR(); } while (0)
#define GAPR(MF) do { MF; SBAR(); } while (0)
#define EX(v) ((VAR & 2u) ? (v) : __builtin_amdgcn_exp2f(v))
#define GAPB(MF, X, B) do { MF; X[B] = EX(X[B]); X[B + 1] = EX(X[B + 1]); X[B + 2] = EX(X[B + 2]); X[B + 3] = EX(X[B + 3]); PIN(X); SBAR(); } while (0)
#define VRD(s, i) do { vl##s = vtr(vp_ + (((i) >> 2) * 4096 + ((i) & 3) * 1024)); vh##s = vtr(vp_ + (((i) >> 2) * 4096 + ((i) & 3) * 1024 + 512)); } while (0)
#define MF32(A, B, C) ((VAR & 16u) ? (C) : __builtin_amdgcn_mfma_f32_32x32x16_bf16(A, B, C, 0, 0, 0))
#define STEP(C0, C1, P0, P1, t, GD) do { SBAR(); \
    const lds_cptr vp_ = vp0 + (((t) - 1) & 3) * SLOTB; const lds_cptr kp_ = kp0 + ((t) & 3) * SLOTB; const lds_cptr rp_ = rp0 + ((t) & 3) * RSLOTB; \
    fa = KFRAG(kp_, rp_, 0); fb = KFRAG(kp_, rp_, 1); fc = KFRAG(kp_, rp_, 2); fd = KFRAG(kp_, rp_, 3); \
    VRD(0, 0); SBAR(); float sacc = (P0[0] + P0[1]); \
    GAPA(C0 = MF32(fa, qr[0], negm), P0[2], P0[3], P0[4], P0[5],     pw0[0] = PKW(P0, 0), pw0[1] = PKW(P0, 2), pw0); fa = KFRAG(kp_, rp_, 4); \
    VRD(1, 4); SBAR(); GAPA(C1 = MF32(fb, qr[0], negm), P0[6], P0[7], P0[8], P0[9],     pw0[2] = PKW(P0, 4), pw0[3] = PKW(P0, 6), pw0); fb = KFRAG(kp_, rp_, 5); \
    VRD(2, 1); SBAR(); GAPA(C0 = MF32(fc, qr[1], C0),   P0[10], P0[11], P0[12], P0[13], pw1[0] = PKW(P0, 8), pw1[1] = PKW(P0, 10), pw1); fc = KFRAG(kp_, rp_, 6); \
    VRD(3, 5); SBAR(); GAPA(C1 = MF32(fd, qr[1], C1),   P0[14], P0[15], P1[0], P1[1],   pw1[2] = PKW(P0, 12), pw1[3] = PKW(P0, 14), pw1); fd = KFRAG(kp_, rp_, 7); \
    SBAR(); GAPA(C0 = MF32(fa, qr[2], C0),   P1[2], P1[3], P1[4], P1[5],     pw2[0] = PKW(P1, 0), pw2[1] = PKW(P1, 2), pw2); fa = KFRAG(kp_, rp_, 8); \
    SBAR(); GAPA(C1 = MF32(fb, qr[2], C1),   P1[6], P1[7], P1[8], P1[9],     pw2[2] = PKW(P1, 4), pw2[3] = PKW(P1, 6), pw2); fb = KFRAG(kp_, rp_, 9); \
    SBAR(); GAPA(C0 = MF32(fc, qr[3], C0),   P1[10], P1[11], P1[12], P1[13], pw3[0] = PKW(P1, 8), pw3[1] = PKW(P1, 10), pw3); fc = KFRAG(kp_, rp_, 10); \
    SBAR(); GAPA(C1 = MF32(fd, qr[3], C1),   P1[14], P1[15], 0.f, 0.f,       pw3[2] = PKW(P1, 12), pw3[3] = PKW(P1, 14), pw3); fd = KFRAG(kp_, rp_, 11); \
    SBAR(); GAPR(C0 = MF32(fa, qr[4], C0)); GAPR(C1 = MF32(fb, qr[4], C1)); GAPR(C0 = MF32(fc, qr[5], C0)); GAPR(C1 = MF32(fd, qr[5], C1)); \
    l_reg += sacc; \
    if constexpr (!(VAR & 1u)) { if (GD) { DMA_T((t) + 2); } } \
    { float a = MX3(C0[0], C0[1], C1[0]), b = MX3(C0[2], C0[3], C1[1]); a = MX3(a, C1[2], C1[3]); \
      _Pragma("unroll") for (int r = 4; r < 16; r += 4) { a = MX3(a, C0[r], C0[r + 1]); b = MX3(b, C0[r + 2], C0[r + 3]); a = MX3(a, C1[r], C1[r + 1]); b = MX3(b, C1[r + 2], C1[r + 3]); } \
      float rm = __builtin_fmaxf(a, b); { auto rr = __builtin_amdgcn_permlane32_swap(__float_as_uint(rm), __float_as_uint(rm), false, false); rm = __builtin_fmaxf(__uint_as_float(rr[0]), __uint_as_float(rr[1])); } \
      resc = false; \
      if (__builtin_expect(__any(rm > (float)THRL), 0)) { const float dl = __builtin_fmaxf(rm, 0.f); mhat += dl; \
        _Pragma("unroll") for (int r = 0; r < 16; ++r) { C0[r] -= dl; C1[r] -= dl; } \
        _Pragma("unroll") for (int r = 0; r < 16; ++r) negm[r] = -mhat; asm volatile("" : "+v"(negm)); \
        const float f = __builtin_amdgcn_exp2f(-dl); l_reg *= f; if (hi == 0) wsf[r32] = f; resc = true; } } \
    SBAR(); \
    GAPB(o[0] = MF32(PAF(0), VFS(0), o[0]), C0, 0); \
    GAPB(o[1] = MF32(PAF(0), VFS(1), o[1]), C0, 4); VRD(0, 2); VRD(1, 6); SBAR(); \
    GAPB(o[0] = MF32(PAF(1), VFS(2), o[0]), C0, 8); \
    GAPB(o[1] = MF32(PAF(1), VFS(3), o[1]), C0, 12); VRD(2, 3); VRD(3, 7); SBAR(); \
    GAPB(o[0] = MF32(PAF(2), VFS(0), o[0]), C1, 0); \
    GAPB(o[1] = MF32(PAF(2), VFS(1), o[1]), C1, 4); \
    GAPB(o[0] = MF32(PAF(3), VFS(2), o[0]), C1, 8); \
    GAPB(o[1] = MF32(PAF(3), VFS(3), o[1]), C1, 12); \
    } while (0)
#define QSW(tt) do { if ((tt) == NRAW) { qr[4] = *reinterpret_cast<const bf16x8*>(&Qw[(size_t)r32 * 768 + 64 + hi * 8]); qr[5] = *reinterpret_cast<const bf16x8*>(&Qw[(size_t)r32 * 768 + 80 + hi * 8]); } } while (0)
#define ENDW(tt) do { if ((tt) + 2 < NT) { WAIT_T(); } else { WAIT_BAR(0); } } while (0)
  int t = 1;
  for (; t + 3 < NT; t += 2) {
    STEP(pB0, pB1, pA0, pA1, t, true);     if constexpr (VAR & 8u) { asm volatile("s_waitcnt vmcnt(3) lgkmcnt(0)" ::: "memory"); } else { WAIT_T(); } RESC(); QSW(t + 1);
    STEP(pA0, pA1, pB0, pB1, t + 1, true); if constexpr (VAR & 8u) { asm volatile("s_waitcnt vmcnt(3) lgkmcnt(0)" ::: "memory"); } else { WAIT_T(); } RESC(); QSW(t + 2);
  }
  for (; t + 1 < NT; t += 2) {
    STEP(pB0, pB1, pA0, pA1, t, (t + 2 < NT));     ENDW(t);     RESC(); QSW(t + 1);
    STEP(pA0, pA1, pB0, pB1, t + 1, (t + 3 < NT)); ENDW(t + 1); RESC(); QSW(t + 2);
  }
  STEP(pB0, pB1, pA0, pA1, NT - 1, false); WAIT_BAR(0); RESC();
  { float sacc = pB0[0] + pB0[1]; _Pragma("unroll") for (int r = 2; r < 16; ++r) sacc += pB0[r]; _Pragma("unroll") for (int r = 0; r < 16; ++r) sacc += pB1[r]; l_reg += sacc;
    pw0 = (u32x4){PKW(pB0, 0), PKW(pB0, 2), PKW(pB0, 4), PKW(pB0, 6)}; pw1 = (u32x4){PKW(pB0, 8), PKW(pB0, 10), PKW(pB0, 12), PKW(pB0, 14)}; pw2 = (u32x4){PKW(pB1, 0), PKW(pB1, 2), PKW(pB1, 4), PKW(pB1, 6)}; pw3 = (u32x4){PKW(pB1, 8), PKW(pB1, 10), PKW(pB1, 12), PKW(pB1, 14)};
    SBAR(); pv(o, vb0 + ((NT - 1) & 3) * SLOTB, PAF(0), PAF(1), PAF(2), PAF(3)); }
#undef PKW
#undef PAF
#undef VFS
#undef PIN
#undef MX3
#undef GAPA
#undef GAPR
#undef GAPB
#undef EX
#undef VRD
#undef MF32
#undef STEP
#undef ENDW
#undef QSW
  { auto rr = __builtin_amdgcn_permlane32_swap(__float_as_uint(l_reg), __float_as_uint(l_reg), false, false); l_reg = __uint_as_float(rr[0]) + __uint_as_float(rr[1]); }
  if (hi == 0) wsf[32 + r32] = l_reg; asm volatile("s_waitcnt lgkmcnt(0)" ::: "memory");
  float rli[16];
#pragma unroll
  for (int r = 0; r < 16; ++r) rli[r] = __builtin_amdgcn_rcpf(wsf[32 + crow(r, hi)]);
  bf16_t* Ow = O + (size_t)(qrow0 + wid * QBLK) * DM + h * 64;
  { bf16_t* stg = (bf16_t*)(shm + LDS_OST) + wid * 2048;
#pragma unroll
    for (int r = 0; r < 16; ++r) { const int orow = crow(r, hi);
#pragma unroll
      for (int d0 = 0; d0 < 2; ++d0) stg[orow * 64 + d0 * 32 + r32] = (bf16_t)f2bf(o[d0][r] * rli[r]); }
    asm volatile("s_waitcnt lgkmcnt(0)" ::: "memory");
#pragma unroll
    for (int i = 0; i < 4; ++i) { const int row = i * 8 + (lane >> 3), ch = lane & 7; const u32x4 v = *(const u32x4*)(stg + row * 64 + ch * 8); *(u32x4*)(Ow + (size_t)row * DM + ch * 8) = v; } }
  asm volatile("s_waitcnt vmcnt(0) lgkmcnt(0)\n\ts_barrier" ::: "memory");
#undef DMA_T
#undef START
#undef RESC
#undef QF
}
#undef SBAR
#undef WAIT_BAR
#undef WAIT_T
#undef LDSF
#undef KFRAG
}
template <unsigned VAR = 0u> __device__ __forceinline__ void attn_mfma_phase(const Ctx& F0, bool with_ctx_queries) {
    const Ctx F = fresh(F0);
    const bf16_t* Qp = (const bf16_t*)(F.ws + WS_Q); const bf16_t* QRp = (const bf16_t*)(F.ws + WS_QR); const bf16_t* KVp = (const bf16_t*)(F.ws + WS_KV); const bf16_t* KRp = (const bf16_t*)(F.ws + WS_KR);
    bf16_t* Op = (bf16_t*)(F.ws + WS_MIX);
    char* shm = (char*)(unsigned char*)F.lds;
    const int xg = F.bid & 7, slot = F.bid >> 3;
    if (F.G == 256) {
        for (int i = 0; i < 4; ++i) { const int bh = 8 * i + xg, b = bh >> 3, h = bh & 7;
            att2::attn_unit<8, VAR>(Qp, QRp, KVp, KRp, Op, b * SEQ + slot * 256, h, b * KVS, KVS / 64, CTXL / 64, shm, F.tid); }
    } else {
        for (int u = F.bid; u < 1024; u += F.G) { const int bh = u >> 5, b = bh >> 3, h = bh & 7;
            att2::attn_unit<8, VAR>(Qp, QRp, KVp, KRp, Op, b * SEQ + (u & 31) * 256, h, b * KVS, KVS / 64, CTXL / 64, shm, F.tid); }
    }
    if (with_ctx_queries) for (int u = F.bid; u < 32; u += F.G) { const int b = u >> 3, h = u & 7;
        att2::attn_unit<8, VAR>(Qp, QRp, KVp, KRp, Op, TL + b * CTXL, h, b * KVS, CTXL / 64, 0, shm, F.tid); }
    __syncthreads();
}

__device__ __forceinline__ void mixers_phase(const Ctx& F0, int l, int nrows, unsigned var = 0u) {
    const Ctx F = fresh(F0);
    LAS float* U = (LAS float*)F.lds;
    LAS float* Y = U + 62 * 256;
    const int c = F.tid & 255, hf = F.tid >> 8, tid = F.tid;
    const float* dwp = F.a->in[I_CDW] + (size_t)l * CONVK * 256 + c;
    float dw[CONVK];
#pragma unroll
    for (int k = 0; k < CONVK; ++k) dw[k] = dwp[k * 256];
    const float cb = F.a->in[I_CB][l * 256 + c];
    const bf16_t* Pp = (const bf16_t*)(F.ws + WS_P); bf16_t* MIXp = (bf16_t*)(F.ws + WS_MIX);
    const int nunits = nrows / 32, nfull = (nunits / F.G) * F.G, nrounds = (nunits + F.G - 1) / F.G;
    auto unit_of = [&](int i) { if (i * F.G < nfull) return i * F.G + F.bid; const int rem = nunits - nfull; if (F.G >= 64 && rem <= 32) return (F.bid >= 32 && F.bid < 32 + rem) ? nfull + F.bid - 32 : -1; const int u = i * F.G + F.bid; return u < nunits ? u : -1; };
    u32x4 ca[4], cg[4], pp[3];
    const u32x4 z4 = {0u, 0u, 0u, 0u};
#define MX_GEOM(u) const int r0 = (u) * 32; int rb, n; if (r0 < TL) { rb = r0 & ~(SEQ - 1); n = SEQ; } else { rb = TL + ((r0 - TL) & ~(CTXL - 1)); n = CTXL; } const int t0 = r0 - rb;
#define MX_ISSUE_CONV(u) do { MX_GEOM(u) _Pragma("unroll") for (int q = 0; q < 4; ++q) { const int i = tid + q * 512, tt = i >> 5, c8 = (i & 31) * 8, t = t0 - 15 + tt; ca[q] = z4; cg[q] = z4; \
        if (i < 62 * 32 && t >= 0 && t < n) { const bf16_t* p = Pp + (size_t)(rb + t) * PW + OFF_CONV + c8; ca[q] = *(const u32x4*)p; cg[q] = *(const u32x4*)(p + 256); } } } while (0)
#define MX_ISSUE_POOL(u) do { MX_GEOM(u) _Pragma("unroll") for (int q = 0; q < 3; ++q) { const int i = tid + q * 512, tt = i >> 5, c8 = (i & 31) * 8, t = t0 - 8 + tt; pp[q] = z4; \
        if (i < 47 * 32 && t >= 0 && t < n) pp[q] = *(const u32x4*)(Pp + (size_t)(rb + t) * PW + OFF_POOL + c8); } } while (0)
    int ucur = unit_of(0);
    if (ucur >= 0) { MX_ISSUE_CONV(ucur); MX_ISSUE_POOL(ucur); }
    for (int it = 0; it < nrounds; ++it) {
        if (ucur < 0) break;
        const int unext = (it + 1 < nrounds) ? unit_of(it + 1) : -1;
        MX_GEOM(ucur)
#pragma unroll
        for (int q = 0; q < 4; ++q) { const int i = tid + q * 512, tt = i >> 5, c8 = (i & 31) * 8;
            if (i < 62 * 32) { const unsigned aw[4] = {ca[q].x, ca[q].y, ca[q].z, ca[q].w}, gw[4] = {cg[q].x, cg[q].y, cg[q].z, cg[q].w}; float v[8];
#pragma unroll
                for (int x = 0; x < 4; ++x) { v[2 * x] = bf2f(aw[x] & 0xffffu) * sigm(bf2f(gw[x] & 0xffffu)); v[2 * x + 1] = bf2f(aw[x] >> 16) * sigm(bf2f(gw[x] >> 16)); }
                *(LAS f32x4*)(U + tt * 256 + c8) = (f32x4){v[0], v[1], v[2], v[3]}; *(LAS f32x4*)(U + tt * 256 + c8 + 4) = (f32x4){v[4], v[5], v[6], v[7]}; } }
        __syncthreads();
        if (unext >= 0) MX_ISSUE_CONV(unext);
        if (!(var & 1u)) { float acc[16];
#pragma unroll
          for (int j = 0; j < 16; ++j) acc[j] = cb;
#pragma unroll
          for (int i = 0; i < 46; ++i) { const float uv = U[(hf * 16 + i) * 256 + c];
#pragma unroll
              for (int j = 0; j < 16; ++j) if (i - j >= 0 && i - j < CONVK) acc[j] += uv * dw[i - j]; }
#pragma unroll
          for (int j = 0; j < 16; ++j) Y[(hf * 16 + j) * 256 + c] = acc[j]; }
        __syncthreads();
        if (!(var & 4u)) { const f32x4 gg = *(const f32x4*)(F.a->in[I_CLNG] + l * 256 + 4 * F.lane), bb = *(const f32x4*)(F.a->in[I_CLNB] + l * 256 + 4 * F.lane);
#pragma unroll
          for (int q = 0; q < 4; ++q) { const int tk = F.wave + 8 * q; f32x4 v = *(const LAS f32x4*)(Y + tk * 256 + 4 * F.lane);
              const float mean = wave_sum((v.x + v.y) + (v.z + v.w)) * (1.f / 256.f); v = v - mean;
              const float rstd = __builtin_amdgcn_rsqf(wave_sum((v.x * v.x + v.y * v.y) + (v.z * v.z + v.w * v.w)) * (1.f / 256.f) + EPS);
              v = v * rstd * gg + bb; u32x2 o; o.x = pk2(silu(v.x), silu(v.y)); o.y = pk2(silu(v.z), silu(v.w));
              *(u32x2*)(MIXp + (size_t)(r0 + tk) * DM + 768 + 4 * F.lane) = o; } }
#pragma unroll
        for (int q = 0; q < 3; ++q) { const int i = tid + q * 512, tt = i >> 5, c8 = (i & 31) * 8;
            if (i < 47 * 32) { const unsigned aw[4] = {pp[q].x, pp[q].y, pp[q].z, pp[q].w};
                *(LAS f32x4*)(U + tt * 256 + c8) = (f32x4){bf2f(aw[0] & 0xffffu), bf2f(aw[0] >> 16), bf2f(aw[1] & 0xffffu), bf2f(aw[1] >> 16)};
                *(LAS f32x4*)(U + tt * 256 + c8 + 4) = (f32x4){bf2f(aw[2] & 0xffffu), bf2f(aw[2] >> 16), bf2f(aw[3] & 0xffffu), bf2f(aw[3] >> 16)}; } }
        __syncthreads();
        if (unext >= 0) MX_ISSUE_POOL(unext);
        if (!(var & 2u)) { const int c2 = (tid & 127) * 2, tq = tid >> 7;
          const int w = 2 << (c2 >> 6), lo = w >> 1, hi = w - 1 - lo; const int tl0 = tq * 8;
          const LAS float* up = U + (tl0 + 8) * 256 + c2;
          f32x2 sm = {0.f, 0.f};
          for (int d = -lo; d <= hi; ++d) sm = sm + *(const LAS f32x2*)(up + d * 256);
#pragma unroll
          for (int j = 0; j < 8; ++j) { const int t = t0 + tl0 + j; const int st = t - lo < 0 ? 0 : t - lo, en = t + hi + 1 > n ? n : t + hi + 1;
              const float rc = __builtin_amdgcn_rcpf((float)(en - st)); const f32x2 ctr = *(const LAS f32x2*)(up + j * 256);
              *(unsigned*)(MIXp + (size_t)(r0 + tl0 + j) * DM + 512 + c2) = pk2(sm.x * rc - ctr.x, sm.y * rc - ctr.y);
              if (j < 7) sm = sm + *(const LAS f32x2*)(up + (j + 1 + hi) * 256) - *(const LAS f32x2*)(up + (j - lo) * 256); } }
        __syncthreads();
        ucur = unext;
    }
#undef MX_GEOM
#undef MX_ISSUE_CONV
#undef MX_ISSUE_POOL
    __syncthreads();
}

constexpr int HS_LD = 1028;
__device__ __forceinline__ void r1_phase(const Ctx& F0, int l, int nrows, bool dry = false) {
    const Ctx F = fresh(F0);
    LAS float* Hs = (LAS float*)F.lds;
    LAS float* Part = (LAS float*)(F.lds + 65792);
    LAS float* Sc = (LAS float*)(F.lds + 82176);
    LAS int* lcount = (LAS int*)(F.lds + 84224); LAS int* gbase = lcount + 32; LAS int* tok_e = gbase + 32; LAS int* tok_r = tok_e + 136 * 4; LAS float* tok_w = (LAS float*)(tok_r + 136 * 4);
    const int lane = F.lane, w = F.wave, e = lane & 31;
    float Wm[32][2];
    { const float* rw = F.a->in[I_RW] + (size_t)l * DM * NE + (size_t)(128 * w + 32 * (lane >> 4)) * NE + (lane & 15);
#pragma unroll
      for (int s_ = 0; s_ < 32; ++s_) { Wm[s_][0] = rw[s_ * NE]; Wm[s_][1] = rw[s_ * NE + 16]; } }
    if (F.tid < 32) lcount[F.tid] = 0;
    __syncthreads();
    const int per = nrows / F.G, rbase = F.bid * per, nchunks = (per + 15) >> 4;
    const float bias_e = F.a->in[I_RB][l * NE + e];
    f32x4 zr[2][4]; u32x2 zb[2][4]; unsigned yr[2][4];
    bf16_t* const Zp = (bf16_t*)(F.ws + WS_Z);
#define R1_ISSUE(cc) do { _Pragma("unroll") for (int q = 0; q < 2; ++q) { const int i = (cc) * 16 + w * 2 + q; \
        if (i < per) { const int r = rbase + i; \
            const unsigned char* yin = ((const unsigned char*)(F.ws + WS_Y1)) + (size_t)r * DM; \
            if (l == 0) { const float* zin = r < TL ? F.a->in[I_X] + (size_t)r * DM : F.a->in[I_CTX] + (size_t)(r - TL) * DM; \
                _Pragma("unroll") for (int j = 0; j < 4; ++j) zr[q][j] = *(const f32x4*)(zin + 4 * lane + 256 * j); } \
            else { const bf16_t* zin = Zp + (size_t)r * DM; \
                _Pragma("unroll") for (int j = 0; j < 4; ++j) zb[q][j] = *(const u32x2*)(zin + 4 * lane + 256 * j); } \
            _Pragma("unroll") for (int j = 0; j < 4; ++j) yr[q][j] = *(const unsigned*)(yin + 4 * lane + 256 * j); } } } while (0)
    R1_ISSUE(0);
    for (int c = 0; c < nchunks; ++c) {
#pragma unroll
        for (int q = 0; q < 2; ++q) { const int i = c * 16 + w * 2 + q;
            if (i < per && !(dry && (DRYVAR & 4u))) { const int r = rbase + i;
                const float* md = ((float*)(F.ws + WS_MISC + M_MOD)) + ((size_t)l * 5 + batch_of(r)) * 6144;
                f32x4 z[4];
#pragma unroll
                for (int j = 0; j < 4; ++j) { const f32x2 ylo = __builtin_amdgcn_cvt_pk_f32_fp8((int)yr[q][j], false), yhi = __builtin_amdgcn_cvt_pk_f32_fp8((int)yr[q][j], true); const f32x4 y = (f32x4){ylo.x, ylo.y, yhi.x, yhi.y} * YB_INV;
                    const u32x2 zo = zb[q][j]; const f32x4 zv = (l == 0) ? zr[q][j] : (f32x4){bf2f(zo.x & 0xffffu), bf2f(zo.x >> 16), bf2f(zo.y & 0xffffu), bf2f(zo.y >> 16)};
                    const f32x4 g = *(const f32x4*)(md + 2048 + 4 * lane + 256 * j); z[j] = zv * ALPHA + g * y; }
                row_ln(z); row_affine(z, F.a->in[I_LN1G] + l * DM, F.a->in[I_LN1B] + l * DM, lane); if (!dry) row_store_bf(z, Zp + (size_t)r * DM, lane);
                row_ln(z); row_mod(z, md + 3072, md + 4096, lane); if (!dry) row_store_bf(z, ((bf16_t*)(F.ws + WS_H)) + (size_t)r * DM, lane);
#pragma unroll
                for (int j = 0; j < 4; ++j) *(LAS f32x4*)(Hs + (w * 2 + q) * HS_LD + 4 * lane + 256 * j) = z[j]; } }
        __syncthreads();
        if (c + 1 < nchunks) R1_ISSUE(c + 1);
        if (!(dry && (DRYVAR & 1u))) { f32x4 acc0 = {0.f, 0.f, 0.f, 0.f}, acc1 = {0.f, 0.f, 0.f, 0.f};
          const LAS float* hp = Hs + (lane & 15) * HS_LD + 128 * w + 32 * (lane >> 4);
#pragma unroll
          for (int s4 = 0; s4 < 8; ++s4) { const f32x4 hv = *(const LAS f32x4*)(hp + 4 * s4);
#pragma unroll
              for (int x = 0; x < 4; ++x) { acc0 = __builtin_amdgcn_mfma_f32_16x16x4f32(hv[x], Wm[4 * s4 + x][0], acc0, 0, 0, 0); acc1 = __builtin_amdgcn_mfma_f32_16x16x4f32(hv[x], Wm[4 * s4 + x][1], acc1, 0, 0, 0); } }
#pragma unroll
          for (int j = 0; j < 4; ++j) { const int row = 4 * (lane >> 4) + j; Part[(w * 16 + row) * 32 + (lane & 15)] = acc0[j]; Part[(w * 16 + row) * 32 + 16 + (lane & 15)] = acc1[j]; } }
        __syncthreads();
        { const int r16 = F.tid >> 5; float lg = 0.f;
#pragma unroll
          for (int w2 = 0; w2 < 8; ++w2) lg += Part[(w2 * 16 + r16) * 32 + e];
          Sc[r16 * 32 + e] = sigm_exact(lg); }
        __syncthreads();
        if (!(dry && (DRYVAR & 2u))) { const int r16 = 2 * w + (lane >> 5), i = c * 16 + r16;
            const float sc = Sc[r16 * 32 + e], sel = sc + bias_e;
            const float m1 = max8(sel), m2 = max8(sel == m1 ? -INFINITY : sel), gs = m1 + m2;
            const float gA = dpp_f<DPP_RM>(gs);
            float t0, t1; t0 = swap16_f(gs, t1); const float gB = (lane & 16) ? t0 : t1; t0 = swap16_f(gA, t1); const float gC = (lane & 16) ? t0 : t1;
            const int g = e >> 3;
            const int rank = ((gA > gs || (gA == gs && (g ^ 1) < g)) ? 1 : 0) + ((gB > gs || (gB == gs && (g ^ 2) < g)) ? 1 : 0) + ((gC > gs || (gC == gs && (g ^ 3) < g)) ? 1 : 0);
            float cand = rank < 2 ? sel : -INFINITY;
            int ei[4]; float wv[4]; float wsum = 0.f;
#pragma unroll
            for (int k = 0; k < 4; ++k) { const float mx = max32(cand);
                const unsigned long long bal = __ballot(cand == mx); const unsigned hb = (lane & 32) ? (unsigned)(bal >> 32) : (unsigned)bal;
                const int widx = __ffs((int)hb) - 1; const bool win = (e == widx);
                const float wk = sum32(win ? sc : 0.f); cand = win ? -INFINITY : cand; ei[k] = widx; wv[k] = wk; wsum += wk; }
            if (e == 0 && i < per) {
#pragma unroll
                for (int k = 0; k < 4; ++k) { const int lr = __hip_atomic_fetch_add(lcount + ei[k], 1, __ATOMIC_RELAXED, __HIP_MEMORY_SCOPE_WORKGROUP); tok_e[i * 4 + k] = ei[k]; tok_r[i * 4 + k] = lr; tok_w[i * 4 + k] = wv[k] / wsum * ROUTED_SCALE; } }
        }
    }
#undef R1_ISSUE
    __syncthreads();
    if (dry) return;
    if (F.tid < 32) gbase[F.tid] = (int)atomicAdd(((unsigned*)(F.ws + WS_CTL)) + CW_GCNT + l * 64 + F.tid, (unsigned)lcount[F.tid]);
    __syncthreads();
    for (int i = F.tid; i < per * 4; i += NTHR) { const int ex = tok_e[i], rank = gbase[ex] + tok_r[i], r = rbase + (i >> 2);
        ((int*)(F.ws + WS_MISC + M_LIST))[(size_t)ex * TT + rank] = r; ((float*)(F.ws + WS_MISC + M_LISTW))[(size_t)ex * TT + rank] = tok_w[i]; ((int*)(F.ws + WS_MISC + M_SELE))[(size_t)r * 4 + (i & 3)] = ex; ((int*)(F.ws + WS_MISC + M_SELR))[(size_t)r * 4 + (i & 3)] = rank; }
    __syncthreads();
}

struct R2Raw { u32x2 z[4]; unsigned y[5][4]; };
__device__ __forceinline__ void r2_issue(R2Raw& w, const Ctx& F, const LAS int* tl, int r, int lane) {
    const bf16_t* zrow = ((const bf16_t*)(F.ws + WS_Z)) + (size_t)r * DM;
    const u32x4 ev = *(const u32x4*)(((int*)(F.ws + WS_MISC + M_SELE)) + (size_t)r * 4), rv = *(const u32x4*)(((int*)(F.ws + WS_MISC + M_SELR)) + (size_t)r * 4);
    const unsigned char* p0 = ((const unsigned char*)(F.ws + WS_YS8)) + (size_t)r * DM;
    const unsigned char* YB = (const unsigned char*)(F.ws + WS_YB);
    const unsigned char* p1 = YB + (size_t)(tl[ev.x] * 256 + (int)rv.x) * DM; const unsigned char* p2 = YB + (size_t)(tl[ev.y] * 256 + (int)rv.y) * DM;
    const unsigned char* p3 = YB + (size_t)(tl[ev.z] * 256 + (int)rv.z) * DM; const unsigned char* p4 = YB + (size_t)(tl[ev.w] * 256 + (int)rv.w) * DM;
#pragma unroll
    for (int j = 0; j < 4; ++j) { const int o = 4 * lane + 256 * j; w.z[j] = *(const u32x2*)(zrow + o); w.y[4][j] = *(const unsigned*)(p0 + o); w.y[0][j] = *(const unsigned*)(p1 + o); w.y[1][j] = *(const unsigned*)(p2 + o); w.y[2][j] = *(const unsigned*)(p3 + o); w.y[3][j] = *(const unsigned*)(p4 + o); }
}
__device__ __forceinline__ void r2_finish(const R2Raw& w, const Ctx& F, int l, int r, int lane, bool dry) {
    const bool last = (l == DEPTH - 1);
    const float* md = ((float*)(F.ws + WS_MISC + M_MOD)) + ((size_t)l * 5 + batch_of(r)) * 6144;
    f32x4 z[4];
#pragma unroll
    for (int j = 0; j < 4; ++j) { f32x4 yr = {0.f, 0.f, 0.f, 0.f};
#pragma unroll
        for (int q = 0; q < 5; ++q) { const f32x2 lo = __builtin_amdgcn_cvt_pk_f32_fp8((int)w.y[q][j], false), hi = __builtin_amdgcn_cvt_pk_f32_fp8((int)w.y[q][j], true); yr = yr + (f32x4){lo.x, lo.y, hi.x, hi.y}; }
        const f32x4 y = yr * YB_INV;
        const u32x2 zo = w.z[j]; const f32x4 zv = {bf2f(zo.x & 0xffffu), bf2f(zo.x >> 16), bf2f(zo.y & 0xffffu), bf2f(zo.y >> 16)};
        const f32x4 g = *(const f32x4*)(md + 5120 + 4 * lane + 256 * j); z[j] = zv * ALPHA + g * y; }
    row_ln(z); row_affine(z, F.a->in[I_LN2G] + l * DM, F.a->in[I_LN2B] + l * DM, lane);
    if (!dry) { if (last) row_store(z, F.out + (size_t)r * DM, lane); else row_store_bf(z, ((bf16_t*)(F.ws + WS_Z)) + (size_t)r * DM, lane); }
    if (!last) { const float* md2 = ((float*)(F.ws + WS_MISC + M_MOD)) + ((size_t)(l + 1) * 5 + batch_of(r)) * 6144; row_ln(z); row_mod(z, md2, md2 + 1024, lane); if (!dry) row_store_bf(z, ((bf16_t*)(F.ws + WS_H)) + (size_t)r * DM, lane); }
}
__device__ __forceinline__ void r2_phase(const Ctx& F0, int l, int nrows, bool dry = false) {
    const Ctx F = fresh(F0);
    expert_tables(F, l, nrows);
    const LAS int* tl = (const LAS int*)(F.lds + LDS_ET);
    const int gw = F.bid * NWAVES + F.wave, NGW = F.G * NWAVES, lane = F.lane;
    for (int r = gw; r < nrows; r += 2 * NGW) {
        const int r2 = r + NGW; const bool two = r2 < nrows;
        R2Raw a, b; r2_issue(a, F, tl, r, lane); r2_issue(b, F, tl, two ? r2 : r, lane);
        r2_finish(a, F, l, r, lane, dry); if (two) r2_finish(b, F, l, r2, lane, dry);
    }
}

constexpr int PH_PER_LAYER = 8, N_PHASES = 2 + DEPTH * PH_PER_LAYER;
__global__ void __launch_bounds__(NTHR, 2) fwd(Args args) {
    extern __shared__ __attribute__((aligned(16))) unsigned char lds_raw[];
    Ctx F;
    F.lds = (LAS unsigned char*)lds_raw; F.tid = threadIdx.x; F.lane = F.tid & 63; F.wave = __builtin_amdgcn_readfirstlane(F.tid >> 6); F.G = gridDim.x; F.bid = blockIdx.x;
    F.a = &args; F.out = args.out; F.ws = args.ws;
    if (F.tid < 16) ((LAS unsigned*)(F.lds + LDS_XB))[F.tid] = 0u;
    __syncthreads();
    XcdBarrier bar; bar.bar = ((unsigned*)(F.ws + WS_CTL)) + CW_BAR; bar.x = 0; bar.st = nullptr;
    if (N_PHASE_LAUNCH == 0) bar = xcd_barrier_post(((unsigned*)(F.ws + WS_CTL)) + CW_BAR, (volatile LAS unsigned*)(F.lds + LDS_XB));
    const int lo = args.ph_lo, hi = args.ph_hi;
#ifndef PH_MASK
#define PH_MASK 0xFFFFFFFFu
#endif
#define IN(k) (lo <= (k) && (k) < hi)
#define EN(b) ((PH_MASK >> (b)) & 1u)
#ifndef DUP_MASK
#define DUP_MASK 0u
#endif
#ifndef DRYVAR
#define DRYVAR 0u
#endif
#define REP(b) for (int _rep = 0; _rep < 1 + (int)((DUP_MASK >> (b)) & 1u); ++_rep)
#define SEAM(k) do { if (IN(k) && IN((k) + 1)) { XcdBarrier b2 = bar; b2.bar = launder_uniform(bar.bar); xcd_barrier(b2); } } while (0)
    if (EN(0) && IN(0)) REP(0) { prep_layer(F, 0); __syncthreads(); mods_phase(F); __syncthreads(); }
    SEAM(0);
    if (EN(1) && IN(1)) REP(1) r0_phase(F);
    SEAM(1);
    for (int l = 0; l < DEPTH; ++l) {
        const int p0 = 2 + l * PH_PER_LAYER; const bool last = (l == DEPTH - 1); const int nrows = last ? TL : TT;
        if (EN(2) && IN(p0 + 0)) REP(2) g1_phase(F);
        SEAM(p0 + 0);
        if (EN(4) && IN(p0 + 1)) REP(4) g23_phase(F);
        SEAM(p0 + 1);
        if (IN(p0 + 2)) { if (EN(5)) { if ((DUP_MASK >> 5) & 1u) mixers_phase(F, l, nrows, DRYVAR); mixers_phase(F, l, nrows); } if (EN(6)) { if ((DUP_MASK >> 6) & 1u) attn_mfma_phase<DRYVAR>(F, !last); attn_mfma_phase<0u>(F, !last); } }
        SEAM(p0 + 2);
        if (EN(7) && IN(p0 + 3)) REP(7) g4_phase(F, nrows);
        SEAM(p0 + 3);
        if (EN(8) && IN(p0 + 4)) { if ((DUP_MASK >> 8) & 1u) { r1_phase(F, l, nrows, args.ph_hi > 0); __syncthreads(); } r1_phase(F, l, nrows); }
        SEAM(p0 + 4);
        if (EN(9) && IN(p0 + 5)) REP(9) g5_phase(F, l, nrows);
        SEAM(p0 + 5);
        if (EN(10) && IN(p0 + 6)) REP(10) g6_phase(F, l, nrows);
        SEAM(p0 + 6);
        if (EN(11) && IN(p0 + 7)) { if ((DUP_MASK >> 11) & 1u) { r2_phase(F, l, nrows, args.ph_hi > 0); __syncthreads(); } r2_phase(F, l, nrows); if (!last) { if ((DUP_MASK >> 12) & 1u) { __syncthreads(); prep_layer(F, l + 1, DRYVAR); } __syncthreads(); prep_layer(F, l + 1); } }
        SEAM(p0 + 7);
    }
#undef IN
#undef SEAM
}

extern "C" void kernel_launch(void* const* d_in, const int* in_sizes, int n_in, void* d_out, int out_size, void* d_ws, size_t ws_size, hipStream_t stream) {
    static int grid = 0;
    if (grid == 0) {
        if (n_in != 31 || out_size != TL * DM || ws_size < WS_END) { fprintf(stderr, "kernel_launch: unexpected shapes (n_in %d out %d ws %zu)\n", n_in, out_size, ws_size); grid = -1; return; }
        int dev = 0, cus = 0, per_cu = 0;
        if (hipGetDevice(&dev) != hipSuccess || hipDeviceGetAttribute(&cus, hipDeviceAttributeMultiprocessorCount, dev) != hipSuccess) { grid = -1; return; }
        if (hipFuncSetAttribute((const void*)fwd, hipFuncAttributeMaxDynamicSharedMemorySize, LDS_BYTES) != hipSuccess) { fprintf(stderr, "kernel_launch: hipFuncSetAttribute failed\n"); grid = -1; return; }
        if (hipOccupancyMaxActiveBlocksPerMultiprocessor(&per_cu, (const void*)fwd, NTHR, LDS_BYTES) != hipSuccess || per_cu < 1) fprintf(stderr, "kernel_launch: occupancy query reports %d\n", per_cu);
        (void)hipGetLastError();
        grid = cus;
    }
    if (grid < 0) return;
    (void)hipMemsetAsync((char*)d_ws + WS_CTL, 0, CTL_ZERO_BYTES, stream);
    Args a{};
    for (int i = 0; i < 31; ++i) a.in[i] = (const float*)d_in[i];
    a.out = (float*)d_out; a.ws = (unsigned char*)d_ws;
    if (N_PHASE_LAUNCH == 0) { a.ph_lo = 0; a.ph_hi = N_PHASES; hipLaunchKernelGGL(fwd, dim3(grid), dim3(NTHR), LDS_BYTES, stream, a); }
    else for (int p = 0; p < N_PHASES; ++p) { a.ph_lo = p; a.ph_hi = p + 1; hipLaunchKernelGGL(fwd, dim3(grid), dim3(NTHR), LDS_BYTES, stream, a); }
}
```

```cpp
#include <hip/hip_runtime.h>
#include <cstdio>
#include <cstdint>

#define LAS __attribute__((address_space(3)))
#define GAS __attribute__((address_space(1)))
typedef unsigned short bf16_t;
typedef short bf16x8 __attribute__((ext_vector_type(8)));
typedef float f32x4 __attribute__((ext_vector_type(4)));
typedef float f32x2 __attribute__((ext_vector_type(2)));
typedef unsigned u32x4 __attribute__((ext_vector_type(4)));
typedef unsigned u32x2 __attribute__((ext_vector_type(2)));

#ifndef DRYVAR
#define DRYVAR 0u
#endif
#ifndef N_PHASE_LAUNCH
#define N_PHASE_LAUNCH 0
#endif

constexpr int DM = 1024, NBATCH = 4, SEQ = 8192, CTXL = 256, DEPTH = 2;
constexpr int TL = NBATCH * SEQ, TC = NBATCH * CTXL, TT = TL + TC;
constexpr int KVS = SEQ + CTXL;
constexpr int NH = 8, QK_NOPE = 64, QK_ROPE = 32, VD = 64, QLORA = 256, KVLORA = 128;
constexpr int INC = 1184, PW = 1280;
constexpr int OFF_KV = 256, OFF_KR = 384, OFF_POOL = 416, OFF_CONV = 672;
constexpr int NE = 32, DEXP = 256, CONVK = 31;
constexpr float ALPHA = 1.4142135623730951f, EPS = 1e-6f, ROUTED_SCALE = 2.5f;
constexpr float ATTN_SCALE = 0.10206207261596575f;
constexpr int NWAVES = 8, NTHR = 512;

constexpr size_t MiB = 1u << 20;
constexpr size_t WS_CTL = 0, CTL_ZERO_BYTES = 1 * MiB;
constexpr int CW_BAR = 4096;
constexpr int CW_GCNT = 16384;
constexpr size_t WS_W = 1 * MiB;
constexpr size_t W_WIN = 0, W_WQ = W_WIN + (size_t)PW * DM * 2, W_WKV = W_WQ + (size_t)768 * 256 * 2, W_WO = W_WKV + (size_t)1024 * 256 * 2,
                 W_WGU = W_WO + (size_t)DM * DM * 2, W_WD = W_WGU + (size_t)33 * 512 * DM * 2, W_END = W_WD + (size_t)33 * DM * 256 * 2;
static_assert(W_END <= 56 * MiB, "weights region");
constexpr size_t WS_MISC = 61 * MiB;
constexpr size_t M_MOD = 0, M_ROPE = M_MOD + (size_t)DEPTH * 5 * 6144 * 4, M_RS = M_ROPE + 128 * 8 * 2 * 4, M_SELE = M_RS + (size_t)TT * 32,
                 M_SELR = M_SELE + (size_t)TT * 16, M_LIST = M_SELR + (size_t)TT * 16, M_LISTW = M_LIST + (size_t)NE * TT * 4, M_END = M_LISTW + (size_t)NE * TT * 4;
static_assert(M_END <= 12 * MiB, "misc region");
constexpr size_t WS_H = 73 * MiB;
constexpr size_t WS_X = 139 * MiB;
constexpr size_t WS_P = WS_X, WS_Q = 222 * MiB, WS_QR = 272 * MiB, WS_KV = 289 * MiB, WS_KR = 355 * MiB, WS_MIX = 358 * MiB, WS_Y1 = WS_X  ;
constexpr size_t WS_YS8 = 366 * MiB;
constexpr size_t WS_Z = 424 * MiB;
constexpr size_t WS_HB = WS_X, WS_YB = 226 * MiB, WS_END = 512 * MiB;
static_assert(WS_P + (size_t)TT * PW * 2 <= WS_Q && WS_Q + (size_t)TT * 768 * 2 <= WS_QR && WS_QR + (size_t)TT * 256 * 2 <= WS_KV && WS_KV + (size_t)TT * 2048 <= WS_KR &&
              WS_KR + (size_t)TT * 64 <= WS_MIX && WS_MIX + (size_t)TT * 2048 <= WS_Z && WS_Y1 + (size_t)TT * 2048 <= WS_Q && WS_Z + (size_t)TT * 2048 <= WS_END, "attention-time map");
static_assert(WS_HB + (size_t)(4 * TT + 32 * 255 + TT) * 512 <= WS_YB && WS_YB + (size_t)(4 * TT + 32 * 255) * 1024 <= WS_YS8 && WS_YS8 + (size_t)TT * 1024 <= WS_Z, "moe-time map");
constexpr int LDS_BYTES = 163840;
constexpr int LDS_XB = LDS_BYTES - 64;

__device__ __forceinline__ float bf2f(unsigned b) { return __uint_as_float(b << 16); }
__device__ __forceinline__ unsigned f2bf(float f) { unsigned u = __float_as_uint(f); return (u + 0x7fffu + ((u >> 16) & 1u)) >> 16; }
__device__ __forceinline__ unsigned pk2(float lo, float hi) { return f2bf(lo) | (f2bf(hi) << 16); }
template <int CTRL> __device__ __forceinline__ float dpp_f(float v) { return __builtin_bit_cast(float, __builtin_amdgcn_update_dpp(0, __builtin_bit_cast(int, v), CTRL, 0xF, 0xF, false)); }
#define DPP_X1 0xB1
#define DPP_X2 0x4E
#define DPP_HM 0x141
#define DPP_RM 0x140
__device__ __forceinline__ float swap16_f(float v, float& other) { auto r = __builtin_amdgcn_permlane16_swap(__float_as_uint(v), __float_as_uint(v), false, false); other = __uint_as_float(r[1]); return __uint_as_float(r[0]); }
__device__ __forceinline__ float sum16(float v) { v += dpp_f<DPP_X1>(v); v += dpp_f<DPP_X2>(v); v += dpp_f<DPP_HM>(v); v += dpp_f<DPP_RM>(v); return v; }
__device__ __forceinline__ float sum32(float v) { v = sum16(v); float o; const float a = swap16_f(v, o); return a + o; }
__device__ __forceinline__ float wave_sum(float v) {
    v = sum32(v);
    auto r = __builtin_amdgcn_permlane32_swap(__float_as_uint(v), __float_as_uint(v), false, false);
    return __uint_as_float(r[0]) + __uint_as_float(r[1]);
}
__device__ __forceinline__ float max8(float v) { v = fmaxf(v, dpp_f<DPP_X1>(v)); v = fmaxf(v, dpp_f<DPP_X2>(v)); v = fmaxf(v, dpp_f<DPP_HM>(v)); return v; }
__device__ __forceinline__ float max32(float v) { v = max8(v); v = fmaxf(v, dpp_f<DPP_RM>(v)); float o; const float a = swap16_f(v, o); return fmaxf(a, o); }
__device__ __forceinline__ float sigm_exact(float x) { return 1.f / (1.f + __expf(-x)); }
__device__ __forceinline__ float sigm(float x) { return __builtin_amdgcn_rcpf(1.f + __expf(-x)); }
__device__ __forceinline__ float silu(float x) { return x * __builtin_amdgcn_rcpf(1.f + __expf(-x)); }
__device__ __forceinline__ int kvrow_of(int r) { return r < TL ? (r >> 13) * KVS + CTXL + (r & (SEQ - 1)) : ((r - TL) >> 8) * KVS + ((r - TL) & (CTXL - 1)); }
__device__ __forceinline__ int batch_of(int r) { return r < TL ? (r >> 13) : 4; }
#define LDS_WAIT() asm volatile("s_waitcnt lgkmcnt(0)" ::: "memory")
#define VM_WAIT() asm volatile("s_waitcnt vmcnt(0)" ::: "memory")

#define XB_TMO      128
#define XB_XCNT(j)  (256  + 64 * (j))
#define XB_XSUB(j)  (1280 + 64 * (j))
#define XB_XGEN(j)  (2304 + 64 * (j))
#define XB_TOP      3328
#define XB_TOPGEN   3392
#define XCD_BAR_WORDS 3456
#define XB_SPIN_CAP (1u << 22)
__device__ __forceinline__ unsigned xb_ld(unsigned* p)              { return __hip_atomic_load(p, __ATOMIC_RELAXED, __HIP_MEMORY_SCOPE_AGENT); }
__device__ __forceinline__ unsigned xb_add(unsigned* p, unsigned v) { return __hip_atomic_fetch_add(p, v, __ATOMIC_RELAXED, __HIP_MEMORY_SCOPE_AGENT); }
__device__ __forceinline__ unsigned xb_xcc_id() { return (unsigned)__builtin_amdgcn_s_getreg((3 << 11) | 20) & 0xFu; }
#define XB_SPIN(cond, bar) do { unsigned _sp = 0; while (cond) { __builtin_amdgcn_s_sleep(1); \
    if ((++_sp & 255u) == 0u) { if (xb_ld(&(bar)[XB_TMO])) break; if (_sp > XB_SPIN_CAP) { atomicAdd(&(bar)[XB_TMO], 1u); break; } } } } while (0)
struct XcdBarrier { unsigned* bar; unsigned x; volatile LAS unsigned* st; };
__device__ __forceinline__ XcdBarrier xcd_barrier_post(unsigned* bar, volatile LAS unsigned* st) {
    XcdBarrier b; b.bar = bar; b.x = xb_xcc_id(); b.st = st;
    if (threadIdx.x == 0) (void)xb_add(&bar[XB_XCNT(b.x)], 1u);
    return b;
}
__device__ __forceinline__ void xcd_barrier_complete(unsigned* bar, unsigned x, unsigned& nloc, unsigned& nx) {
    const unsigned G = gridDim.x * gridDim.y * gridDim.z;
    unsigned sum, cnt, mine, sp = 0u;
    for (;;) {
        sum = 0u; cnt = 0u; mine = 0u;
#pragma unroll
        for (unsigned j = 0; j < 16; ++j) { const unsigned c = xb_ld(&bar[XB_XCNT(j)]); sum += c; cnt += (c > 0u) ? 1u : 0u; mine = (j == x) ? c : mine; }
        if (sum == G) break;
        __builtin_amdgcn_s_sleep(1);
        if ((++sp & 255u) == 0u) { if (xb_ld(&bar[XB_TMO])) break; if (sp > XB_SPIN_CAP) { atomicAdd(&bar[XB_TMO], 1u); break; } }
    }
    nloc = mine > 0u ? mine : 1u; nx = cnt > 0u ? cnt : 1u;
}
__device__ __forceinline__ void xcd_barrier(const XcdBarrier& b) {
    asm volatile("s_waitcnt vmcnt(0)" ::: "memory");
    __syncthreads();
    if (threadIdx.x == 0) {
        unsigned* bar = b.bar;
        __builtin_amdgcn_s_waitcnt(0);
        unsigned nloc = b.st[0], nx = b.st[1];
        if (nloc == 0u) { xcd_barrier_complete(bar, b.x, nloc, nx); b.st[0] = nloc; b.st[1] = nx; }
        const unsigned old = xb_add(&bar[XB_XSUB(b.x)], 1u);
        const unsigned gen = old / nloc;
        if (old + 1u == (gen + 1u) * nloc) {
            __builtin_amdgcn_fence(__ATOMIC_RELEASE, "agent");
            asm volatile("s_waitcnt vmcnt(0)" ::: "memory");
            const unsigned og = xb_add(&bar[XB_TOP], 1u);
            const unsigned tg = og / nx;
            if (og + 1u == (tg + 1u) * nx) xb_add(&bar[XB_TOPGEN], 1u);
            else XB_SPIN(xb_ld(&bar[XB_TOPGEN]) == tg, bar);
            __builtin_amdgcn_fence(__ATOMIC_ACQUIRE, "agent");
            xb_add(&bar[XB_XGEN(b.x)], 1u);
            asm volatile("s_waitcnt vmcnt(0)" ::: "memory");
        } else {
            XB_SPIN(xb_ld(&bar[XB_XGEN(b.x)]) == gen, bar);
            __builtin_amdgcn_fence(__ATOMIC_ACQUIRE, "agent");
            asm volatile("s_waitcnt vmcnt(0)" ::: "memory");
        }
    }
    __syncthreads();
}

struct Args { const float* in[31]; float* out; unsigned char* ws; int ph_lo, ph_hi; };
struct Ctx {
    LAS unsigned char* lds; int tid, lane, wave, G, bid;
    const Args* a; float* out; unsigned char* ws;
};
template <class T> __device__ __forceinline__ T* launder_uniform(T* p) {
    unsigned lo, hi;
    asm volatile("v_mov_b32 %0, %2\n\tv_mov_b32 %1, %3" : "=&v"(lo), "=&v"(hi) : "s"((unsigned)(uintptr_t)p), "s"((unsigned)((uintptr_t)p >> 32)));
    lo = __builtin_amdgcn_readfirstlane(lo); hi = __builtin_amdgcn_readfirstlane(hi);
    return (T*)(((uintptr_t)hi << 32) | (uintptr_t)lo);
}
__device__ __forceinline__ Ctx fresh(const Ctx& F0) {
    Ctx F = F0; int bid = F0.bid, G = F0.G, wv = F0.wave;
    int lane = (int)__builtin_amdgcn_mbcnt_hi(~0u, __builtin_amdgcn_mbcnt_lo(~0u, 0u));
    asm volatile("" : "+v"(lane)); asm volatile("" : "+v"(bid)); asm volatile("" : "+v"(G)); asm volatile("" : "+v"(wv));
    bid = __builtin_amdgcn_readfirstlane(bid); G = __builtin_amdgcn_readfirstlane(G); wv = __builtin_amdgcn_readfirstlane(wv);
    F.tid = wv * 64 + lane; F.lane = lane; F.wave = wv; F.bid = bid; F.G = G; F.ws = launder_uniform(F0.ws); F.out = launder_uniform(F0.out); F.a = F0.a;
    { unsigned l = (unsigned)(uintptr_t)F0.lds; asm volatile("" : "+v"(l)); F.lds = (LAS unsigned char*)(uintptr_t)__builtin_amdgcn_readfirstlane(l); }
    return F;
}
enum { I_X = 0, I_C, I_CTX, I_CCTX, I_ADAW, I_ADAB, I_WIN, I_QG, I_WUQ, I_KVG, I_WUKV, I_POOLW, I_POOLS, I_CDW, I_CB, I_CLNG, I_CLNB, I_CPW, I_WOUT,
       I_LN1G, I_LN1B, I_RW, I_RB, I_EWG, I_EWU, I_EWD, I_SWG, I_SWU, I_SWD, I_LN2G, I_LN2B };

__device__ __forceinline__ int permd(int c) { return (c & ~255) + 128 * ((c >> 3) & 1) + 32 * ((c >> 6) & 3) + 8 * ((c >> 4) & 3) + (c & 7); }
__device__ __forceinline__ void xpose_item(const float* W, int N, const float* gain, bf16_t* WT, int ldk, int koff, int rmul, int radd, LAS float* scr, int kb, int nb, int lane, bool pd = false) {
    const int k0 = 64 * kb, n0 = 32 * nb;
    float v[32]; const float* wp = W + (size_t)(k0 + (lane >> 5)) * N + n0 + (lane & 31);
#pragma unroll
    for (int i = 0; i < 32; ++i) v[i] = wp[(size_t)(2 * i) * N];
    if (gain) {
#pragma unroll
        for (int i = 0; i < 32; ++i) v[i] *= gain[k0 + 2 * i + (lane >> 5)]; }
#pragma unroll
    for (int i = 0; i < 32; ++i) scr[(2 * i + (lane >> 5)) * 33 + (lane & 31)] = v[i];
    LDS_WAIT(); asm volatile("" ::: "memory");
    const int c = lane & 7;
#pragma unroll
    for (int j = 0; j < 4; ++j) { const int n = (lane >> 3) + 8 * j; const LAS float* s = scr + (8 * c) * 33 + n;
        u32x4 o; o.x = pk2(s[0 * 33], s[1 * 33]); o.y = pk2(s[2 * 33], s[3 * 33]); o.z = pk2(s[4 * 33], s[5 * 33]); o.w = pk2(s[6 * 33], s[7 * 33]);
        const int drow = pd ? permd(n0 + n) : (n0 + n) * rmul + radd;
        *(u32x4*)(WT + (size_t)drow * ldk + koff + k0 + 8 * c) = o; }
    LDS_WAIT(); asm volatile("" ::: "memory");
}
__device__ __forceinline__ void prep_layer(const Ctx& F0, int l, unsigned var = 0u) {
    const Ctx F = fresh(F0);
    LAS float* scr = (LAS float*)(F.lds + F.wave * 16384);
    const int gw = F.bid * NWAVES + F.wave, NGW = F.G * NWAVES, lane = F.lane;
    const float* w_in = F.a->in[I_WIN] + (size_t)l * DM * INC; const float* w_uq = F.a->in[I_WUQ] + (size_t)l * 256 * 768; const float* w_ukv = F.a->in[I_WUKV] + (size_t)l * 128 * 1024;
    const float* w_out = F.a->in[I_WOUT] + (size_t)l * DM * DM;
    constexpr int I1 = 16 * 37, I2 = 4 * 24, I3 = 2 * 32, I4 = 8 * 32, I5 = 33 * 2 * 128, I6 = 33 * 128, I7 = 1024  , I8 = 96   + 128  ;
    constexpr int NIT = I1 + I2 + I3 + I4 + I5 + I6 + I7 + I8;
    for (int it = gw; it < NIT; it += NGW) {
        int r = it;
        if (r < I1) { xpose_item(w_in, INC, nullptr, ((bf16_t*)(F.ws + WS_W + W_WIN)), DM, 0, 1, 0, scr, r / 37, r % 37, lane); continue; } r -= I1;
        if (r < I2) { xpose_item(w_uq, 768, F.a->in[I_QG] + l * 256, ((bf16_t*)(F.ws + WS_W + W_WQ)), 256, 0, 1, 0, scr, r / 24, r % 24, lane); continue; } r -= I2;
        if (r < I3) { xpose_item(w_ukv, 1024, F.a->in[I_KVG] + l * 128, ((bf16_t*)(F.ws + WS_W + W_WKV)), 256, 0, 1, 0, scr, r / 32, r % 32, lane); continue; } r -= I3;
        if (r < I4) { xpose_item(w_out, DM, nullptr, ((bf16_t*)(F.ws + WS_W + W_WO)), DM, 0, 1, 0, scr, r / 32, r % 32, lane, true); continue; } r -= I4;
        if (r < I5) { if (var & 8u) continue; const int e = r / 256, q = r % 256, which = q / 128, i2 = q % 128;
            const float* src = e < 32 ? (which ? F.a->in[I_EWU] : F.a->in[I_EWG]) + ((size_t)l * 32 + e) * DM * 256 : (which ? F.a->in[I_SWU] : F.a->in[I_SWG]) + (size_t)l * DM * 256;
            xpose_item(src, 256, nullptr, ((bf16_t*)(F.ws + WS_W + W_WGU)) + (size_t)e * 512 * DM, DM, 0, 1, ((i2 % 8) / 4) * 128 + which * 128, scr, i2 / 8, i2 % 8, lane); continue; } r -= I5;
        if (r < I6) { if (var & 16u) continue; const int e = r / 128, i2 = r % 128;
            const float* src = e < 32 ? F.a->in[I_EWD] + ((size_t)l * 32 + e) * 256 * DM : F.a->in[I_SWD] + (size_t)l * 256 * DM;
            xpose_item(src, DM, nullptr, ((bf16_t*)(F.ws + WS_W + W_WD)) + (size_t)e * DM * 256, 256, 0, 1, 0, scr, i2 / 32, i2 % 32, lane, true); continue; } r -= I6;
        if (r < I7) { if (var & 32u) continue;
            const int kg = r / 16, n = (r % 16) * 64 + lane; float acc[8];
#pragma unroll
            for (int i = 0; i < 8; ++i) acc[i] = 0.f;
            if (kg < 32) { const int g = kg / 8, i0 = (kg % 8) * 8; const float* pw = F.a->in[I_POOLW] + ((size_t)l * 4 + g) * 4096; const float* ps = F.a->in[I_POOLS] + l * 256 + g * 64;
                for (int jb = 0; jb < 64; jb += 16) { float wv[16];
#pragma unroll
                    for (int j = 0; j < 16; ++j) wv[j] = w_out[(size_t)(512 + g * 64 + jb + j) * DM + n];
#pragma unroll
                    for (int j = 0; j < 16; ++j) { const float wj = wv[j] * ps[jb + j];
#pragma unroll
                        for (int i = 0; i < 8; ++i) acc[i] += pw[(i0 + i) * 64 + jb + j] * wj; } } }
            else { const int i0 = (kg - 32) * 8; const float* cp = F.a->in[I_CPW] + (size_t)l * 65536;
                for (int jb = 0; jb < 256; jb += 16) { float wv[16];
#pragma unroll
                    for (int j = 0; j < 16; ++j) wv[j] = w_out[(size_t)(768 + jb + j) * DM + n];
#pragma unroll
                    for (int j = 0; j < 16; ++j) {
#pragma unroll
                        for (int i = 0; i < 8; ++i) acc[i] += cp[(i0 + i) * 256 + jb + j] * wv[j]; } } }
            u32x4 o; o.x = pk2(acc[0], acc[1]); o.y = pk2(acc[2], acc[3]); o.z = pk2(acc[4], acc[5]); o.w = pk2(acc[6], acc[7]);
            *(u32x4*)(((bf16_t*)(F.ws + WS_W + W_WO)) + (size_t)permd(n) * DM + 512 + kg * 8) = o; continue; } r -= I7;
        { unsigned zz = 0u; asm volatile("" : "+v"(zz)); const u32x4 z = {zz, zz, zz, zz};
          if (r < 96) { u32x4* d = (u32x4*)(((bf16_t*)(F.ws + WS_W + W_WIN)) + (size_t)(INC + r) * DM); d[lane] = z; d[64 + lane] = z; }
          else { const int n = (r - 96) * 8 + (lane >> 3); u32x4* d = (u32x4*)(((bf16_t*)(F.ws + WS_W + W_WKV)) + (size_t)n * 256 + 128); d[lane & 7] = z; d[8 + (lane & 7)] = z; } }
    }
}

__device__ __forceinline__ void mods_phase(const Ctx& F0) {
    const Ctx F = fresh(F0);
    LAS float* sv = (LAS float*)F.lds;
    LAS float* part = sv + 5 * 1024;
    for (int i = F.tid; i < 5 * 1024; i += NTHR) { const int j = i >> 10, k = i & 1023; const float c = j < 4 ? F.a->in[I_C][j * DM + k] : F.a->in[I_CCTX][k]; sv[i] = silu(c); }
    __syncthreads();
    for (int it = F.bid; it < DEPTH * 96; it += F.G) {
        const int l = it / 96, n = (it % 96) * 64 + F.lane; const float* aw = F.a->in[I_ADAW] + (size_t)l * DM * 6144 + n;
        float acc[5] = {0.f, 0.f, 0.f, 0.f, 0.f};
        const int kb = F.wave * 128;
#pragma unroll 8
        for (int k = 0; k < 128; ++k) { const float a = aw[(size_t)(kb + k) * 6144];
#pragma unroll
            for (int j = 0; j < 5; ++j) acc[j] += sv[j * 1024 + kb + k] * a; }
#pragma unroll
        for (int j = 0; j < 5; ++j) part[(F.wave * 5 + j) * 64 + F.lane] = acc[j];
        __syncthreads();
        if (F.wave < 5) { float s = F.a->in[I_ADAB][l * 6144 + n];
#pragma unroll
            for (int w = 0; w < 8; ++w) s += part[(w * 5 + F.wave) * 64 + F.lane];
            ((float*)(F.ws + WS_MISC + M_MOD))[((size_t)l * 5 + F.wave) * 6144 + n] = s; }
        __syncthreads();
    }
    if (F.bid == F.G - 1) {
        for (int i = F.tid; i < 1024; i += NTHR) { const int pos = i >> 3, j = i & 7;
            const double c1 = j == 0 ? 0.54030230586813977 : j == 1 ? 0.95041528025518285 : j == 2 ? 0.99500416527802582 : j == 3 ? 0.99950004166527784 : j == 4 ? 0.99995000041666526 : j == 5 ? 0.99999500000416663 : j == 6 ? 0.99999950000004167 : 0.99999995000000041;
            const double s1 = j == 0 ? 0.8414709848078965 : j == 1 ? 0.31098359290718575 : j == 2 ? 0.099833416646828155 : j == 3 ? 0.031617506402433708 : j == 4 ? 0.0099998333341666645 : j == 5 ? 0.0031622723897082477 : j == 6 ? 0.00099999983333334168 : 0.00031622776074637522;
            double c = 1.0, sn = 0.0;
            for (int q = 0; q < pos; ++q) { const double nc = c * c1 - sn * s1, ns = sn * c1 + c * s1; c = nc; sn = ns; }
            ((float*)(F.ws + WS_MISC + M_ROPE))[pos * 16 + j] = (float)c; ((float*)(F.ws + WS_MISC + M_ROPE))[pos * 16 + 8 + j] = (float)sn; }
    }
}

__device__ __forceinline__ void row_ln(f32x4 (&v)[4]) {
    float s = 0.f;
#pragma unroll
    for (int j = 0; j < 4; ++j) s += (v[j].x + v[j].y) + (v[j].z + v[j].w);
    const float mean = wave_sum(s) * (1.f / DM); float s2 = 0.f;
#pragma unroll
    for (int j = 0; j < 4; ++j) { v[j] = v[j] - mean; s2 += (v[j].x * v[j].x + v[j].y * v[j].y) + (v[j].z * v[j].z + v[j].w * v[j].w); }
    const float rstd = 1.f / sqrtf(wave_sum(s2) * (1.f / DM) + EPS);
#pragma unroll
    for (int j = 0; j < 4; ++j) v[j] = v[j] * rstd;
}
__device__ __forceinline__ void row_load(f32x4 (&v)[4], const float* row, int lane) {
#pragma unroll
    for (int j = 0; j < 4; ++j) v[j] = *(const f32x4*)(row + 4 * lane + 256 * j);
}
__device__ __forceinline__ void row_store(const f32x4 (&v)[4], float* row, int lane) {
#pragma unroll
    for (int j = 0; j < 4; ++j) *(f32x4*)(row + 4 * lane + 256 * j) = v[j];
}
__device__ __forceinline__ void row_store_bf(const f32x4 (&v)[4], bf16_t* row, int lane) {
#pragma unroll
    for (int j = 0; j < 4; ++j) { u32x2 o; o.x = pk2(v[j].x, v[j].y); o.y = pk2(v[j].z, v[j].w); *(u32x2*)(row + 4 * lane + 256 * j) = o; }
}
__device__ __forceinline__ void row_load_bf(f32x4 (&v)[4], const bf16_t* row, int lane) {
#pragma unroll
    for (int j = 0; j < 4; ++j) { const u32x2 o = *(const u32x2*)(row + 4 * lane + 256 * j); v[j] = (f32x4){bf2f(o.x & 0xffffu), bf2f(o.x >> 16), bf2f(o.y & 0xffffu), bf2f(o.y >> 16)}; }
}
__device__ __forceinline__ void row_mod(f32x4 (&v)[4], const float* shift, const float* scale, int lane) {
#pragma unroll
    for (int j = 0; j < 4; ++j) { const f32x4 sc = *(const f32x4*)(scale + 4 * lane + 256 * j), sh = *(const f32x4*)(shift + 4 * lane + 256 * j); v[j] = v[j] * (sc + 1.f) + sh; }
}
__device__ __forceinline__ void row_affine(f32x4 (&v)[4], const float* g, const float* b, int lane) {
#pragma unroll
    for (int j = 0; j < 4; ++j) { const f32x4 gg = *(const f32x4*)(g + 4 * lane + 256 * j), bb = *(const f32x4*)(b + 4 * lane + 256 * j); v[j] = v[j] * gg + bb; }
}

__device__ __forceinline__ void r0_phase(const Ctx& F0) {
    const Ctx F = fresh(F0);
    const int gw = F.bid * NWAVES + F.wave, NGW = F.G * NWAVES;
    for (int r = gw; r < TT; r += NGW) {
        const float* src = r < TL ? F.a->in[I_X] + (size_t)r * DM : F.a->in[I_CTX] + (size_t)(r - TL) * DM;
        const float* md = ((float*)(F.ws + WS_MISC + M_MOD)) + (size_t)batch_of(r) * 6144;
        f32x4 v[4]; row_load(v, src, F.lane); row_ln(v); row_mod(v, md, md + 1024, F.lane); row_store_bf(v, ((bf16_t*)(F.ws + WS_H)) + (size_t)r * DM, F.lane);
    }
}

#ifndef PG8_ALIGN_DEFAULT
#define PG8_ALIGN_DEFAULT true
#endif
namespace pg8 {
constexpr int BM = 256, BK = 64, HALF = 128, HTB = HALF * BK * 2, STAGE_BYTES = 8 * HTB, NXCD = 8, WGM = 8;
__device__ __forceinline__ int lds_byte(int r, int c) { const int st = (r >> 4) * 2 + (c >> 5), rr = r & 15, cc = c & 31, ob = rr * 64 + cc * 2; return st * 1024 + (ob ^ (((ob >> 9) & 1) << 5)); }
__device__ __forceinline__ void stage_rc(int b, int& R, int& C) { const int st = b / 1024, sb = b % 1024, swz = sb ^ (((sb >> 9) & 1) << 5); R = (st >> 1) * 16 + swz / 64; C = (st & 1) * 32 + (swz % 64) / 2; }
__device__ __forceinline__ int perm32(int rho) { const int n = rho >> 4, i = rho & 15; return 8 * (i >> 2) + 4 * n + (i & 3); }
struct Unit { int pm, pn, e, nvalid, base, idx; };
__device__ __forceinline__ int xcd_remap(int wgid, int nwg) { const int q = nwg / NXCD, r = nwg % NXCD, xcd = wgid % NXCD, off = wgid / NXCD; return (xcd < r ? xcd * (q + 1) : r * (q + 1) + (xcd - r) * q) + off; }
struct StaticOrder {
    int nM, nN, nwg, G, c;
    __device__ void init(int M, int N, int G_, int c_) { nM = M / BM; nN = N / BM; nwg = nM * nN; G = G_; c = c_; }
    __device__ void at(int L, int i, Unit& u) const {
        const int wgid = xcd_remap(L, nwg);
        const int nig = WGM * nN, gid = wgid / nig, fm = gid * WGM, gsz = (nM - fm) < WGM ? (nM - fm) : WGM;
        u.pm = fm + ((wgid % nig) % gsz); u.pn = (wgid % nig) / gsz; u.e = 0; u.nvalid = 256; u.base = 0; u.idx = i;
    }
    __device__ bool next(int i, Unit& u) const { const long L = (long)i * G + c; if (L >= nwg) return false; at((int)L, i, u); return true; }
};
struct DualOrder {
    StaticOrder A, B; int G, c;
    __device__ bool next(int i, Unit& u) const { const long L = (long)i * G + c; if (L >= A.nwg + B.nwg) return false;
        if (L < A.nwg) { A.at((int)L, i, u); u.e = 0; } else { B.at((int)L - A.nwg, i, u); u.e = 1; } return true; }
};
struct ExpertOrder {
    const LAS int* tl; const LAS int* cnt; const LAS int* te; int nN, nwg, G, c;
    __device__ void init(const LAS int* tl_, const LAS int* cnt_, const LAS int* te_, int nN_, int G_, int c_) { tl = tl_; cnt = cnt_; te = te_; nN = nN_; nwg = __builtin_amdgcn_readfirstlane(tl_[33]) * nN_; G = G_; c = c_; }
    __device__ bool next(int i, Unit& u) const {
        const long L = (long)i * G + c; if (L >= nwg) return false;
        const int wgid = xcd_remap((int)L, nwg), mt = wgid / nN;
        const int e = __builtin_amdgcn_readfirstlane(te[mt]);
        const int te_ = __builtin_amdgcn_readfirstlane(tl[e]), ce = __builtin_amdgcn_readfirstlane(cnt[e]);
        u.e = e; u.pm = mt - te_; u.pn = wgid % nN; u.nvalid = ce - u.pm * 256; u.base = te_ * 256; u.idx = i; return true;
    }
};
__device__ __forceinline__ unsigned cvt_pk_bf16(float lo, float hi) { unsigned r; asm volatile("v_cvt_pk_bf16_f32 %0, %1, %2" : "=v"(r) : "v"(lo), "v"(hi)); return r; }
__device__ __forceinline__ u32x4 pack8(const f32x4& v0, const f32x4& v1) { u32x4 w; w.x = cvt_pk_bf16(v0[0], v0[1]); w.y = cvt_pk_bf16(v0[2], v0[3]); w.z = cvt_pk_bf16(v1[0], v1[1]); w.w = cvt_pk_bf16(v1[2], v1[3]); return w; }

template <bool GATHER, bool ALIGN_EPI = PG8_ALIGN_DEFAULT, class Sched, class AOff, class BPtr, class Epi>
__device__ __forceinline__ void gemm256(LAS unsigned char* lds, int tid, const char* Abase, int pitch, int K, const Sched& S, const AOff& aoff, const BPtr& bptr, const Epi& E) {
    const int wid = __builtin_amdgcn_readfirstlane(tid >> 6), lane = tid & 63, wr = wid >> 2, wc = wid & 3, fr = lane & 15, fq = lane >> 4;
    const int nt = K / BK;
    int sR, sC; stage_rc(tid * 16, sR, sC);
    const unsigned voffB = (unsigned)(((sR & ~31) + perm32(sR & 31)) * K + sC) * 2u;
    const unsigned laneA = (unsigned)sR * (unsigned)pitch + (unsigned)sC * 2u;
    const size_t kstep = (size_t)(BK * 2);
    const size_t hstepB = (size_t)HALF * K * 2, pstepB = (size_t)64 * K * 2;
    const size_t hstepA = (size_t)HALF * pitch, pstepA = (size_t)64 * pitch;
    const unsigned ldsw = (unsigned)wid * 1024u;
    const int aoffl = lds_byte(wr * 64 + fr, fq * 8), boffl = lds_byte(wc * 32 + fr, fq * 8);
#define PG8_SA(b, h) (((b) * 2 + (h)) * HTB)
#define PG8_SB(b, h) ((4 + (b) * 2 + (h)) * HTB)
#define PG8_STAGEB(bufoff, gbase) do { _Pragma("unroll") for (int _i = 0; _i < 2; ++_i) \
        __builtin_amdgcn_global_load_lds((const unsigned*)((const char*)(gbase) + _i * pstepB + voffB), (LAS unsigned*)(lds + (bufoff) + ldsw + _i * 8192), 16, 0, 0); } while (0)
#define PG8_STAGEA(bufoff, TP, OFFS, h, kb) do { _Pragma("unroll") for (int _i = 0; _i < 2; ++_i) { \
        const char* _p; if constexpr (GATHER) _p = Abase + (size_t)(OFFS)[h][_i] + (kb); else _p = (TP) + ((h) * hstepA + _i * pstepA + (kb)) + laneA; \
        __builtin_amdgcn_global_load_lds((const unsigned*)_p, (LAS unsigned*)(lds + (bufoff) + ldsw + _i * 8192), 16, 0, 0); } } while (0)
#define PG8_LDA(dst, b, h) do { _Pragma("unroll") for (int m = 0; m < 4; ++m) _Pragma("unroll") for (int k = 0; k < 2; ++k) dst[m][k] = *(const LAS bf16x8*)(lds + PG8_SA(b, h) + aoffl + m * 2048 + k * 1024); } while (0)
#define PG8_LDB(dst, b, h) do { _Pragma("unroll") for (int n = 0; n < 2; ++n) _Pragma("unroll") for (int k = 0; k < 2; ++k) dst[n][k] = *(const LAS bf16x8*)(lds + PG8_SB(b, h) + boffl + n * 2048 + k * 1024); } while (0)
#define PG8_MMA(ai, bj, At, Bt) do { __builtin_amdgcn_s_setprio(1); _Pragma("unroll") for (int m = 0; m < 4; ++m) _Pragma("unroll") for (int n = 0; n < 2; ++n) _Pragma("unroll") for (int k = 0; k < 2; ++k) \
        acc[ai][bj][m][n] = __builtin_amdgcn_mfma_f32_16x16x32_bf16(Bt[n][k], At[m][k], acc[ai][bj][m][n], 0, 0, 0); __builtin_amdgcn_s_setprio(0); } while (0)
#define PG8_WAIT_V(n) asm volatile("s_waitcnt vmcnt(" #n ")" ::: "memory")
#define PG8_WAIT_L(n) asm volatile("s_waitcnt lgkmcnt(" #n ")" ::: "memory")
#define PG8_BAR __builtin_amdgcn_s_barrier()
#define PG8_SCHED __builtin_amdgcn_sched_barrier(0)
#define PG8_AOFFS(dst, tp, u) do { if constexpr (GATHER) { _Pragma("unroll") for (int _h = 0; _h < 2; ++_h) _Pragma("unroll") for (int _i = 0; _i < 2; ++_i) dst[_h][_i] = aoff(u, _h * 128 + _i * 64 + sR) + (unsigned)sC * 2u; } \
        else tp = aoff(u); } while (0)
    Unit cur, nxt; int ui = 0;
    if (!S.next(0, cur)) return;
    f32x4 acc[2][2][4][2];
#pragma unroll
    for (int a = 0; a < 2; ++a)
#pragma unroll
        for (int b = 0; b < 2; ++b)
#pragma unroll
            for (int m = 0; m < 4; ++m)
#pragma unroll
                for (int n = 0; n < 2; ++n) acc[a][b][m][n] = (f32x4){0.f, 0.f, 0.f, 0.f};
    bf16x8 At[4][2], B0[2][2], B1[2][2];
    unsigned cA[2][2] = {{0u, 0u}, {0u, 0u}}, nA[2][2] = {{0u, 0u}, {0u, 0u}}; const char* cTP = Abase; const char* nTP = Abase;
    PG8_AOFFS(cA, cTP, cur);
    const char* cB = bptr(cur);
    PG8_STAGEB(PG8_SB(0, 0), cB); PG8_STAGEB(PG8_SB(0, 1), cB + hstepB); PG8_STAGEA(PG8_SA(0, 0), cTP, cA, 0, 0); PG8_STAGEA(PG8_SA(0, 1), cTP, cA, 1, 0);
    if (wr == 1) PG8_BAR;
    PG8_WAIT_V(2); PG8_BAR;
    PG8_STAGEB(PG8_SB(1, 0), cB + kstep); PG8_STAGEA(PG8_SA(1, 0), cTP, cA, 0, kstep); PG8_STAGEB(PG8_SB(1, 1), cB + hstepB + kstep);
    PG8_WAIT_V(6); PG8_BAR;
    for (;;) {
        const bool has_next = S.next(ui + 1, nxt);
        const char* nB = cB; nTP = cTP;
        if (has_next) { PG8_AOFFS(nA, nTP, nxt); nB = bptr(nxt); }
        else { if constexpr (GATHER) {
#pragma unroll
            for (int h = 0; h < 2; ++h)
#pragma unroll
                for (int i = 0; i < 2; ++i) nA[h][i] = cA[h][i]; } }
        for (int t = 0; t < nt; t += 2) {
            const bool last = (t == nt - 2);
            const size_t k1 = (size_t)(t + 1) * kstep;
            unsigned a2o[2][2] = {{0u, 0u}, {0u, 0u}};
            if constexpr (GATHER) {
#pragma unroll
                for (int h = 0; h < 2; ++h)
#pragma unroll
                    for (int i = 0; i < 2; ++i) a2o[h][i] = last ? nA[h][i] : cA[h][i]; }
            const char* t2p = last ? nTP : cTP;
            const size_t k2 = last ? 0 : (size_t)(t + 2) * kstep, k3 = k2 + kstep;
            const char* b2 = last ? nB : cB + (size_t)(t + 2) * kstep; const char* b3 = b2 + kstep;
            PG8_LDB(B0, 0, 0); PG8_LDB(B1, 0, 1); PG8_SCHED; PG8_LDA(At, 0, 0); PG8_STAGEA(PG8_SA(1, 1), cTP, cA, 1, k1);
            PG8_WAIT_V(8); PG8_WAIT_L(0); PG8_BAR; PG8_MMA(0, 0, At, B0); PG8_MMA(0, 1, At, B1); PG8_BAR; PG8_SCHED;
            PG8_LDA(At, 0, 1); PG8_STAGEB(PG8_SB(0, 0), b2); PG8_STAGEB(PG8_SB(0, 1), b2 + hstepB); PG8_STAGEA(PG8_SA(0, 0), t2p, a2o, 0, k2);
            PG8_WAIT_V(8); PG8_WAIT_L(0); PG8_BAR; PG8_MMA(1, 0, At, B0); PG8_MMA(1, 1, At, B1); PG8_BAR; PG8_SCHED;
            PG8_LDB(B0, 1, 0); PG8_LDB(B1, 1, 1); PG8_SCHED; PG8_LDA(At, 1, 0); PG8_STAGEA(PG8_SA(0, 1), t2p, a2o, 1, k2);
            PG8_WAIT_V(8); PG8_WAIT_L(0); PG8_BAR; PG8_MMA(0, 0, At, B0); PG8_MMA(0, 1, At, B1); PG8_BAR; PG8_SCHED;
            PG8_LDA(At, 1, 1); PG8_STAGEB(PG8_SB(1, 0), b3); PG8_STAGEB(PG8_SB(1, 1), b3 + hstepB); PG8_STAGEA(PG8_SA(1, 0), t2p, a2o, 0, k3);
            PG8_WAIT_V(8); PG8_WAIT_L(0); PG8_BAR; PG8_MMA(1, 0, At, B0); PG8_MMA(1, 1, At, B1); PG8_BAR; PG8_SCHED;
        }
        if constexpr (ALIGN_EPI) { if (wr == 0) PG8_BAR; }
        { int l2 = lane; asm volatile("" : "+v"(l2)); E(acc, cur, wr, wc, l2 & 15, l2 >> 4); }
        if (!has_next) break;
#pragma unroll
        for (int a = 0; a < 2; ++a)
#pragma unroll
            for (int b = 0; b < 2; ++b)
#pragma unroll
                for (int m = 0; m < 4; ++m)
#pragma unroll
                    for (int n = 0; n < 2; ++n) acc[a][b][m][n] = (f32x4){0.f, 0.f, 0.f, 0.f};
        cur = nxt; cB = nB; cTP = nTP; ++ui;
        if constexpr (GATHER) {
#pragma unroll
            for (int h = 0; h < 2; ++h)
#pragma unroll
                for (int i = 0; i < 2; ++i) cA[h][i] = nA[h][i]; }
        if constexpr (ALIGN_EPI) { if (wr == 1) PG8_BAR; }
    }
    PG8_WAIT_V(0);
    if constexpr (!ALIGN_EPI) { if (wr == 0) PG8_BAR; }
    PG8_BAR;
#undef PG8_SA
#undef PG8_SB
#undef PG8_STAGEA
#undef PG8_STAGEB
#undef PG8_LDA
#undef PG8_LDB
#undef PG8_MMA
#undef PG8_WAIT_V
#undef PG8_WAIT_L
#undef PG8_BAR
#undef PG8_SCHED
#undef PG8_AOFFS
}
}

constexpr float YB_SCALE = 16.f, YB_INV = 1.f / 16.f;
#define FP8C(x) __builtin_amdgcn_fmed3f((x), -440.f, 440.f)
__device__ __forceinline__ u32x2 pack8_fp8(const f32x4& v0, const f32x4& v1) { u32x2 w; int p = __builtin_amdgcn_cvt_pk_fp8_f32(FP8C(v0[0]), FP8C(v0[1]), 0, false); p = __builtin_amdgcn_cvt_pk_fp8_f32(FP8C(v0[2]), FP8C(v0[3]), p, true); w.x = (unsigned)p;
    p = __builtin_amdgcn_cvt_pk_fp8_f32(FP8C(v1[0]), FP8C(v1[1]), 0, false); p = __builtin_amdgcn_cvt_pk_fp8_f32(FP8C(v1[2]), FP8C(v1[3]), p, true); w.y = (unsigned)p; return w; }
struct EpiStore { bf16_t* O; int ldc;
    __device__ __forceinline__ void operator()(const f32x4 (&acc)[2][2][4][2], const pg8::Unit& u, int wr, int wc, int fr, int fq) const {
        bf16_t* base = O + (size_t)(u.pm * 256 + wr * 64 + fr) * ldc + u.pn * 256 + wc * 32 + 8 * fq;
#pragma unroll
        for (int ai = 0; ai < 2; ++ai)
#pragma unroll
            for (int m = 0; m < 4; ++m) { bf16_t* rowp = base + (size_t)(ai * 128 + m * 16) * ldc;
#pragma unroll
                for (int bj = 0; bj < 2; ++bj) *(u32x4*)(rowp + bj * 128) = pg8::pack8(acc[ai][bj][m][0], acc[ai][bj][m][1]);
                asm volatile("" ::: "memory"); } } };
struct EpiG1 { bf16_t* P; float* rs; bf16_t* KR; const float* rope;
    __device__ __forceinline__ void operator()(const f32x4 (&acc)[2][2][4][2], const pg8::Unit& u, int wr, int wc, int fr, int fq) const {
        bf16_t* base = P + (size_t)(u.pm * 256 + wr * 64 + fr) * PW + u.pn * 256 + wc * 32 + 8 * fq;
#pragma unroll
        for (int ai = 0; ai < 2; ++ai)
#pragma unroll
            for (int m = 0; m < 4; ++m) { bf16_t* rowp = base + (size_t)(ai * 128 + m * 16) * PW;
#pragma unroll
                for (int bj = 0; bj < 2; ++bj) *(u32x4*)(rowp + bj * 128) = pg8::pack8(acc[ai][bj][m][0], acc[ai][bj][m][1]);
                asm volatile("" ::: "memory"); }
        if (u.pn < 2) {
#pragma unroll
            for (int ai = 0; ai < 2; ++ai)
#pragma unroll
                for (int m = 0; m < 4; ++m) { const int r = u.pm * 256 + ai * 128 + wr * 64 + m * 16 + fr;
                    const f32x4 a0 = acc[ai][0][m][0], a1 = acc[ai][0][m][1], b0 = acc[ai][1][m][0], b1 = acc[ai][1][m][1];
                    float ss = (a0[0] * a0[0] + a0[1] * a0[1]) + (a0[2] * a0[2] + a0[3] * a0[3]) + (a1[0] * a1[0] + a1[1] * a1[1]) + (a1[2] * a1[2] + a1[3] * a1[3]);
                    if (u.pn == 0) ss += (b0[0] * b0[0] + b0[1] * b0[1]) + (b0[2] * b0[2] + b0[3] * b0[3]) + (b1[0] * b1[0] + b1[1] * b1[1]) + (b1[2] * b1[2] + b1[3] * b1[3]);
                    { float o; const float a = swap16_f(ss, o); ss = a + o; }
                    { auto rr = __builtin_amdgcn_permlane32_swap(__float_as_uint(ss), __float_as_uint(ss), false, false); ss = __uint_as_float(rr[0]) + __uint_as_float(rr[1]); }
                    if (fq == 0) rs[(size_t)r * 8 + u.pn * 4 + wc] = ss;
                    if (u.pn == 1) {
                        f32x4 p0, p1;
#pragma unroll
                        for (int i = 0; i < 4; ++i) { float o; const float a = swap16_f(b0[i], o); p0[i] = (fq & 1) ? a : o; const float c = swap16_f(b1[i], o); p1[i] = (fq & 1) ? c : o; }
                        if (wc == 0) { f32x4 v0 = b0, v1 = b1;
                            if (r < TL) { const int sq = r & (SEQ - 1), pos = (fq & 2) ? (sq & 63) : (sq >> 6); const float* tb = rope + pos * 16;
                                const f32x4 cs0 = *(const f32x4*)tb, cs1 = *(const f32x4*)(tb + 4), sn0 = *(const f32x4*)(tb + 8), sn1 = *(const f32x4*)(tb + 12);
                                if (fq & 1) { v0 = v0 * cs0 + p0 * sn0; v1 = v1 * cs1 + p1 * sn1; } else { v0 = v0 * cs0 - p0 * sn0; v1 = v1 * cs1 - p1 * sn1; } }
                            *(u32x4*)(KR + (size_t)kvrow_of(r) * 32 + 8 * fq) = pg8::pack8(v0, v1); } }
                    asm volatile("" ::: "memory"); } } } };
__device__ __forceinline__ void g1_phase(const Ctx& F0) {
    const Ctx F = fresh(F0);
    pg8::StaticOrder S; S.init(TT, PW, F.G, F.bid);
    const char* Ab = (const char*)(F.ws + WS_H);
    auto aoff = [&](const pg8::Unit& u) { return Ab + (size_t)u.pm * 256 * DM * 2; };
    const char* Bt = (const char*)(F.ws + WS_W + W_WIN);
    auto bptr = [&](const pg8::Unit& u) { return Bt + (size_t)u.pn * 256 * DM * 2; };
    EpiG1 E{(bf16_t*)(F.ws + WS_P), (float*)(F.ws + WS_MISC + M_RS), (bf16_t*)(F.ws + WS_KR), (const float*)(F.ws + WS_MISC + M_ROPE)};
    pg8::gemm256<false>(F.lds, F.tid, Ab, DM * 2, DM, S, aoff, bptr, E);
}
struct EpiQ { bf16_t* Q; bf16_t* QR; const float* rs; const float* rope;
    __device__ __forceinline__ void operator()(const f32x4 (&acc)[2][2][4][2], const pg8::Unit& u, int wr, int wc, int fr, int fq) const {
        float rs8[2][4];
#pragma unroll
        for (int ai = 0; ai < 2; ++ai)
#pragma unroll
            for (int m = 0; m < 4; ++m) { const f32x4 q4 = *(const f32x4*)(rs + (size_t)(u.pm * 256 + ai * 128 + wr * 64 + m * 16 + fr) * 8); rs8[ai][m] = __builtin_amdgcn_rsqf(((q4[0] + q4[1]) + (q4[2] + q4[3])) * (1.f / 256.f) + EPS); }
#pragma unroll
        for (int ai = 0; ai < 2; ++ai)
#pragma unroll
            for (int m = 0; m < 4; ++m) { const int r = u.pm * 256 + ai * 128 + wr * 64 + m * 16 + fr; const float sc = rs8[ai][m] * (ATTN_SCALE * 1.4426950408889634f); const int s = r & (SEQ - 1);
#pragma unroll
                for (int bj = 0; bj < 2; ++bj) { const int col0 = u.pn * 256 + bj * 128 + wc * 32 + 8 * fq, hh = col0 / 96, cw = col0 - hh * 96;
                    f32x4 v0 = acc[ai][bj][m][0] * sc, v1 = acc[ai][bj][m][1] * sc; f32x4 p0, p1;
#pragma unroll
                    for (int i = 0; i < 4; ++i) { p0[i] = __shfl_xor(v0[i], 16); p1[i] = __shfl_xor(v1[i], 16); }
                    if (cw >= 64 && r < TL) { const int c2 = cw - 64, pos = (c2 & 16) ? (s & 63) : (s >> 6); const bool second = (c2 & 8) != 0; const float* tb = rope + pos * 16;
                        *(u32x4*)(QR + (size_t)r * 256 + hh * 32 + c2) = pg8::pack8(v0, v1);
                        const f32x4 cs0 = *(const f32x4*)tb, cs1 = *(const f32x4*)(tb + 4), sn0 = *(const f32x4*)(tb + 8), sn1 = *(const f32x4*)(tb + 12);
                        if (second) { v0 = v0 * cs0 + p0 * sn0; v1 = v1 * cs1 + p1 * sn1; } else { v0 = v0 * cs0 - p0 * sn0; v1 = v1 * cs1 - p1 * sn1; } }
                    *(u32x4*)(Q + (size_t)r * 768 + col0) = pg8::pack8(v0, v1); }
                asm volatile("" ::: "memory"); } } };
struct EpiKV { bf16_t* KV; const float* rs;
    __device__ __forceinline__ void operator()(const f32x4 (&acc)[2][2][4][2], const pg8::Unit& u, int wr, int wc, int fr, int fq) const {
        float rs8[2][4];
#pragma unroll
        for (int ai = 0; ai < 2; ++ai)
#pragma unroll
            for (int m = 0; m < 4; ++m) { const f32x4 q4 = *(const f32x4*)(rs + (size_t)(u.pm * 256 + ai * 128 + wr * 64 + m * 16 + fr) * 8 + 4); rs8[ai][m] = __builtin_amdgcn_rsqf(((q4[0] + q4[1]) + (q4[2] + q4[3])) * (1.f / 128.f) + EPS); }
#pragma unroll
        for (int ai = 0; ai < 2; ++ai)
#pragma unroll
            for (int m = 0; m < 4; ++m) { const int r = u.pm * 256 + ai * 128 + wr * 64 + m * 16 + fr; const float sc = rs8[ai][m]; bf16_t* rowp = KV + (size_t)kvrow_of(r) * 1024 + u.pn * 256 + wc * 32 + 8 * fq;
#pragma unroll
                for (int bj = 0; bj < 2; ++bj) *(u32x4*)(rowp + bj * 128) = pg8::pack8(acc[ai][bj][m][0] * sc, acc[ai][bj][m][1] * sc);
                asm volatile("" ::: "memory"); } } };
struct EpiQKV { EpiKV ekv; EpiQ eq;
    __device__ __forceinline__ void operator()(const f32x4 (&acc)[2][2][4][2], const pg8::Unit& u, int wr, int wc, int fr, int fq) const { if (u.e == 0) ekv(acc, u, wr, wc, fr, fq); else eq(acc, u, wr, wc, fr, fq); } };
__device__ __forceinline__ void g23_phase(const Ctx& F0) {
    const Ctx F = fresh(F0);
    pg8::DualOrder S; S.A.init(TT, 1024, F.G, F.bid); S.B.init(TT, 768, F.G, F.bid); S.G = F.G; S.c = F.bid;
    const char* Abq = (const char*)(F.ws + WS_P);
    auto aoff = [&](const pg8::Unit& u) { return Abq + (size_t)(u.e == 0 ? OFF_KV * 2 : 0) + (size_t)u.pm * 256 * PW * 2; };
    const char* Wb = (const char*)(F.ws + WS_W);
    auto bptr = [&](const pg8::Unit& u) { return Wb + (size_t)(u.e == 0 ? W_WKV : W_WQ) + (size_t)u.pn * 256 * 256 * 2; };
    EpiQKV E{EpiKV{(bf16_t*)(F.ws + WS_KV), (const float*)(F.ws + WS_MISC + M_RS)}, EpiQ{(bf16_t*)(F.ws + WS_Q), (bf16_t*)(F.ws + WS_QR), (const float*)(F.ws + WS_MISC + M_RS), (const float*)(F.ws + WS_MISC + M_ROPE)}};
    pg8::gemm256<false>(F.lds, F.tid, Abq, PW * 2, 256, S, aoff, bptr, E);
}
struct EpiStore8 { unsigned char* O;
    __device__ __forceinline__ void operator()(const f32x4 (&acc)[2][2][4][2], const pg8::Unit& u, int wr, int wc, int fr, int fq) const {
        unsigned char* base = O + (size_t)(u.pm * 256 + wr * 64 + fr) * DM + u.pn * 256 + wc * 64 + 16 * fq;
#pragma unroll
        for (int ai = 0; ai < 2; ++ai)
#pragma unroll
            for (int m = 0; m < 4; ++m) { const u32x2 lo = pack8_fp8(acc[ai][0][m][0] * YB_SCALE, acc[ai][0][m][1] * YB_SCALE), hi = pack8_fp8(acc[ai][1][m][0] * YB_SCALE, acc[ai][1][m][1] * YB_SCALE);
                *(u32x4*)(base + (size_t)(ai * 128 + m * 16) * DM) = (u32x4){lo.x, lo.y, hi.x, hi.y};
                asm volatile("" ::: "memory"); } } };
__device__ __forceinline__ void g4_phase(const Ctx& F0, int nrows) {
    const Ctx F = fresh(F0);
    pg8::StaticOrder S; S.init(nrows, DM, F.G, F.bid);
    const char* Ab = (const char*)(F.ws + WS_MIX);
    auto aoff = [&](const pg8::Unit& u) { return Ab + (size_t)u.pm * 256 * DM * 2; };
    const char* Bt = (const char*)(F.ws + WS_W + W_WO);
    auto bptr = [&](const pg8::Unit& u) { return Bt + (size_t)u.pn * 256 * DM * 2; };
    EpiStore8 E{(unsigned char*)(F.ws + WS_Y1)};
    pg8::gemm256<false>(F.lds, F.tid, Ab, DM * 2, DM, S, aoff, bptr, E);
}

constexpr int LDS_ET = 139264, LDS_TE = LDS_ET + 512, LDS_RT = LDS_TE + 3072;
static_assert(LDS_RT + 8192 <= LDS_XB, "LDS tables");
__device__ __forceinline__ void expert_tables(const Ctx& F, int l, int nrows) {
    LAS int* tl = (LAS int*)(F.lds + LDS_ET); LAS int* cnt = tl + 64; LAS int* te = (LAS int*)(F.lds + LDS_TE);
    if (F.tid == 0) { int acc = 0;
        for (int e = 0; e < 33; ++e) { const int c = e < 32 ? (int)__hip_atomic_load(((unsigned*)(F.ws + WS_CTL)) + CW_GCNT + l * 64 + e, __ATOMIC_RELAXED, __HIP_MEMORY_SCOPE_AGENT) : nrows; cnt[e] = c; tl[e] = acc; acc += (c + 255) / 256; }
        tl[33] = acc; }
    __syncthreads();
    const int nmt = tl[33];
    for (int mt = F.tid; mt < nmt && mt < 768; mt += NTHR) { int e = 0; while (e < 32 && mt >= tl[e + 1]) ++e; te[mt] = e; }
    __syncthreads();
}
struct EpiGU { bf16_t* HB;
    __device__ __forceinline__ void operator()(const f32x4 (&acc)[2][2][4][2], const pg8::Unit& u, int wr, int wc, int fr, int fq) const {
#pragma unroll
        for (int ai = 0; ai < 2; ++ai)
#pragma unroll
            for (int m = 0; m < 4; ++m) { const int rl = ai * 128 + wr * 64 + m * 16 + fr;
                if (rl < u.nvalid) { f32x4 h0, h1;
#pragma unroll
                    for (int i = 0; i < 4; ++i) { h0[i] = silu(acc[ai][0][m][0][i]) * acc[ai][1][m][0][i]; h1[i] = silu(acc[ai][0][m][1][i]) * acc[ai][1][m][1][i]; }
                    *(u32x4*)(HB + (size_t)(u.base + u.pm * 256 + rl) * 256 + u.pn * 128 + wc * 32 + 8 * fq) = pg8::pack8(h0, h1); }
                asm volatile("" ::: "memory"); } } };
__device__ __forceinline__ void g5_phase(const Ctx& F0, int l, int nrows) {
    const Ctx F = fresh(F0);
    expert_tables(F, l, nrows);
    const LAS int* tl = (const LAS int*)(F.lds + LDS_ET); const LAS int* cnt = tl + 64;
    pg8::ExpertOrder S; S.init(tl, cnt, (const LAS int*)(F.lds + LDS_TE), 2, F.G, F.bid);
    const int* list = (const int*)(F.ws + WS_MISC + M_LIST);
    LAS unsigned* rowtab = (LAS unsigned*)(F.lds + LDS_RT);
    { pg8::Unit u;
      for (int i = 0; i < 8 && S.next(i, u); ++i) if (F.tid < 256) { int r = u.pm * 256 + F.tid; const int lastv = u.pm * 256 + u.nvalid - 1; r = r < lastv ? r : lastv;
          const int tok = u.e < 32 ? list[(size_t)u.e * TT + r] : r; rowtab[i * 256 + F.tid] = (unsigned)tok * (unsigned)(DM * 2); }
      __syncthreads(); }
    auto aoff = [&](const pg8::Unit& u, int R) { return rowtab[(u.idx & 7) * 256 + R]; };
    const char* Bt = (const char*)(F.ws + WS_W + W_WGU);
    auto bptr = [&](const pg8::Unit& u) { return Bt + ((size_t)u.e * 512 + (size_t)u.pn * 256) * DM * 2; };
    EpiGU E{(bf16_t*)(F.ws + WS_HB)};
    pg8::gemm256<true>(F.lds, F.tid, (const char*)(F.ws + WS_H), DM * 2, DM, S, aoff, bptr, E);
}
struct EpiD { unsigned char* YB; unsigned char* YS8; const float* listw;
    __device__ __forceinline__ void operator()(const f32x4 (&acc)[2][2][4][2], const pg8::Unit& u, int wr, int wc, int fr, int fq) const {
        float g8[2][4];
#pragma unroll
        for (int ai = 0; ai < 2; ++ai)
#pragma unroll
            for (int m = 0; m < 4; ++m) { const int rl = ai * 128 + wr * 64 + m * 16 + fr; g8[ai][m] = (u.e < 32 && rl < u.nvalid) ? listw[(size_t)u.e * TT + u.pm * 256 + rl] : 1.f; }
#pragma unroll
        for (int ai = 0; ai < 2; ++ai)
#pragma unroll
            for (int m = 0; m < 4; ++m) { const int rl = ai * 128 + wr * 64 + m * 16 + fr;
                if (rl < u.nvalid) { const int i = u.pm * 256 + rl; const int co = u.pn * 256 + wc * 64 + 16 * fq;
                    if (u.e < 32) { const float g = g8[ai][m] * YB_SCALE; const u32x2 lo = pack8_fp8(acc[ai][0][m][0] * g, acc[ai][0][m][1] * g), hi = pack8_fp8(acc[ai][1][m][0] * g, acc[ai][1][m][1] * g);
                        *(u32x4*)(YB + (size_t)(u.base + i) * DM + co) = (u32x4){lo.x, lo.y, hi.x, hi.y}; }
                    else { const u32x2 lo = pack8_fp8(acc[ai][0][m][0] * YB_SCALE, acc[ai][0][m][1] * YB_SCALE), hi = pack8_fp8(acc[ai][1][m][0] * YB_SCALE, acc[ai][1][m][1] * YB_SCALE);
                        *(u32x4*)(YS8 + (size_t)i * DM + co) = (u32x4){lo.x, lo.y, hi.x, hi.y}; } }
                asm volatile("" ::: "memory"); } } };
__device__ __forceinline__ void g6_phase(const Ctx& F0, int l, int nrows) {
    const Ctx F = fresh(F0);
    expert_tables(F, l, nrows);
    const LAS int* tl = (const LAS int*)(F.lds + LDS_ET); const LAS int* cnt = tl + 64;
    pg8::ExpertOrder S; S.init(tl, cnt, (const LAS int*)(F.lds + LDS_TE), 4, F.G, F.bid);
    const char* Ab = (const char*)(F.ws + WS_HB);
    auto aoff = [&](const pg8::Unit& u) { return Ab + (size_t)(u.base + u.pm * 256) * 512; };
    const char* Bt = (const char*)(F.ws + WS_W + W_WD);
    auto bptr = [&](const pg8::Unit& u) { return Bt + ((size_t)u.e * DM + (size_t)u.pn * 256) * 256 * 2; };
    EpiD E{(unsigned char*)(F.ws + WS_YB), (unsigned char*)(F.ws + WS_YS8), (const float*)(F.ws + WS_MISC + M_LISTW)};
    pg8::gemm256<false>(F.lds, F.tid, Ab, 512, 256, S, aoff, bptr, E);
}

namespace att2 {
typedef float f32x16 __attribute__((ext_vector_type(16)));
typedef short s16x4 __attribute__((ext_vector_type(4)));
constexpr int NW = 8, QBLK = 32, QB = 256, KVBLK = 64;
__device__ __forceinline__ int crow(int r, int hi) { return (r & 3) + 8 * (r >> 2) + 4 * hi; }
#define SBAR() __builtin_amdgcn_sched_barrier(0)
constexpr int SLOTB = 8192, RSLOTB = 4096;
constexpr int LDS_K = 0, LDS_V = 4 * SLOTB, LDS_R = 8 * SLOTB, LDS_WS = LDS_R + 4 * RSLOTB, LDS_OST = LDS_WS + NW * 64 * 4, LDS_BYTES_ATT = LDS_OST + NW * 4096;
static_assert(LDS_BYTES_ATT <= 131072, "attention LDS");
__device__ __forceinline__ void glds16s(const void* sbase, unsigned voff, unsigned lds_dst) { unsigned keep;
  asm volatile("s_mov_b32 %0, m0\n\ts_mov_b32 m0, %3\n\ts_nop 0\n\tglobal_load_lds_dwordx4 %1, %2\n\ts_mov_b32 m0, %0" : "=&s"(keep) : "v"(voff), "s"(sbase), "s"(lds_dst) : "memory"); }
__device__ __forceinline__ float max3f(float a, float b, float c) { float r; asm("v_max3_f32 %0, %1, %2, %3" : "=v"(r) : "v"(a), "v"(b), "v"(c)); return r; }
__device__ __forceinline__ float max2f(float a, float b) { float r; asm("v_max_f32_e32 %0, %1, %2" : "=v"(r) : "v"(a), "v"(b)); return r; }
__device__ __forceinline__ float fadd_s(float a, float b) { float r; asm("v_add_f32_e32 %0, %1, %2" : "=v"(r) : "v"(a), "v"(b)); return r; }
__device__ __forceinline__ float fsub_s(float a, float b) { float r; asm("v_sub_f32_e32 %0, %1, %2" : "=v"(r) : "v"(a), "v"(b)); return r; }
typedef float f32x2_t __attribute__((ext_vector_type(2))); typedef __bf16 bf16x2_t __attribute__((ext_vector_type(2)));
__device__ __forceinline__ unsigned cvtpk_s(float lo, float hi) { f32x2_t v = {lo, hi}; bf16x2_t b = __builtin_convertvector(v, bf16x2_t); return __builtin_bit_cast(unsigned, b); }
#define WAIT_BAR(N) asm volatile("s_waitcnt vmcnt(" #N ") lgkmcnt(0)\n\ts_barrier" ::: "memory")
#define WAIT_T() do { if (wid < 4) { WAIT_BAR(3); } else { WAIT_BAR(2); } } while (0)
typedef __attribute__((address_space(3))) const char* lds_cptr;
typedef short v4i16_t __attribute__((ext_vector_type(4)));
#define LDSF(p) (*(const __attribute__((address_space(3))) bf16x8*)(p))
#define KFRAG(kp, rp, j) ((j) < 8 ? LDSF((kp) + ((j) >> 1) * 2048 + ((j) & 1) * 512) : LDSF((rp) + (((j) - 8) >> 1) * 2048 + ((j) & 1) * 512))
__device__ __forceinline__ void qkt0(f32x16& p0, f32x16& p1, lds_cptr kp, lds_cptr rp, const bf16x8* qr, const f32x16& negm) {
#pragma unroll
  for (int d0 = 0; d0 < 6; ++d0) {
    const bf16x8 b0 = KFRAG(kp, rp, 2 * d0), b1 = KFRAG(kp, rp, 2 * d0 + 1);
    if (d0 == 0) { p0 = __builtin_amdgcn_mfma_f32_32x32x16_bf16(b0, qr[0], negm, 0, 0, 0); p1 = __builtin_amdgcn_mfma_f32_32x32x16_bf16(b1, qr[0], negm, 0, 0, 0); }
    else { p0 = __builtin_amdgcn_mfma_f32_32x32x16_bf16(b0, qr[d0], p0, 0, 0, 0); p1 = __builtin_amdgcn_mfma_f32_32x32x16_bf16(b1, qr[d0], p1, 0, 0, 0); } }
}
__device__ __forceinline__ s16x4 vtr(lds_cptr p) { return __builtin_bit_cast(s16x4, __builtin_amdgcn_ds_read_tr16_b64_v4i16((__attribute__((address_space(3))) v4i16_t*)p)); }
__device__ __forceinline__ float rowmax(const f32x16& p0, const f32x16& p1) {
  float a = max3f(p0[0], p0[1], p1[0]), b = max3f(p0[2], p0[3], p1[1]); a = max3f(a, p1[2], p1[3]);
#pragma unroll
  for (int r = 4; r < 16; r += 4) { a = max3f(a, p0[r], p0[r + 1]); b = max3f(b, p0[r + 2], p0[r + 3]); a = max3f(a, p1[r], p1[r + 1]); b = max3f(b, p1[r + 2], p1[r + 3]); }
  const float m = max2f(a, b);
  auto rr = __builtin_amdgcn_permlane32_swap(__float_as_uint(m), __float_as_uint(m), false, false);
  return max2f(__uint_as_float(rr[0]), __uint_as_float(rr[1]));
}
__device__ __forceinline__ void pv(f32x16* o, int vb, bf16x8 pa0, bf16x8 pa1, bf16x8 pa2, bf16x8 pa3) {
#pragma unroll
  for (int d0 = 0; d0 < 2; ++d0) { s16x4 lo[4], hi[4];
#pragma unroll
    for (int ks = 0; ks < 4; ++ks) {
      asm volatile("ds_read_b64_tr_b16 %0,%1 offset:%c2" : "=&v"(lo[ks]) : "v"(vb), "i"(d0 * 4096 + ks * 1024) : "memory");
      asm volatile("ds_read_b64_tr_b16 %0,%1 offset:%c2" : "=&v"(hi[ks]) : "v"(vb), "i"(d0 * 4096 + ks * 1024 + 512) : "memory"); }
    asm volatile("s_waitcnt lgkmcnt(0)" ::: "memory"); SBAR();
#define PK(k) (bf16x8){lo[k][0], lo[k][1], lo[k][2], lo[k][3], hi[k][0], hi[k][1], hi[k][2], hi[k][3]}
    o[d0] = __builtin_amdgcn_mfma_f32_32x32x16_bf16(pa0, PK(0), o[d0], 0, 0, 0);
    o[d0] = __builtin_amdgcn_mfma_f32_32x32x16_bf16(pa1, PK(1), o[d0], 0, 0, 0);
    o[d0] = __builtin_amdgcn_mfma_f32_32x32x16_bf16(pa2, PK(2), o[d0], 0, 0, 0);
    o[d0] = __builtin_amdgcn_mfma_f32_32x32x16_bf16(pa3, PK(3), o[d0], 0, 0, 0);
#undef PK
  }
}
template <int THRL, unsigned VAR = 0u> __device__ __forceinline__ void attn_unit(const bf16_t* Q, const bf16_t* QRb, const bf16_t* __restrict__ KV, const bf16_t* __restrict__ KR, bf16_t* O,
                                                             int qrow0, int h, int kvb, int NT, int NRAW, char* shm, int tid) {
  const int lane = tid & 63, r32 = lane & 31, hi = lane >> 5; const int wid = __builtin_amdgcn_readfirstlane(tid >> 6);
  const bf16_t* Qw = Q + (size_t)(qrow0 + wid * QBLK) * 768 + h * 96;
  const bf16_t* Kh = KV + (size_t)kvb * 1024 + h * 128; const bf16_t* Rh = KR + (size_t)kvb * 32;
  const unsigned lds0 = (unsigned)(uintptr_t)shm;
  float* wsf = (float*)(shm + LDS_WS) + wid * 64;
  const unsigned koff = (unsigned)(lane * 1024 + wid * 8) * 2u, voff = (unsigned)((16 * (wid & 3) + (lane >> 2)) * 1024 + 64 + (wid >> 2) * 32 + (lane & 3) * 8) * 2u, roff = (unsigned)(lane * 32 + (wid & 3) * 8) * 2u;
  const unsigned kdst = lds0 + LDS_K + wid * 1024, vdst = lds0 + LDS_V + wid * 1024, rdst = lds0 + LDS_R + (wid & 3) * 1024;
#define DMA_T(t) do { const char* kb_ = (const char*)Kh + (size_t)(t) * (KVBLK * 2048); const char* rb_ = (const char*)Rh + (size_t)(t) * (KVBLK * 64); \
                      glds16s(kb_, koff, (unsigned)__builtin_amdgcn_readfirstlane(kdst + ((t) & 3) * SLOTB)); \
                      if (wid < 4) glds16s(rb_, roff, (unsigned)__builtin_amdgcn_readfirstlane(rdst + ((t) & 3) * RSLOTB)); \
                      glds16s(kb_, voff, (unsigned)__builtin_amdgcn_readfirstlane(vdst + ((t) & 3) * SLOTB)); } while (0)
  const int vb0 = (int)(lds0 + LDS_V) + ((lane >> 4) & 1) * 32 + (lane & 3) * 8 + (4 * hi + ((lane & 15) >> 2)) * 64;
  const lds_cptr shm3 = (lds_cptr)shm; const lds_cptr kp0 = shm3 + LDS_K + hi * 1024 + r32 * 16; const lds_cptr rp0 = shm3 + LDS_R + hi * 1024 + r32 * 16;
  const lds_cptr vp0 = shm3 + LDS_V + ((lane >> 4) & 1) * 32 + (lane & 3) * 8 + (4 * hi + ((lane & 15) >> 2)) * 64;
  bf16x8 qr[6];
#pragma unroll
  for (int d0 = 0; d0 < 4; ++d0) qr[d0] = *reinterpret_cast<const bf16x8*>(&Qw[(size_t)r32 * 768 + d0 * 16 + hi * 8]);
  { const bf16_t* qp = NRAW > 0 ? QRb + (size_t)(qrow0 + wid * QBLK + r32) * 256 + h * 32 + hi * 8 : Qw + (size_t)r32 * 768 + 64 + hi * 8;
    qr[4] = *reinterpret_cast<const bf16x8*>(qp); qr[5] = *reinterpret_cast<const bf16x8*>(qp + 16); }
  const lds_cptr qp0 = shm3 + LDS_OST + wid * 4096 + lane * 16;
#pragma unroll
  for (int d0 = 0; d0 < 4; ++d0) *(__attribute__((address_space(3))) bf16x8*)(shm3 + LDS_OST + wid * 4096 + lane * 16 + d0 * 1024) = qr[d0];
#define QF(d0) LDSF(qp0 + (d0) * 1024)
  DMA_T(0); DMA_T(1);
  float mhat = 0.f, l_reg = 0.f; f32x16 o[2], negm; { float z0 = 0.f; asm volatile("" : "+v"(z0));
#pragma unroll
    for (int r = 0; r < 16; ++r) { o[0][r] = z0; o[1][r] = z0; negm[r] = z0; } }
  asm volatile("" : "+v"(negm));
  bool resc = false;
#define START(P0, P1) do { const float rm = rowmax(P0, P1); resc = false; \
    { const float dl = rm; mhat = fadd_s(mhat, dl); \
      _Pragma("unroll") for (int r = 0; r < 16; ++r) { P0[r] = fsub_s(P0[r], dl); P1[r] = fsub_s(P1[r], dl); } \
      _Pragma("unroll") for (int r = 0; r < 16; ++r) negm[r] = -mhat; asm volatile("" : "+v"(negm)); } \
    _Pragma("unroll") for (int r = 0; r < 16; ++r) P0[r] = __builtin_amdgcn_exp2f(P0[r]); } while (0)
#define RESC() do { if (resc) { asm volatile("s_waitcnt lgkmcnt(0)" ::: "memory"); \
      _Pragma("unroll") for (int d_ = 0; d_ < 2; ++d_) _Pragma("unroll") for (int r = 0; r < 16; ++r) o[d_][r] *= wsf[crow(r, hi)]; } } while (0)
  f32x16 pA0, pA1, pB0, pB1;
  WAIT_T();
  qkt0(pA0, pA1, kp0, rp0, qr, negm); asm volatile("s_nop 15\n\ts_nop 7" : "+v"(pA0), "+v"(pA1));
  START(pA0, pA1);
  _Pragma("unroll") for (int r = 0; r < 16; ++r) pA1[r] = __builtin_amdgcn_exp2f(pA1[r]);
  DMA_T(2);
  WAIT_T();
  s16x4 vl0, vh0, vl1, vh1, vl2, vh2, vl3, vh3; u32x4 pw0, pw1, pw2, pw3; bf16x8 fa, fb, fc, fd;
#define PKW(P, B) cvtpk_s(P[B], P[B + 1])
#define PAF(k) __builtin_bit_cast(bf16x8, pw##k)
#define VFS(s) (bf16x8){vl##s[0], vl##s[1], vl##s[2], vl##s[3], vh##s[0], vh##s[1], vh##s[2], vh##s[3]}
#define PIN(x) asm volatile("" : "+v"(x))
#define MX3(a, b, c) __builtin_fmaxf(__builtin_fmaxf((a), (b)), (c))
#define GAPA(MF, A0, A1, A2, A3, W0, W1, PW) do { MF; if constexpr (!(VAR & 4u)) { sacc += A0; sacc += A1; sacc += A2; sacc += A3; PIN(sacc); W0; W1; PIN(PW); } SBAR(); } while (0)
#define GAPR(MF) do { MF; SBAR(); } while (0)
#define EX(v) ((VAR & 2u) ? (v) : __builtin_amdgcn_exp2f(v))
#define GAPB(MF, X, B) do { MF; X[B] = EX(X[B]); X[B + 1] = EX(X[B + 1]); X[B + 2] = EX(X[B + 2]); X[B + 3] = EX(X[B + 3]); PIN(X); SBAR(); } while (0)
#define VRD(s, i) do { vl##s = vtr(vp_ + (((i) >> 2) * 4096 + ((i) & 3) * 1024)); vh##s = vtr(vp_ + (((i) >> 2) * 4096 + ((i) & 3) * 1024 + 512)); } while (0)
#define MF32(A, B, C) ((VAR & 16u) ? (C) : __builtin_amdgcn_mfma_f32_32x32x16_bf16(A, B, C, 0, 0, 0))
#define STEP(C0, C1, P0, P1, t, GD) do { SBAR(); \
    const lds_cptr vp_ = vp0 + (((t) - 1) & 3) * SLOTB; const lds_cptr kp_ = kp0 + ((t) & 3) * SLOTB; const lds_cptr rp_ = rp0 + ((t) & 3) * RSLOTB; \
    fa = KFRAG(kp_, rp_, 0); fb = KFRAG(kp_, rp_, 1); fc = KFRAG(kp_, rp_, 2); fd = KFRAG(kp_, rp_, 3); \
    VRD(0, 0); SBAR(); float sacc = (P0[0] + P0[1]); \
    GAPA(C0 = MF32(fa, qr[0], negm), P0[2], P0[3], P0[4], P0[5],     pw0[0] = PKW(P0, 0), pw0[1] = PKW(P0, 2), pw0); fa = KFRAG(kp_, rp_, 4); \
    VRD(1, 4); SBAR(); GAPA(C1 = MF32(fb, qr[0], negm), P0[6], P0[7], P0[8], P0[9],     pw0[2] = PKW(P0, 4), pw0[3] = PKW(P0, 6), pw0); fb = KFRAG(kp_, rp_, 5); \
    VRD(2, 1); SBAR(); GAPA(C0 = MF32(fc, qr[1], C0),   P0[10], P0[11], P0[12], P0[13], pw1[0] = PKW(P0, 8), pw1[1] = PKW(P0, 10), pw1); fc = KFRAG(kp_, rp_, 6); \
    VRD(3, 5); SBAR(); GAPA(C1 = MF32(fd, qr[1], C1),   P0[14], P0[15], P1[0], P1[1],   pw1[2] = PKW(P0, 12), pw1[3] = PKW(P0, 14), pw1); fd = KFRAG(kp_, rp_, 7); \
    SBAR(); GAPA(C0 = MF32(fa, qr[2], C0),   P1[2], P1[3], P1[4], P1[5],     pw2[0] = PKW(P1, 0), pw2[1] = PKW(P1, 2), pw2); fa = KFRAG(kp_, rp_, 8); \
    SBAR(); GAPA(C1 = MF32(fb, qr[2], C1),   P1[6], P1[7], P1[8], P1[9],     pw2[2] = PKW(P1, 4), pw2[3] = PKW(P1, 6), pw2); fb = KFRAG(kp_, rp_, 9); \
    SBAR(); GAPA(C0 = MF32(fc, qr[3], C0),   P1[10], P1[11], P1[12], P1[13], pw3[0] = PKW(P1, 8), pw3[1] = PKW(P1, 10), pw3); fc = KFRAG(kp_, rp_, 10); \
    SBAR(); GAPA(C1 = MF32(fd, qr[3], C1),   P1[14], P1[15], 0.f, 0.f,       pw3[2] = PKW(P1, 12), pw3[3] = PKW(P1, 14), pw3); fd = KFRAG(kp_, rp_, 11); \
    SBAR(); GAPR(C0 = MF32(fa, qr[4], C0)); GAPR(C1 = MF32(fb, qr[4], C1)); GAPR(C0 = MF32(fc, qr[5], C0)); GAPR(C1 = MF32(fd, qr[5], C1)); \
    l_reg += sacc; \
    if constexpr (!(VAR & 1u)) { if (GD) { DMA_T((t) + 2); } } \
    { float a = MX3(C0[0], C0[1], C1[0]), b = MX3(C0[2], C0[3], C1[1]); a = MX3(a, C1[2], C1[3]); \
      _Pragma("unroll") for (int r = 4; r < 16; r += 4) { a = MX3(a, C0[r], C0[r + 1]); b = MX3(b, C0[r + 2], C0[r + 3]); a = MX3(a, C1[r], C1[r + 1]); b = MX3(b, C1[r + 2], C1[r + 3]); } \
      float rm = __builtin_fmaxf(a, b); { auto rr = __builtin_amdgcn_permlane32_swap(__float_as_uint(rm), __float_as_uint(rm), false, false); rm = __builtin_fmaxf(__uint_as_float(rr[0]), __uint_as_float(rr[1])); } \
      resc = false; \
      if (__builtin_expect(__any(rm > (float)THRL), 0)) { const float dl = __builtin_fmaxf(rm, 0.f); mhat += dl; \
        _Pragma("unroll") for (int r = 0; r < 16; ++r) { C0[r] -= dl; C1[r] -= dl; } \
        _Pragma("unroll") for (int r = 0; r < 16; ++r) negm[r] = -mhat; asm volatile("" : "+v"(negm)); \
        const float f = __builtin_amdgcn_exp2f(-dl); l_reg *= f; if (hi == 0) wsf[r32] = f; resc = true; } } \
    SBAR(); \
    GAPB(o[0] = MF32(PAF(0), VFS(0), o[0]), C0, 0); \
    GAPB(o[1] = MF32(PAF(0), VFS(1), o[1]), C0, 4); VRD(0, 2); VRD(1, 6); SBAR(); \
    GAPB(o[0] = MF32(PAF(1), VFS(2), o[0]), C0, 8); \
    GAPB(o[1] = MF32(PAF(1), VFS(3), o[1]), C0, 12); VRD(2, 3); VRD(3, 7); SBAR(); \
    GAPB(o[0] = MF32(PAF(2), VFS(0), o[0]), C1, 0); \
    GAPB(o[1] = MF32(PAF(2), VFS(1), o[1]), C1, 4); \
    GAPB(o[0] = MF32(PAF(3), VFS(2), o[0]), C1, 8); \
    GAPB(o[1] = MF32(PAF(3), VFS(3), o[1]), C1, 12); \
    } while (0)
#define QSW(tt) do { if ((tt) == NRAW) { qr[4] = *reinterpret_cast<const bf16x8*>(&Qw[(size_t)r32 * 768 + 64 + hi * 8]); qr[5] = *reinterpret_cast<const bf16x8*>(&Qw[(size_t)r32 * 768 + 80 + hi * 8]); } } while (0)
#define ENDW(tt) do { if ((tt) + 2 < NT) { WAIT_T(); } else { WAIT_BAR(0); } } while (0)
  int t = 1;
  for (; t + 3 < NT; t += 2) {
    STEP(pB0, pB1, pA0, pA1, t, true);     if constexpr (VAR & 8u) { asm volatile("s_waitcnt vmcnt(3) lgkmcnt(0)" ::: "memory"); } else { WAIT_T(); } RESC(); QSW(t + 1);
    STEP(pA0, pA1, pB0, pB1, t + 1, true); if constexpr (VAR & 8u) { asm volatile("s_waitcnt vmcnt(3) lgkmcnt(0)" ::: "memory"); } else { WAIT_T(); } RESC(); QSW(t + 2);
  }
  for (; t + 1 < NT; t += 2) {
    STEP(pB0, pB1, pA0, pA1, t, (t + 2 < NT));     ENDW(t);     RESC(); QSW(t + 1);
    STEP(pA0, pA1, pB0, pB1, t + 1, (t + 3 < NT)); ENDW(t + 1); RESC(); QSW(t + 2);
  }
  STEP(pB0, pB1, pA0, pA1, NT - 1, false); WAIT_BAR(0); RESC();
  { float sacc = pB0[0] + pB0[1]; _Pragma("unroll") for (int r = 2; r < 16; ++r) sacc += pB0[r]; _Pragma("unroll") for (int r = 0; r < 16; ++r) sacc += pB1[r]; l_reg += sacc;
    pw0 = (u32x4){PKW(pB0, 0), PKW(pB0, 2), PKW(pB0, 4), PKW(pB0, 6)}; pw1 = (u32x4){PKW(pB0, 8), PKW(pB0, 10), PKW(pB0, 12), PKW(pB0, 14)}; pw2 = (u32x4){PKW(pB1, 0), PKW(pB1, 2), PKW(pB1, 4), PKW(pB1, 6)}; pw3 = (u32x4){PKW(pB1, 8), PKW(pB1, 10), PKW(pB1, 12), PKW(pB1, 14)};
    SBAR(); pv(o, vb0 + ((NT - 1) & 3) * SLOTB, PAF(0), PAF(1), PAF(2), PAF(3)); }
#undef PKW
#undef PAF
#undef VFS
#undef PIN
#undef MX3
#undef GAPA
#undef GAPR
#undef GAPB
#undef EX
#undef VRD
#undef MF32
#undef STEP
#undef ENDW
#undef QSW
  { auto rr = __builtin_amdgcn_permlane32_swap(__float_as_uint(l_reg), __float_as_uint(l_reg), false, false); l_reg = __uint_as_float(rr[0]) + __uint_as_float(rr[1]); }
  if (hi == 0) wsf[32 + r32] = l_reg; asm volatile("s_waitcnt lgkmcnt(0)" ::: "memory");
  float rli[16];
#pragma unroll
  for (int r = 0; r < 16; ++r) rli[r] = __builtin_amdgcn_rcpf(wsf[32 + crow(r, hi)]);
  bf16_t* Ow = O + (size_t)(qrow0 + wid * QBLK) * DM + h * 64;
  { bf16_t* stg = (bf16_t*)(shm + LDS_OST) + wid * 2048;
#pragma unroll
    for (int r = 0; r < 16; ++r) { const int orow = crow(r, hi);
#pragma unroll
      for (int d0 = 0; d0 < 2; ++d0) stg[orow * 64 + d0 * 32 + r32] = (bf16_t)f2bf(o[d0][r] * rli[r]); }
    asm volatile("s_waitcnt lgkmcnt(0)" ::: "memory");
#pragma unroll
    for (int i = 0; i < 4; ++i) { const int row = i * 8 + (lane >> 3), ch = lane & 7; const u32x4 v = *(const u32x4*)(stg + row * 64 + ch * 8); *(u32x4*)(Ow + (size_t)row * DM + ch * 8) = v; } }
  asm volatile("s_waitcnt vmcnt(0) lgkmcnt(0)\n\ts_barrier" ::: "memory");
#undef DMA_T
#undef START
#undef RESC
#undef QF
}
#undef SBAR
#undef WAIT_BAR
#undef WAIT_T
#undef LDSF
#undef KFRAG
}
template <unsigned VAR = 0u> __device__ __forceinline__ void attn_mfma_phase(const Ctx& F0, bool with_ctx_queries) {
    const Ctx F = fresh(F0);
    const bf16_t* Qp = (const bf16_t*)(F.ws + WS_Q); const bf16_t* QRp = (const bf16_t*)(F.ws + WS_QR); const bf16_t* KVp = (const bf16_t*)(F.ws + WS_KV); const bf16_t* KRp = (const bf16_t*)(F.ws + WS_KR);
    bf16_t* Op = (bf16_t*)(F.ws + WS_MIX);
    char* shm = (char*)(unsigned char*)F.lds;
    const int xg = F.bid & 7, slot = F.bid >> 3;
    if (F.G == 256) {
        for (int i = 0; i < 4; ++i) { const int bh = 8 * i + xg, b = bh >> 3, h = bh & 7;
            att2::attn_unit<8, VAR>(Qp, QRp, KVp, KRp, Op, b * SEQ + slot * 256, h, b * KVS, KVS / 64, CTXL / 64, shm, F.tid); }
    } else {
        for (int u = F.bid; u < 1024; u += F.G) { const int bh = u >> 5, b = bh >> 3, h = bh & 7;
            att2::attn_unit<8, VAR>(Qp, QRp, KVp, KRp, Op, b * SEQ + (u & 31) * 256, h, b * KVS, KVS / 64, CTXL / 64, shm, F.tid); }
    }
    if (with_ctx_queries) for (int u = F.bid; u < 32; u += F.G) { const int b = u >> 3, h = u & 7;
        att2::attn_unit<8, VAR>(Qp, QRp, KVp, KRp, Op, TL + b * CTXL, h, b * KVS, CTXL / 64, 0, shm, F.tid); }
    __syncthreads();
}

template <int G> __device__ __forceinline__ void pool_pair(const LAS float* UP, bf16_t* mrow, int t0, int n, int p, int ch) {
    constexpr int W = 2 << G, LO = W >> 1, HI = W - 1 - LO;
    const int a = 2 * p; const LAS float* up = UP + (a + 8 - LO) * 256 + 64 * G + 8 * ch;
    f32x4 r0[W + 1], r1[W + 1];
#pragma unroll
    for (int d = 0; d <= W; ++d) { r0[d] = *(const LAS f32x4*)(up + d * 256); r1[d] = *(const LAS f32x4*)(up + d * 256 + 4); }
    f32x4 s0 = r0[0], s1 = r1[0];
#pragma unroll
    for (int d = 1; d < W; ++d) { s0 = s0 + r0[d]; s1 = s1 + r1[d]; }
    const f32x4 q0 = s0 - r0[0] + r0[W], q1 = s1 - r1[0] + r1[W];
    const int ta = t0 + a, tb = ta + 1;
    const int sta = ta - LO < 0 ? 0 : ta - LO, ena = ta + HI + 1 > n ? n : ta + HI + 1, stb = tb - LO < 0 ? 0 : tb - LO, enb = tb + HI + 1 > n ? n : tb + HI + 1;
    const float rca = __builtin_amdgcn_rcpf((float)(ena - sta)), rcb = __builtin_amdgcn_rcpf((float)(enb - stb));
    const f32x4 a0 = s0 * rca - r0[LO], a1 = s1 * rca - r1[LO], b0 = q0 * rcb - r0[LO + 1], b1 = q1 * rcb - r1[LO + 1];
    bf16_t* op = mrow + (size_t)a * DM + 64 * G + 8 * ch;
    *(u32x4*)op = (u32x4){pk2(a0.x, a0.y), pk2(a0.z, a0.w), pk2(a1.x, a1.y), pk2(a1.z, a1.w)};
    *(u32x4*)(op + DM) = (u32x4){pk2(b0.x, b0.y), pk2(b0.z, b0.w), pk2(b1.x, b1.y), pk2(b1.z, b1.w)};
}
__device__ __forceinline__ void mixers_phase(const Ctx& F0, int l, int nrows, unsigned var = 0u) {
    const Ctx F = fresh(F0);
    LAS float* U = (LAS float*)F.lds;
    LAS float* Y = U + 62 * 256;
    LAS float* UP = Y + 32 * 256;
    const int c = F.tid & 255, hf = F.tid >> 8, tid = F.tid;
    const float* dwp = F.a->in[I_CDW] + (size_t)l * CONVK * 256 + c;
    float dw[CONVK];
#pragma unroll
    for (int k = 0; k < CONVK; ++k) dw[k] = dwp[k * 256];
    const float cb = F.a->in[I_CB][l * 256 + c];
    const bf16_t* Pp = (const bf16_t*)(F.ws + WS_P); bf16_t* MIXp = (bf16_t*)(F.ws + WS_MIX);
    const int nunits = nrows / 32, nfull = (nunits / F.G) * F.G, nrounds = (nunits + F.G - 1) / F.G;
    auto unit_of = [&](int i) { if (i * F.G < nfull) return i * F.G + F.bid; const int rem = nunits - nfull; if (F.G >= 64 && rem <= 32) return (F.bid >= 32 && F.bid < 32 + rem) ? nfull + F.bid - 32 : -1; const int u = i * F.G + F.bid; return u < nunits ? u : -1; };
    u32x4 ca[4], cg[4], pp[3];
    const u32x4 z4 = {0u, 0u, 0u, 0u};
#define MX_GEOM(u) const int r0 = (u) * 32; int rb, n; if (r0 < TL) { rb = r0 & ~(SEQ - 1); n = SEQ; } else { rb = TL + ((r0 - TL) & ~(CTXL - 1)); n = CTXL; } const int t0 = r0 - rb;
#define MX_ISSUE_CONV(u) do { MX_GEOM(u) _Pragma("unroll") for (int q = 0; q < 4; ++q) { const int i = tid + q * 512, tt = i >> 5, c8 = (i & 31) * 8, t = t0 - 15 + tt; ca[q] = z4; cg[q] = z4; \
        if (i < 62 * 32 && t >= 0 && t < n) { const bf16_t* p = Pp + (size_t)(rb + t) * PW + OFF_CONV + c8; ca[q] = *(const u32x4*)p; cg[q] = *(const u32x4*)(p + 256); } } } while (0)
#define MX_ISSUE_POOL(u) do { MX_GEOM(u) _Pragma("unroll") for (int q = 0; q < 3; ++q) { const int i = tid + q * 512, tt = i >> 5, c8 = (i & 31) * 8, t = t0 - 8 + tt; pp[q] = z4; \
        if (i < 47 * 32 && t >= 0 && t < n) pp[q] = *(const u32x4*)(Pp + (size_t)(rb + t) * PW + OFF_POOL + c8); } } while (0)
    int ucur = unit_of(0);
    if (ucur >= 0) { MX_ISSUE_CONV(ucur); MX_ISSUE_POOL(ucur); }
    for (int it = 0; it < nrounds; ++it) {
        if (ucur < 0) break;
        const int unext = (it + 1 < nrounds) ? unit_of(it + 1) : -1;
        MX_GEOM(ucur)
#pragma unroll
        for (int q = 0; q < 4; ++q) { const int i = tid + q * 512, tt = i >> 5, c8 = (i & 31) * 8;
            if (i < 62 * 32) { const unsigned aw[4] = {ca[q].x, ca[q].y, ca[q].z, ca[q].w}, gw[4] = {cg[q].x, cg[q].y, cg[q].z, cg[q].w}; float v[8];
#pragma unroll
                for (int x = 0; x < 4; ++x) { v[2 * x] = bf2f(aw[x] & 0xffffu) * sigm(bf2f(gw[x] & 0xffffu)); v[2 * x + 1] = bf2f(aw[x] >> 16) * sigm(bf2f(gw[x] >> 16)); }
                *(LAS f32x4*)(U + tt * 256 + c8) = (f32x4){v[0], v[1], v[2], v[3]}; *(LAS f32x4*)(U + tt * 256 + c8 + 4) = (f32x4){v[4], v[5], v[6], v[7]}; } }
#pragma unroll
        for (int q = 0; q < 3; ++q) { const int i = tid + q * 512, tt = i >> 5, c8 = (i & 31) * 8;
            if (i < 47 * 32) { const unsigned aw[4] = {pp[q].x, pp[q].y, pp[q].z, pp[q].w};
                *(LAS f32x4*)(UP + tt * 256 + c8) = (f32x4){bf2f(aw[0] & 0xffffu), bf2f(aw[0] >> 16), bf2f(aw[1] & 0xffffu), bf2f(aw[1] >> 16)};
                *(LAS f32x4*)(UP + tt * 256 + c8 + 4) = (f32x4){bf2f(aw[2] & 0xffffu), bf2f(aw[2] >> 16), bf2f(aw[3] & 0xffffu), bf2f(aw[3] >> 16)}; } }
        __syncthreads();
        if (unext >= 0) { MX_ISSUE_CONV(unext); MX_ISSUE_POOL(unext); }
        if (!(var & 1u)) { float acc[16];
#pragma unroll
          for (int j = 0; j < 16; ++j) acc[j] = cb;
#pragma unroll
          for (int i = 0; i < 46; ++i) { const float uv = U[(hf * 16 + i) * 256 + c];
#pragma unroll
              for (int j = 0; j < 16; ++j) if (i - j >= 0 && i - j < CONVK) acc[j] += uv * dw[i - j]; }
#pragma unroll
          for (int j = 0; j < 16; ++j) Y[(hf * 16 + j) * 256 + c] = acc[j]; }
        if (!(var & 2u)) {
          bf16_t* mrow = MIXp + (size_t)r0 * DM + 512; const int pr = 8 * (F.wave >> 2) + (F.lane >> 3), ch = F.lane & 7;
          switch (F.wave & 3) { case 0: pool_pair<0>(UP, mrow, t0, n, pr, ch); break; case 1: pool_pair<1>(UP, mrow, t0, n, pr, ch); break; case 2: pool_pair<2>(UP, mrow, t0, n, pr, ch); break; default: pool_pair<3>(UP, mrow, t0, n, pr, ch); break; } }
        __syncthreads();
        if (!(var & 4u)) { const int tk = 4 * F.wave + (F.lane >> 4), c0 = 16 * (F.lane & 15); f32x4 v[4];
#pragma unroll
          for (int k = 0; k < 4; ++k) v[k] = *(const LAS f32x4*)(Y + tk * 256 + c0 + 4 * k);
          float s1 = 0.f;
#pragma unroll
          for (int k = 0; k < 4; ++k) s1 += (v[k].x + v[k].y) + (v[k].z + v[k].w);
          const float mean = sum16(s1) * (1.f / 256.f); float s2 = 0.f;
#pragma unroll
          for (int k = 0; k < 4; ++k) { v[k] = v[k] - mean; s2 += (v[k].x * v[k].x + v[k].y * v[k].y) + (v[k].z * v[k].z + v[k].w * v[k].w); }
          const float rstd = __builtin_amdgcn_rsqf(sum16(s2) * (1.f / 256.f) + EPS);
          const float* gp = F.a->in[I_CLNG] + l * 256 + c0; const float* bp = F.a->in[I_CLNB] + l * 256 + c0; unsigned o[8];
#pragma unroll
          for (int k = 0; k < 4; ++k) { const f32x4 gg = *(const f32x4*)(gp + 4 * k), bb = *(const f32x4*)(bp + 4 * k); const f32x4 y = v[k] * rstd * gg + bb; o[2 * k] = pk2(silu(y.x), silu(y.y)); o[2 * k + 1] = pk2(silu(y.z), silu(y.w)); }
          bf16_t* op = MIXp + (size_t)(r0 + tk) * DM + 768 + c0;
          *(u32x4*)op = (u32x4){o[0], o[1], o[2], o[3]}; *(u32x4*)(op + 8) = (u32x4){o[4], o[5], o[6], o[7]}; }
        ucur = unext;
    }
#undef MX_GEOM
#undef MX_ISSUE_CONV
#undef MX_ISSUE_POOL
    __syncthreads();
}

constexpr int HS_LD = 1028;
__device__ __forceinline__ void r1_phase(const Ctx& F0, int l, int nrows, bool dry = false) {
    const Ctx F = fresh(F0);
    LAS float* Hs = (LAS float*)F.lds;
    LAS float* Part = (LAS float*)(F.lds + 65792);
    LAS float* Sc = (LAS float*)(F.lds + 82176);
    LAS int* lcount = (LAS int*)(F.lds + 84224); LAS int* gbase = lcount + 32; LAS int* tok_e = gbase + 32; LAS int* tok_r = tok_e + 136 * 4; LAS float* tok_w = (LAS float*)(tok_r + 136 * 4);
    const int lane = F.lane, w = F.wave, e = lane & 31;
    float Wm[32][2];
    { const float* rw = F.a->in[I_RW] + (size_t)l * DM * NE + (size_t)(128 * w + 32 * (lane >> 4)) * NE + (lane & 15);
#pragma unroll
      for (int s_ = 0; s_ < 32; ++s_) { Wm[s_][0] = rw[s_ * NE]; Wm[s_][1] = rw[s_ * NE + 16]; } }
    if (F.tid < 32) lcount[F.tid] = 0;
    __syncthreads();
    const int per = nrows / F.G, rbase = F.bid * per, nchunks = (per + 15) >> 4;
    const float bias_e = F.a->in[I_RB][l * NE + e];
    f32x4 zr[2][4]; u32x2 zb[2][4]; unsigned yr[2][4];
    bf16_t* const Zp = (bf16_t*)(F.ws + WS_Z);
#define R1_ISSUE(cc) do { _Pragma("unroll") for (int q = 0; q < 2; ++q) { const int i = (cc) * 16 + w * 2 + q; \
        if (i < per) { const int r = rbase + i; \
            const unsigned char* yin = ((const unsigned char*)(F.ws + WS_Y1)) + (size_t)r * DM; \
            if (l == 0) { const float* zin = r < TL ? F.a->in[I_X] + (size_t)r * DM : F.a->in[I_CTX] + (size_t)(r - TL) * DM; \
                _Pragma("unroll") for (int j = 0; j < 4; ++j) zr[q][j] = *(const f32x4*)(zin + 4 * lane + 256 * j); } \
            else { const bf16_t* zin = Zp + (size_t)r * DM; \
                _Pragma("unroll") for (int j = 0; j < 4; ++j) zb[q][j] = *(const u32x2*)(zin + 4 * lane + 256 * j); } \
            _Pragma("unroll") for (int j = 0; j < 4; ++j) yr[q][j] = *(const unsigned*)(yin + 4 * lane + 256 * j); } } } while (0)
    R1_ISSUE(0);
    for (int c = 0; c < nchunks; ++c) {
#pragma unroll
        for (int q = 0; q < 2; ++q) { const int i = c * 16 + w * 2 + q;
            if (i < per && !(dry && (DRYVAR & 4u))) { const int r = rbase + i;
                const float* md = ((float*)(F.ws + WS_MISC + M_MOD)) + ((size_t)l * 5 + batch_of(r)) * 6144;
                f32x4 z[4];
#pragma unroll
                for (int j = 0; j < 4; ++j) { const f32x2 ylo = __builtin_amdgcn_cvt_pk_f32_fp8((int)yr[q][j], false), yhi = __builtin_amdgcn_cvt_pk_f32_fp8((int)yr[q][j], true); const f32x4 y = (f32x4){ylo.x, ylo.y, yhi.x, yhi.y} * YB_INV;
                    const u32x2 zo = zb[q][j]; const f32x4 zv = (l == 0) ? zr[q][j] : (f32x4){bf2f(zo.x & 0xffffu), bf2f(zo.x >> 16), bf2f(zo.y & 0xffffu), bf2f(zo.y >> 16)};
                    const f32x4 g = *(const f32x4*)(md + 2048 + 4 * lane + 256 * j); z[j] = zv * ALPHA + g * y; }
                row_ln(z); row_affine(z, F.a->in[I_LN1G] + l * DM, F.a->in[I_LN1B] + l * DM, lane); if (!dry) row_store_bf(z, Zp + (size_t)r * DM, lane);
                row_ln(z); row_mod(z, md + 3072, md + 4096, lane); if (!dry) row_store_bf(z, ((bf16_t*)(F.ws + WS_H)) + (size_t)r * DM, lane);
#pragma unroll
                for (int j = 0; j < 4; ++j) *(LAS f32x4*)(Hs + (w * 2 + q) * HS_LD + 4 * lane + 256 * j) = z[j]; } }
        __syncthreads();
        if (c + 1 < nchunks) R1_ISSUE(c + 1);
        if (!(dry && (DRYVAR & 1u))) { f32x4 acc0 = {0.f, 0.f, 0.f, 0.f}, acc1 = {0.f, 0.f, 0.f, 0.f};
          const LAS float* hp = Hs + (lane & 15) * HS_LD + 128 * w + 32 * (lane >> 4);
#pragma unroll
          for (int s4 = 0; s4 < 8; ++s4) { const f32x4 hv = *(const LAS f32x4*)(hp + 4 * s4);
#pragma unroll
              for (int x = 0; x < 4; ++x) { acc0 = __builtin_amdgcn_mfma_f32_16x16x4f32(hv[x], Wm[4 * s4 + x][0], acc0, 0, 0, 0); acc1 = __builtin_amdgcn_mfma_f32_16x16x4f32(hv[x], Wm[4 * s4 + x][1], acc1, 0, 0, 0); } }
#pragma unroll
          for (int j = 0; j < 4; ++j) { const int row = 4 * (lane >> 4) + j; Part[(w * 16 + row) * 32 + (lane & 15)] = acc0[j]; Part[(w * 16 + row) * 32 + 16 + (lane & 15)] = acc1[j]; } }
        __syncthreads();
        { const int r16 = F.tid >> 5; float lg = 0.f;
#pragma unroll
          for (int w2 = 0; w2 < 8; ++w2) lg += Part[(w2 * 16 + r16) * 32 + e];
          Sc[r16 * 32 + e] = sigm_exact(lg); }
        __syncthreads();
        if (!(dry && (DRYVAR & 2u))) { const int r16 = 2 * w + (lane >> 5), i = c * 16 + r16;
            const float sc = Sc[r16 * 32 + e], sel = sc + bias_e;
            const float m1 = max8(sel), m2 = max8(sel == m1 ? -INFINITY : sel), gs = m1 + m2;
            const float gA = dpp_f<DPP_RM>(gs);
            float t0, t1; t0 = swap16_f(gs, t1); const float gB = (lane & 16) ? t0 : t1; t0 = swap16_f(gA, t1); const float gC = (lane & 16) ? t0 : t1;
            const int g = e >> 3;
            const int rank = ((gA > gs || (gA == gs && (g ^ 1) < g)) ? 1 : 0) + ((gB > gs || (gB == gs && (g ^ 2) < g)) ? 1 : 0) + ((gC > gs || (gC == gs && (g ^ 3) < g)) ? 1 : 0);
            float cand = rank < 2 ? sel : -INFINITY;
            int ei[4]; float wv[4]; float wsum = 0.f;
#pragma unroll
            for (int k = 0; k < 4; ++k) { const float mx = max32(cand);
                const unsigned long long bal = __ballot(cand == mx); const unsigned hb = (lane & 32) ? (unsigned)(bal >> 32) : (unsigned)bal;
                const int widx = __ffs((int)hb) - 1; const bool win = (e == widx);
                const float wk = sum32(win ? sc : 0.f); cand = win ? -INFINITY : cand; ei[k] = widx; wv[k] = wk; wsum += wk; }
            if (e == 0 && i < per) {
#pragma unroll
                for (int k = 0; k < 4; ++k) { const int lr = __hip_atomic_fetch_add(lcount + ei[k], 1, __ATOMIC_RELAXED, __HIP_MEMORY_SCOPE_WORKGROUP); tok_e[i * 4 + k] = ei[k]; tok_r[i * 4 + k] = lr; tok_w[i * 4 + k] = wv[k] / wsum * ROUTED_SCALE; } }
        }
    }
#undef R1_ISSUE
    __syncthreads();
    if (dry) return;
    if (F.tid < 32) gbase[F.tid] = (int)atomicAdd(((unsigned*)(F.ws + WS_CTL)) + CW_GCNT + l * 64 + F.tid, (unsigned)lcount[F.tid]);
    __syncthreads();
    for (int i = F.tid; i < per * 4; i += NTHR) { const int ex = tok_e[i], rank = gbase[ex] + tok_r[i], r = rbase + (i >> 2);
        ((int*)(F.ws + WS_MISC + M_LIST))[(size_t)ex * TT + rank] = r; ((float*)(F.ws + WS_MISC + M_LISTW))[(size_t)ex * TT + rank] = tok_w[i]; ((int*)(F.ws + WS_MISC + M_SELE))[(size_t)r * 4 + (i & 3)] = ex; ((int*)(F.ws + WS_MISC + M_SELR))[(size_t)r * 4 + (i & 3)] = rank; }
    __syncthreads();
}

struct R2Raw { u32x2 z[4]; unsigned y[5][4]; };
__device__ __forceinline__ void r2_issue(R2Raw& w, const Ctx& F, const LAS int* tl, int r, int lane) {
    const bf16_t* zrow = ((const bf16_t*)(F.ws + WS_Z)) + (size_t)r * DM;
    const u32x4 ev = *(const u32x4*)(((int*)(F.ws + WS_MISC + M_SELE)) + (size_t)r * 4), rv = *(const u32x4*)(((int*)(F.ws + WS_MISC + M_SELR)) + (size_t)r * 4);
    const unsigned char* p0 = ((const unsigned char*)(F.ws + WS_YS8)) + (size_t)r * DM;
    const unsigned char* YB = (const unsigned char*)(F.ws + WS_YB);
    const unsigned char* p1 = YB + (size_t)(tl[ev.x] * 256 + (int)rv.x) * DM; const unsigned char* p2 = YB + (size_t)(tl[ev.y] * 256 + (int)rv.y) * DM;
    const unsigned char* p3 = YB + (size_t)(tl[ev.z] * 256 + (int)rv.z) * DM; const unsigned char* p4 = YB + (size_t)(tl[ev.w] * 256 + (int)rv.w) * DM;
#pragma unroll
    for (int j = 0; j < 4; ++j) { const int o = 4 * lane + 256 * j; w.z[j] = *(const u32x2*)(zrow + o); w.y[4][j] = *(const unsigned*)(p0 + o); w.y[0][j] = *(const unsigned*)(p1 + o); w.y[1][j] = *(const unsigned*)(p2 + o); w.y[2][j] = *(const unsigned*)(p3 + o); w.y[3][j] = *(const unsigned*)(p4 + o); }
}
__device__ __forceinline__ void r2_finish(const R2Raw& w, const Ctx& F, int l, int r, int lane, bool dry) {
    const bool last = (l == DEPTH - 1);
    const float* md = ((float*)(F.ws + WS_MISC + M_MOD)) + ((size_t)l * 5 + batch_of(r)) * 6144;
    f32x4 z[4];
#pragma unroll
    for (int j = 0; j < 4; ++j) { f32x4 yr = {0.f, 0.f, 0.f, 0.f};
#pragma unroll
        for (int q = 0; q < 5; ++q) { const f32x2 lo = __builtin_amdgcn_cvt_pk_f32_fp8((int)w.y[q][j], false), hi = __builtin_amdgcn_cvt_pk_f32_fp8((int)w.y[q][j], true); yr = yr + (f32x4){lo.x, lo.y, hi.x, hi.y}; }
        const f32x4 y = yr * YB_INV;
        const u32x2 zo = w.z[j]; const f32x4 zv = {bf2f(zo.x & 0xffffu), bf2f(zo.x >> 16), bf2f(zo.y & 0xffffu), bf2f(zo.y >> 16)};
        const f32x4 g = *(const f32x4*)(md + 5120 + 4 * lane + 256 * j); z[j] = zv * ALPHA + g * y; }
    row_ln(z); row_affine(z, F.a->in[I_LN2G] + l * DM, F.a->in[I_LN2B] + l * DM, lane);
    if (!dry) { if (last) row_store(z, F.out + (size_t)r * DM, lane); else row_store_bf(z, ((bf16_t*)(F.ws + WS_Z)) + (size_t)r * DM, lane); }
    if (!last) { const float* md2 = ((float*)(F.ws + WS_MISC + M_MOD)) + ((size_t)(l + 1) * 5 + batch_of(r)) * 6144; row_ln(z); row_mod(z, md2, md2 + 1024, lane); if (!dry) row_store_bf(z, ((bf16_t*)(F.ws + WS_H)) + (size_t)r * DM, lane); }
}
__device__ __forceinline__ void r2_phase(const Ctx& F0, int l, int nrows, bool dry = false) {
    const Ctx F = fresh(F0);
    expert_tables(F, l, nrows);
    const LAS int* tl = (const LAS int*)(F.lds + LDS_ET);
    const int gw = F.bid * NWAVES + F.wave, NGW = F.G * NWAVES, lane = F.lane;
    for (int r = gw; r < nrows; r += 2 * NGW) {
        const int r2 = r + NGW; const bool two = r2 < nrows;
        R2Raw a, b; r2_issue(a, F, tl, r, lane); r2_issue(b, F, tl, two ? r2 : r, lane);
        r2_finish(a, F, l, r, lane, dry); if (two) r2_finish(b, F, l, r2, lane, dry);
    }
}

constexpr int PH_PER_LAYER = 8, N_PHASES = 2 + DEPTH * PH_PER_LAYER;
__global__ void __launch_bounds__(NTHR, 2) fwd(Args args) {
    extern __shared__ __attribute__((aligned(16))) unsigned char lds_raw[];
    Ctx F;
    F.lds = (LAS unsigned char*)lds_raw; F.tid = threadIdx.x; F.lane = F.tid & 63; F.wave = __builtin_amdgcn_readfirstlane(F.tid >> 6); F.G = gridDim.x; F.bid = blockIdx.x;
    F.a = &args; F.out = args.out; F.ws = args.ws;
    if (F.tid < 16) ((LAS unsigned*)(F.lds + LDS_XB))[F.tid] = 0u;
    __syncthreads();
    XcdBarrier bar; bar.bar = ((unsigned*)(F.ws + WS_CTL)) + CW_BAR; bar.x = 0; bar.st = nullptr;
    if (N_PHASE_LAUNCH == 0) bar = xcd_barrier_post(((unsigned*)(F.ws + WS_CTL)) + CW_BAR, (volatile LAS unsigned*)(F.lds + LDS_XB));
    const int lo = args.ph_lo, hi = args.ph_hi;
#ifndef PH_MASK
#define PH_MASK 0xFFFFFFFFu
#endif
#define IN(k) (lo <= (k) && (k) < hi)
#define EN(b) ((PH_MASK >> (b)) & 1u)
#ifndef DUP_MASK
#define DUP_MASK 0u
#endif
#ifndef DRYVAR
#define DRYVAR 0u
#endif
#define REP(b) for (int _rep = 0; _rep < 1 + (int)((DUP_MASK >> (b)) & 1u); ++_rep)
#define SEAM(k) do { if (IN(k) && IN((k) + 1)) { XcdBarrier b2 = bar; b2.bar = launder_uniform(bar.bar); xcd_barrier(b2); } } while (0)
    if (EN(0) && IN(0)) REP(0) { prep_layer(F, 0); __syncthreads(); mods_phase(F); __syncthreads(); }
    SEAM(0);
    if (EN(1) && IN(1)) REP(1) r0_phase(F);
    SEAM(1);
    for (int l = 0; l < DEPTH; ++l) {
        const int p0 = 2 + l * PH_PER_LAYER; const bool last = (l == DEPTH - 1); const int nrows = last ? TL : TT;
        if (EN(2) && IN(p0 + 0)) REP(2) g1_phase(F);
        SEAM(p0 + 0);
        if (EN(4) && IN(p0 + 1)) REP(4) g23_phase(F);
        SEAM(p0 + 1);
        if (IN(p0 + 2)) { if (EN(5)) { if ((DUP_MASK >> 5) & 1u) mixers_phase(F, l, nrows, DRYVAR); mixers_phase(F, l, nrows); } if (EN(6)) { if ((DUP_MASK >> 6) & 1u) attn_mfma_phase<DRYVAR>(F, !last); attn_mfma_phase<0u>(F, !last); } }
        SEAM(p0 + 2);
        if (EN(7) && IN(p0 + 3)) REP(7) g4_phase(F, nrows);
        SEAM(p0 + 3);
        if (EN(8) && IN(p0 + 4)) { if ((DUP_MASK >> 8) & 1u) { r1_phase(F, l, nrows, args.ph_hi > 0); __syncthreads(); } r1_phase(F, l, nrows); }
        SEAM(p0 + 4);
        if (EN(9) && IN(p0 + 5)) REP(9) g5_phase(F, l, nrows);
        SEAM(p0 + 5);
        if (EN(10) && IN(p0 + 6)) REP(10) g6_phase(F, l, nrows);
        SEAM(p0 + 6);
        if (EN(11) && IN(p0 + 7)) { if ((DUP_MASK >> 11) & 1u) { r2_phase(F, l, nrows, args.ph_hi > 0); __syncthreads(); } r2_phase(F, l, nrows); if (!last) { if ((DUP_MASK >> 12) & 1u) { __syncthreads(); prep_layer(F, l + 1, DRYVAR); } __syncthreads(); prep_layer(F, l + 1); } }
        SEAM(p0 + 7);
    }
#undef IN
#undef SEAM
}

extern "C" void kernel_launch(void* const* d_in, const int* in_sizes, int n_in, void* d_out, int out_size, void* d_ws, size_t ws_size, hipStream_t stream) {
    static int grid = 0;
    if (grid == 0) {
        if (n_in != 31 || out_size != TL * DM || ws_size < WS_END) { fprintf(stderr, "kernel_launch: unexpected shapes (n_in %d out %d ws %zu)\n", n_in, out_size, ws_size); grid = -1; return; }
        int dev = 0, cus = 0, per_cu = 0;
        if (hipGetDevice(&dev) != hipSuccess || hipDeviceGetAttribute(&cus, hipDeviceAttributeMultiprocessorCount, dev) != hipSuccess) { grid = -1; return; }
        if (hipFuncSetAttribute((const void*)fwd, hipFuncAttributeMaxDynamicSharedMemorySize, LDS_BYTES) != hipSuccess) { fprintf(stderr, "kernel_launch: hipFuncSetAttribute failed\n"); grid = -1; return; }
        if (hipOccupancyMaxActiveBlocksPerMultiprocessor(&per_cu, (const void*)fwd, NTHR, LDS_BYTES) != hipSuccess || per_cu < 1) fprintf(stderr, "kernel_launch: occupancy query reports %d\n", per_cu);
        (void)hipGetLastError();
        grid = cus;
    }
    if (grid < 0) return;
    (void)hipMemsetAsync((char*)d_ws + WS_CTL, 0, CTL_ZERO_BYTES, stream);
    Args a{};
    for (int i = 0; i < 31; ++i) a.in[i] = (const float*)d_in[i];
    a.out = (float*)d_out; a.ws = (unsigned char*)d_ws;
    if (N_PHASE_LAUNCH == 0) { a.ph_lo = 0; a.ph_hi = N_PHASES; hipLaunchKernelGGL(fwd, dim3(grid), dim3(NTHR), LDS_BYTES, stream, a); }
    else for (int p = 0; p < N_PHASES; ++p) { a.ph_lo = p; a.ph_hi = p + 1; hipLaunchKernelGGL(fwd, dim3(grid), dim3(NTHR), LDS_BYTES, stream, a); }
}
```

```cpp
#include <hip/hip_runtime.h>
#include <cstdio>
#include <cstdint>

#define LAS __attribute__((address_space(3)))
#define GAS __attribute__((address_space(1)))
typedef unsigned short bf16_t;
typedef short bf16x8 __attribute__((ext_vector_type(8)));
typedef float f32x4 __attribute__((ext_vector_type(4)));
typedef float f32x2 __attribute__((ext_vector_type(2)));
typedef unsigned u32x4 __attribute__((ext_vector_type(4)));
typedef unsigned u32x2 __attribute__((ext_vector_type(2)));

#ifndef DRYVAR
#define DRYVAR 0u
#endif
#ifndef N_PHASE_LAUNCH
#define N_PHASE_LAUNCH 0
#endif

constexpr int DM = 1024, NBATCH = 4, SEQ = 8192, CTXL = 256, DEPTH = 2;
constexpr int TL = NBATCH * SEQ, TC = NBATCH * CTXL, TT = TL + TC;
constexpr int KVS = SEQ + CTXL;
constexpr int NH = 8, QK_NOPE = 64, QK_ROPE = 32, VD = 64, QLORA = 256, KVLORA = 128;
constexpr int INC = 1184, PW = 1280;
constexpr int OFF_KV = 256, OFF_KR = 384, OFF_POOL = 416, OFF_CONV = 672;
constexpr int NE = 32, DEXP = 256, CONVK = 31;
constexpr float ALPHA = 1.4142135623730951f, EPS = 1e-6f, ROUTED_SCALE = 2.5f;
constexpr float ATTN_SCALE = 0.10206207261596575f;
constexpr int NWAVES = 8, NTHR = 512;

constexpr size_t MiB = 1u << 20;
constexpr size_t WS_CTL = 0, CTL_ZERO_BYTES = 1 * MiB;
constexpr int CW_BAR = 4096;
constexpr int CW_GCNT = 16384;
constexpr int CW_RDY1 = 57344, GDONE_IN_RDY1 = 255 * 16 + 8;
constexpr int CW_RDY = 32768, GDONE_IN_RDY = 767 * 16 + 8;
constexpr size_t WS_W = 1 * MiB;
constexpr size_t W_WIN = 0, W_WQ = W_WIN + (size_t)PW * DM * 2, W_WKV = W_WQ + (size_t)768 * 256 * 2, W_WO = W_WKV + (size_t)1024 * 256 * 2,
                 W_WGU = W_WO + (size_t)DM * DM * 2, W_WD = W_WGU + (size_t)33 * 512 * DM * 2, W_END = W_WD + (size_t)33 * DM * 256 * 2;
static_assert(W_END <= 56 * MiB, "weights region");
constexpr size_t WS_MISC = 61 * MiB;
constexpr size_t M_MOD = 0, M_ROPE = M_MOD + (size_t)DEPTH * 5 * 6144 * 4, M_RS = M_ROPE + 128 * 8 * 2 * 4, M_SELE = M_RS + (size_t)TT * 32,
                 M_SELR = M_SELE + (size_t)TT * 16, M_LIST = M_SELR + (size_t)TT * 16, M_LISTW = M_LIST + (size_t)NE * TT * 4, M_END = M_LISTW + (size_t)NE * TT * 4;
static_assert(M_END <= 12 * MiB, "misc region");
constexpr size_t WS_H = 73 * MiB;
constexpr size_t WS_X = 139 * MiB;
constexpr size_t WS_P = WS_X, WS_Q = 222 * MiB, WS_QR = 272 * MiB, WS_KV = 289 * MiB, WS_KR = 355 * MiB, WS_MIX = 358 * MiB, WS_Y1 = WS_X  ;
constexpr size_t WS_YS8 = 366 * MiB;
constexpr size_t WS_Z = 424 * MiB;
constexpr size_t WS_HB = WS_X, WS_YB = 226 * MiB, WS_END = 512 * MiB;
static_assert(WS_P + (size_t)TT * PW * 2 <= WS_Q && WS_Q + (size_t)TT * 768 * 2 <= WS_QR && WS_QR + (size_t)TT * 256 * 2 <= WS_KV && WS_KV + (size_t)TT * 2048 <= WS_KR &&
              WS_KR + (size_t)TT * 64 <= WS_MIX && WS_MIX + (size_t)TT * 2048 <= WS_Z && WS_Y1 + (size_t)TT * 2048 <= WS_Q && WS_Z + (size_t)TT * 2048 <= WS_END, "attention-time map");
static_assert(WS_HB + (size_t)(4 * TT + 32 * 255 + TT) * 512 <= WS_YB && WS_YB + (size_t)(4 * TT + 32 * 255) * 1024 <= WS_YS8 && WS_YS8 + (size_t)TT * 1024 <= WS_Z, "moe-time map");
constexpr int LDS_BYTES = 163840;
constexpr int LDS_XB = LDS_BYTES - 64;
constexpr int LDS_ET = 139264, LDS_FLAG = 159232;

__device__ __forceinline__ float bf2f(unsigned b) { return __uint_as_float(b << 16); }
__device__ __forceinline__ unsigned f2bf(float f) { unsigned u = __float_as_uint(f); return (u + 0x7fffu + ((u >> 16) & 1u)) >> 16; }
__device__ __forceinline__ unsigned pk2(float lo, float hi) { unsigned r; asm("v_cvt_pk_bf16_f32 %0, %1, %2" : "=v"(r) : "v"(lo), "v"(hi)); return r; }
template <int CTRL> __device__ __forceinline__ float dpp_f(float v) { return __builtin_bit_cast(float, __builtin_amdgcn_update_dpp(0, __builtin_bit_cast(int, v), CTRL, 0xF, 0xF, false)); }
#define DPP_X1 0xB1
#define DPP_X2 0x4E
#define DPP_HM 0x141
#define DPP_RM 0x140
__device__ __forceinline__ float swap16_f(float v, float& other) { auto r = __builtin_amdgcn_permlane16_swap(__float_as_uint(v), __float_as_uint(v), false, false); other = __uint_as_float(r[1]); return __uint_as_float(r[0]); }
__device__ __forceinline__ float sum16(float v) { v += dpp_f<DPP_X1>(v); v += dpp_f<DPP_X2>(v); v += dpp_f<DPP_HM>(v); v += dpp_f<DPP_RM>(v); return v; }
__device__ __forceinline__ float sum32(float v) { v = sum16(v); float o; const float a = swap16_f(v, o); return a + o; }
__device__ __forceinline__ float wave_sum(float v) {
    v = sum32(v);
    auto r = __builtin_amdgcn_permlane32_swap(__float_as_uint(v), __float_as_uint(v), false, false);
    return __uint_as_float(r[0]) + __uint_as_float(r[1]);
}
__device__ __forceinline__ float max8(float v) { v = fmaxf(v, dpp_f<DPP_X1>(v)); v = fmaxf(v, dpp_f<DPP_X2>(v)); v = fmaxf(v, dpp_f<DPP_HM>(v)); return v; }
__device__ __forceinline__ float max32(float v) { v = max8(v); v = fmaxf(v, dpp_f<DPP_RM>(v)); float o; const float a = swap16_f(v, o); return fmaxf(a, o); }
__device__ __forceinline__ float sigm_exact(float x) { return 1.f / (1.f + __expf(-x)); }
__device__ __forceinline__ float sigm(float x) { return __builtin_amdgcn_rcpf(1.f + __expf(-x)); }
__device__ __forceinline__ float silu(float x) { return x * __builtin_amdgcn_rcpf(1.f + __expf(-x)); }
__device__ __forceinline__ int kvrow_of(int r) { return r < TL ? (r >> 13) * KVS + CTXL + (r & (SEQ - 1)) : ((r - TL) >> 8) * KVS + ((r - TL) & (CTXL - 1)); }
__device__ __forceinline__ int batch_of(int r) { return r < TL ? (r >> 13) : 4; }
#define LDS_WAIT() asm volatile("s_waitcnt lgkmcnt(0)" ::: "memory")
#define VM_WAIT() asm volatile("s_waitcnt vmcnt(0)" ::: "memory")

#define XB_TMO      128
#define XB_XCNT(j)  (256  + 64 * (j))
#define XB_XSUB(j)  (1280 + 64 * (j))
#define XB_XGEN(j)  (2304 + 64 * (j))
#define XB_TOP      3328
#define XB_TOPGEN   3392
#define XCD_BAR_WORDS 3456
#define XB_SPIN_CAP (1u << 22)
__device__ __forceinline__ unsigned xb_ld(unsigned* p)              { return __hip_atomic_load(p, __ATOMIC_RELAXED, __HIP_MEMORY_SCOPE_AGENT); }
__device__ __forceinline__ unsigned xb_add(unsigned* p, unsigned v) { return __hip_atomic_fetch_add(p, v, __ATOMIC_RELAXED, __HIP_MEMORY_SCOPE_AGENT); }
__device__ __forceinline__ unsigned xb_xcc_id() { return (unsigned)__builtin_amdgcn_s_getreg((3 << 11) | 20) & 0xFu; }
#define XB_SPIN(cond, bar) do { unsigned _sp = 0; while (cond) { __builtin_amdgcn_s_sleep(1); \
    if ((++_sp & 255u) == 0u) { if (xb_ld(&(bar)[XB_TMO])) break; if (_sp > XB_SPIN_CAP) { atomicAdd(&(bar)[XB_TMO], 1u); break; } } } } while (0)
struct XcdBarrier { unsigned* bar; unsigned x; volatile LAS unsigned* st; };
__device__ __forceinline__ XcdBarrier xcd_barrier_post(unsigned* bar, volatile LAS unsigned* st) {
    XcdBarrier b; b.bar = bar; b.x = xb_xcc_id(); b.st = st;
    if (threadIdx.x == 0) (void)xb_add(&bar[XB_XCNT(b.x)], 1u);
    return b;
}
__device__ __forceinline__ void xcd_barrier_complete(unsigned* bar, unsigned x, unsigned& nloc, unsigned& nx) {
    const unsigned G = gridDim.x * gridDim.y * gridDim.z;
    unsigned sum, cnt, mine, sp = 0u;
    for (;;) {
        sum = 0u; cnt = 0u; mine = 0u;
#pragma unroll
        for (unsigned j = 0; j < 16; ++j) { const unsigned c = xb_ld(&bar[XB_XCNT(j)]); sum += c; cnt += (c > 0u) ? 1u : 0u; mine = (j == x) ? c : mine; }
        if (sum == G) break;
        __builtin_amdgcn_s_sleep(1);
        if ((++sp & 255u) == 0u) { if (xb_ld(&bar[XB_TMO])) break; if (sp > XB_SPIN_CAP) { atomicAdd(&bar[XB_TMO], 1u); break; } }
    }
    nloc = mine > 0u ? mine : 1u; nx = cnt > 0u ? cnt : 1u;
}
__device__ __forceinline__ void xcd_barrier(const XcdBarrier& b, int wave) {
    asm volatile("s_waitcnt vmcnt(0)" ::: "memory");
    __syncthreads();
    unsigned zl; asm volatile("v_mov_b32 %0, 0" : "=v"(zl));
    if (wave == 0 && __builtin_amdgcn_mbcnt_hi(~0u, __builtin_amdgcn_mbcnt_lo(~0u, zl)) == 0u) {
        unsigned* bar = b.bar;
        __builtin_amdgcn_s_waitcnt(0);
        unsigned nloc = b.st[0], nx = b.st[1];
        if (nloc == 0u) { xcd_barrier_complete(bar, b.x, nloc, nx); b.st[0] = nloc; b.st[1] = nx; }
        const unsigned old = xb_add(&bar[XB_XSUB(b.x)], 1u);
        const unsigned gen = old / nloc;
        if (old + 1u == (gen + 1u) * nloc) {
            __builtin_amdgcn_fence(__ATOMIC_RELEASE, "agent");
            asm volatile("s_waitcnt vmcnt(0)" ::: "memory");
            const unsigned og = xb_add(&bar[XB_TOP], 1u);
            const unsigned tg = og / nx;
            if (og + 1u == (tg + 1u) * nx) xb_add(&bar[XB_TOPGEN], 1u);
            else XB_SPIN(xb_ld(&bar[XB_TOPGEN]) == tg, bar);
            __builtin_amdgcn_fence(__ATOMIC_ACQUIRE, "agent");
            xb_add(&bar[XB_XGEN(b.x)], 1u);
            asm volatile("s_waitcnt vmcnt(0)" ::: "memory");
        } else {
            XB_SPIN(xb_ld(&bar[XB_XGEN(b.x)]) == gen, bar);
            __builtin_amdgcn_fence(__ATOMIC_ACQUIRE, "agent");
            asm volatile("s_waitcnt vmcnt(0)" ::: "memory");
        }
    }
    __syncthreads();
}

__device__ unsigned g_rdy[DEPTH][768 * 16];
__device__ unsigned g_rdy1[DEPTH][256 * 16];
__device__ unsigned g_rdy4[DEPTH][256 * 16];
struct Args { const float* in[31]; float* out; unsigned char* ws; int ph_lo, ph_hi; };
struct Ctx {
    LAS unsigned char* lds; int tid, lane, wave, G, bid;
    const Args* a; float* out; unsigned char* ws;
};
template <class T> __device__ __forceinline__ T* launder_uniform(T* p) {
    unsigned lo, hi;
    asm volatile("v_mov_b32 %0, %2\n\tv_mov_b32 %1, %3" : "=&v"(lo), "=&v"(hi) : "s"((unsigned)(uintptr_t)p), "s"((unsigned)((uintptr_t)p >> 32)));
    lo = __builtin_amdgcn_readfirstlane(lo); hi = __builtin_amdgcn_readfirstlane(hi);
    return (T*)(GAS T*)(((uintptr_t)hi << 32) | (uintptr_t)lo);
}
__device__ __forceinline__ const float* gin(const float* p) { return (const float*)(const GAS float*)p; }
__device__ __forceinline__ Ctx fresh(const Ctx& F0) {
    Ctx F = F0; int bid, G, wv;
    unsigned zl; asm volatile("v_mov_b32 %0, 0" : "=v"(zl));
    int lane = (int)__builtin_amdgcn_mbcnt_hi(~0u, __builtin_amdgcn_mbcnt_lo(~0u, zl));
    asm volatile("" : "+v"(lane));
    asm volatile("v_mov_b32 %0, %1" : "=v"(bid) : "s"(F0.bid)); asm volatile("v_mov_b32 %0, %1" : "=v"(G) : "s"(F0.G)); asm volatile("v_mov_b32 %0, %1" : "=v"(wv) : "s"(F0.wave));
    bid = __builtin_amdgcn_readfirstlane(bid); G = __builtin_amdgcn_readfirstlane(G); wv = __builtin_amdgcn_readfirstlane(wv);
    F.tid = wv * 64 + lane; F.lane = lane; F.wave = wv; F.bid = bid; F.G = G; F.ws = launder_uniform(F0.ws); F.out = launder_uniform(F0.out); F.a = F0.a;
    { unsigned l = (unsigned)(uintptr_t)F0.lds; asm volatile("" : "+v"(l)); F.lds = (LAS unsigned char*)(uintptr_t)__builtin_amdgcn_readfirstlane(l); }
    return F;
}
enum { I_X = 0, I_C, I_CTX, I_CCTX, I_ADAW, I_ADAB, I_WIN, I_QG, I_WUQ, I_KVG, I_WUKV, I_POOLW, I_POOLS, I_CDW, I_CB, I_CLNG, I_CLNB, I_CPW, I_WOUT,
       I_LN1G, I_LN1B, I_RW, I_RB, I_EWG, I_EWU, I_EWD, I_SWG, I_SWU, I_SWD, I_LN2G, I_LN2B };

constexpr float YB_SCALE = 16.f, YB_INV = 1.f / 16.f;
__device__ __forceinline__ int permd(int c) { return (c & ~255) + 128 * ((c >> 3) & 1) + 32 * ((c >> 6) & 3) + 8 * ((c >> 4) & 3) + (c & 7); }
__device__ __forceinline__ void xpose_item(const float* W, int N, const float* gain, bf16_t* WT, int ldk, int koff, int rmul, int radd, LAS float* scr, int kb, int nb, int lane, bool pd = false, float cmul = 1.f) {
    const int k0 = 64 * kb, n0 = 32 * nb;
    float v[32]; const float* wp = W + (size_t)(k0 + (lane >> 5)) * N + n0 + (lane & 31);
#pragma unroll
    for (int i = 0; i < 32; ++i) v[i] = wp[(size_t)(2 * i) * N];
    if (gain) {
#pragma unroll
        for (int i = 0; i < 32; ++i) v[i] *= gain[k0 + 2 * i + (lane >> 5)]; }
#pragma unroll
    for (int i = 0; i < 32; ++i) scr[(2 * i + (lane >> 5)) * 33 + (lane & 31)] = v[i] * cmul;
    LDS_WAIT(); asm volatile("" ::: "memory");
    const int c = lane & 7;
#pragma unroll
    for (int j = 0; j < 4; ++j) { const int n = (lane >> 3) + 8 * j; const LAS float* s = scr + (8 * c) * 33 + n;
        u32x4 o; o.x = pk2(s[0 * 33], s[1 * 33]); o.y = pk2(s[2 * 33], s[3 * 33]); o.z = pk2(s[4 * 33], s[5 * 33]); o.w = pk2(s[6 * 33], s[7 * 33]);
        const int drow = pd ? permd(n0 + n) : (n0 + n) * rmul + radd;
        *(u32x4*)(WT + (size_t)drow * ldk + koff + k0 + 8 * c) = o; }
    LDS_WAIT(); asm volatile("" ::: "memory");
}
__device__ __forceinline__ void prep_layer(const Ctx& F0, int l, unsigned var = 0u) {
    const Ctx F = fresh(F0);
    LAS float* scr = (LAS float*)(F.lds + F.wave * 16384);
    const int gw = F.bid * NWAVES + F.wave, NGW = F.G * NWAVES, lane = F.lane;
    const float* w_in = gin(F.a->in[I_WIN]) + (size_t)l * DM * INC; const float* w_uq = gin(F.a->in[I_WUQ]) + (size_t)l * 256 * 768; const float* w_ukv = gin(F.a->in[I_WUKV]) + (size_t)l * 128 * 1024;
    const float* w_out = gin(F.a->in[I_WOUT]) + (size_t)l * DM * DM;
    constexpr int I1 = 16 * 37, I2 = 4 * 24, I3 = 2 * 32, I4 = 8 * 32, I5 = 33 * 2 * 128, I6 = 33 * 128, I7 = 1024  , I8 = 96   + 128  ;
    constexpr int NIT = I1 + I2 + I3 + I4 + I5 + I6 + I7 + I8;
    for (int it = gw; it < NIT; it += NGW) {
        int r = it;
        if (r < I1) { xpose_item(w_in, INC, nullptr, ((bf16_t*)(F.ws + WS_W + W_WIN)), DM, 0, 1, 0, scr, r / 37, r % 37, lane); continue; } r -= I1;
        if (r < I2) { xpose_item(w_uq, 768, gin(F.a->in[I_QG]) + l * 256, ((bf16_t*)(F.ws + WS_W + W_WQ)), 256, 0, 1, 0, scr, r / 24, r % 24, lane); continue; } r -= I2;
        if (r < I3) { xpose_item(w_ukv, 1024, gin(F.a->in[I_KVG]) + l * 128, ((bf16_t*)(F.ws + WS_W + W_WKV)), 256, 0, 1, 0, scr, r / 32, r % 32, lane); continue; } r -= I3;
        if (r < I4) { xpose_item(w_out, DM, nullptr, ((bf16_t*)(F.ws + WS_W + W_WO)), DM, 0, 1, 0, scr, r / 32, r % 32, lane, true, YB_SCALE); continue; } r -= I4;
        if (r < I5) { if (var & 8u) continue; const int e = r / 256, q = r % 256, which = q / 128, i2 = q % 128;
            const float* src = e < 32 ? (which ? gin(F.a->in[I_EWU]) : gin(F.a->in[I_EWG])) + ((size_t)l * 32 + e) * DM * 256 : (which ? gin(F.a->in[I_SWU]) : gin(F.a->in[I_SWG])) + (size_t)l * DM * 256;
            xpose_item(src, 256, nullptr, ((bf16_t*)(F.ws + WS_W + W_WGU)) + (size_t)e * 512 * DM, DM, 0, 1, ((i2 % 8) / 4) * 128 + which * 128, scr, i2 / 8, i2 % 8, lane); continue; } r -= I5;
        if (r < I6) { if (var & 16u) continue; const int e = r / 128, i2 = r % 128;
            const float* src = e < 32 ? gin(F.a->in[I_EWD]) + ((size_t)l * 32 + e) * 256 * DM : gin(F.a->in[I_SWD]) + (size_t)l * 256 * DM;
            xpose_item(src, DM, nullptr, ((bf16_t*)(F.ws + WS_W + W_WD)) + (size_t)e * DM * 256, 256, 0, 1, 0, scr, i2 / 32, i2 % 32, lane, true, YB_SCALE); continue; } r -= I6;
        if (r < I7) { if (var & 32u) continue;
            const int kg = r / 16, n = (r % 16) * 64 + lane; float acc[8];
#pragma unroll
            for (int i = 0; i < 8; ++i) acc[i] = 0.f;
            if (kg < 32) { const int g = kg / 8, i0 = (kg % 8) * 8; const float* pw = gin(F.a->in[I_POOLW]) + ((size_t)l * 4 + g) * 4096; const float* ps = gin(F.a->in[I_POOLS]) + l * 256 + g * 64;
                for (int jb = 0; jb < 64; jb += 16) { float wv[16];
#pragma unroll
                    for (int j = 0; j < 16; ++j) wv[j] = w_out[(size_t)(512 + g * 64 + jb + j) * DM + n];
#pragma unroll
                    for (int j = 0; j < 16; ++j) { const float wj = wv[j] * ps[jb + j];
#pragma unroll
                        for (int i = 0; i < 8; ++i) acc[i] += pw[(i0 + i) * 64 + jb + j] * wj; } } }
            else { const int i0 = (kg - 32) * 8; const float* cp = gin(F.a->in[I_CPW]) + (size_t)l * 65536;
                for (int jb = 0; jb < 256; jb += 16) { float wv[16];
#pragma unroll
                    for (int j = 0; j < 16; ++j) wv[j] = w_out[(size_t)(768 + jb + j) * DM + n];
#pragma unroll
                    for (int j = 0; j < 16; ++j) {
#pragma unroll
                        for (int i = 0; i < 8; ++i) acc[i] += cp[(i0 + i) * 256 + jb + j] * wv[j]; } } }
#pragma unroll
            for (int i = 0; i < 8; ++i) acc[i] *= YB_SCALE;
            u32x4 o; o.x = pk2(acc[0], acc[1]); o.y = pk2(acc[2], acc[3]); o.z = pk2(acc[4], acc[5]); o.w = pk2(acc[6], acc[7]);
            *(u32x4*)(((bf16_t*)(F.ws + WS_W + W_WO)) + (size_t)permd(n) * DM + 512 + kg * 8) = o; continue; } r -= I7;
        { unsigned zz = 0u; asm volatile("" : "+v"(zz)); const u32x4 z = {zz, zz, zz, zz};
          if (r < 96) { u32x4* d = (u32x4*)(((bf16_t*)(F.ws + WS_W + W_WIN)) + (size_t)(INC + r) * DM); d[lane] = z; d[64 + lane] = z; }
          else { const int n = (r - 96) * 8 + (lane >> 3); u32x4* d = (u32x4*)(((bf16_t*)(F.ws + WS_W + W_WKV)) + (size_t)n * 256 + 128); d[lane & 7] = z; d[8 + (lane & 7)] = z; } }
    }
}

__device__ __forceinline__ void mods_phase(const Ctx& F0) {
    const Ctx F = fresh(F0);
    LAS float* sv = (LAS float*)F.lds;
    LAS float* part = sv + 5 * 1024;
    for (int i = F.tid; i < 5 * 1024; i += NTHR) { const int j = i >> 10, k = i & 1023; const float c = j < 4 ? gin(F.a->in[I_C])[j * DM + k] : gin(F.a->in[I_CCTX])[k]; sv[i] = silu(c); }
    __syncthreads();
    for (int it = F.bid; it < DEPTH * 96; it += F.G) {
        const int l = it / 96, n = (it % 96) * 64 + F.lane;
        float acc[5] = {0.f, 0.f, 0.f, 0.f, 0.f};
        const int kb = F.wave * 128;
        const float* rowb = gin(F.a->in[I_ADAW]) + (size_t)l * DM * 6144 + (size_t)kb * 6144 + (it % 96) * 64;
        const unsigned voff = (unsigned)F.lane * 4u;
#pragma unroll 1
        for (int kk = 0; kk < 128; kk += 32) { float a[32];
#pragma unroll
            for (int j = 0; j < 32; ++j) { const float* rp = rowb + (size_t)(kk + j) * 6144; asm volatile("global_load_dword %0, %1, %2" : "=&v"(a[j]) : "v"(voff), "s"(rp) : "memory"); }
            asm volatile("s_waitcnt vmcnt(0)" ::: "memory"); __builtin_amdgcn_sched_barrier(0);
#pragma unroll
            for (int j = 0; j < 32; j += 4)
#pragma unroll
                for (int q = 0; q < 5; ++q) { const f32x4 c4 = *(const LAS f32x4*)(sv + q * 1024 + kb + kk + j); acc[q] += (c4.x * a[j] + c4.y * a[j + 1]) + (c4.z * a[j + 2] + c4.w * a[j + 3]); } }
#pragma unroll
        for (int j = 0; j < 5; ++j) part[(F.wave * 5 + j) * 64 + F.lane] = acc[j];
        __syncthreads();
        if (F.wave < 5) { float s = gin(F.a->in[I_ADAB])[l * 6144 + n];
#pragma unroll
            for (int w = 0; w < 8; ++w) s += part[(w * 5 + F.wave) * 64 + F.lane];
            ((float*)(F.ws + WS_MISC + M_MOD))[((size_t)l * 5 + F.wave) * 6144 + n] = s; }
        __syncthreads();
    }
    if (F.bid == F.G - 1) {
        for (int i = F.tid; i < 1024; i += NTHR) { const int pos = i >> 3, j = i & 7;
            const double c1 = j == 0 ? 0.54030230586813977 : j == 1 ? 0.95041528025518285 : j == 2 ? 0.99500416527802582 : j == 3 ? 0.99950004166527784 : j == 4 ? 0.99995000041666526 : j == 5 ? 0.99999500000416663 : j == 6 ? 0.99999950000004167 : 0.99999995000000041;
            const double s1 = j == 0 ? 0.8414709848078965 : j == 1 ? 0.31098359290718575 : j == 2 ? 0.099833416646828155 : j == 3 ? 0.031617506402433708 : j == 4 ? 0.0099998333341666645 : j == 5 ? 0.0031622723897082477 : j == 6 ? 0.00099999983333334168 : 0.00031622776074637522;
            double c = 1.0, sn = 0.0;
            for (int q = 0; q < pos; ++q) { const double nc = c * c1 - sn * s1, ns = sn * c1 + c * s1; c = nc; sn = ns; }
            ((float*)(F.ws + WS_MISC + M_ROPE))[pos * 16 + j] = (float)c; ((float*)(F.ws + WS_MISC + M_ROPE))[pos * 16 + 8 + j] = (float)sn; }
    }
}

__device__ __forceinline__ void row_ln(f32x4 (&v)[4]) {
    float s = 0.f;
#pragma unroll
    for (int j = 0; j < 4; ++j) s += (v[j].x + v[j].y) + (v[j].z + v[j].w);
    const float mean = wave_sum(s) * (1.f / DM); float s2 = 0.f;
#pragma unroll
    for (int j = 0; j < 4; ++j) { v[j] = v[j] - mean; s2 += (v[j].x * v[j].x + v[j].y * v[j].y) + (v[j].z * v[j].z + v[j].w * v[j].w); }
    const float rstd = __builtin_amdgcn_rsqf(wave_sum(s2) * (1.f / DM) + EPS);
#pragma unroll
    for (int j = 0; j < 4; ++j) v[j] = v[j] * rstd;
}
__device__ __forceinline__ void row_load(f32x4 (&v)[4], const float* row, int lane) {
#pragma unroll
    for (int j = 0; j < 4; ++j) v[j] = *(const f32x4*)(row + 4 * lane + 256 * j);
}
__device__ __forceinline__ void row_store(const f32x4 (&v)[4], float* row, int lane) {
#pragma unroll
    for (int j = 0; j < 4; ++j) *(f32x4*)(row + 4 * lane + 256 * j) = v[j];
}
__device__ __forceinline__ void row_store_bf(const f32x4 (&v)[4], bf16_t* row, int lane) {
#pragma unroll
    for (int j = 0; j < 4; ++j) { u32x2 o; o.x = pk2(v[j].x, v[j].y); o.y = pk2(v[j].z, v[j].w); *(u32x2*)(row + 4 * lane + 256 * j) = o; }
}
__device__ __forceinline__ void row_load_bf(f32x4 (&v)[4], const bf16_t* row, int lane) {
#pragma unroll
    for (int j = 0; j < 4; ++j) { const u32x2 o = *(const u32x2*)(row + 4 * lane + 256 * j); v[j] = (f32x4){bf2f(o.x & 0xffffu), bf2f(o.x >> 16), bf2f(o.y & 0xffffu), bf2f(o.y >> 16)}; }
}
__device__ __forceinline__ void row_mod(f32x4 (&v)[4], const float* shift, const float* scale, int lane) {
#pragma unroll
    for (int j = 0; j < 4; ++j) { const f32x4 sc = *(const f32x4*)(scale + 4 * lane + 256 * j), sh = *(const f32x4*)(shift + 4 * lane + 256 * j); v[j] = v[j] * (sc + 1.f) + sh; }
}
__device__ __forceinline__ void row_affine(f32x4 (&v)[4], const float* g, const float* b, int lane) {
#pragma unroll
    for (int j = 0; j < 4; ++j) { const f32x4 gg = *(const f32x4*)(g + 4 * lane + 256 * j), bb = *(const f32x4*)(b + 4 * lane + 256 * j); v[j] = v[j] * gg + bb; }
}

__device__ __forceinline__ void row_mod_l(f32x4 (&v)[4], const LAS float* shift, const LAS float* scale, int lane) {
#pragma unroll
    for (int j = 0; j < 4; ++j) { const f32x4 sc = *(const LAS f32x4*)(scale + 4 * lane + 256 * j), sh = *(const LAS f32x4*)(shift + 4 * lane + 256 * j); v[j] = v[j] * (sc + 1.f) + sh; }
}
__device__ __forceinline__ void row_affine_l(f32x4 (&v)[4], const LAS float* g, const LAS float* b, int lane) {
#pragma unroll
    for (int j = 0; j < 4; ++j) { const f32x4 gg = *(const LAS f32x4*)(g + 4 * lane + 256 * j), bb = *(const LAS f32x4*)(b + 4 * lane + 256 * j); v[j] = v[j] * gg + bb; }
}

__device__ __forceinline__ void wave_sum2(float& a, float& b) {
    a += dpp_f<DPP_X1>(a); b += dpp_f<DPP_X1>(b); a += dpp_f<DPP_X2>(a); b += dpp_f<DPP_X2>(b); a += dpp_f<DPP_HM>(a); b += dpp_f<DPP_HM>(b); a += dpp_f<DPP_RM>(a); b += dpp_f<DPP_RM>(b);
    { float oa, ob; const float xa = swap16_f(a, oa), xb = swap16_f(b, ob); a = xa + oa; b = xb + ob; }
    { auto ra = __builtin_amdgcn_permlane32_swap(__float_as_uint(a), __float_as_uint(a), false, false); auto rb = __builtin_amdgcn_permlane32_swap(__float_as_uint(b), __float_as_uint(b), false, false);
      a = __uint_as_float(ra[0]) + __uint_as_float(ra[1]); b = __uint_as_float(rb[0]) + __uint_as_float(rb[1]); }
}
template <bool MOD> __device__ __forceinline__ void row_ln_fused_l(f32x4 (&v)[4], const LAS float* mulv, const LAS float* addv, int lane) {
    float s1 = 0.f, s2 = 0.f;
#pragma unroll
    for (int j = 0; j < 4; ++j) { s1 += (v[j].x + v[j].y) + (v[j].z + v[j].w); s2 += (v[j].x * v[j].x + v[j].y * v[j].y) + (v[j].z * v[j].z + v[j].w * v[j].w); }
    wave_sum2(s1, s2);
    const float mean = s1 * (1.f / DM), var = __builtin_fmaxf(s2 * (1.f / DM) - mean * mean, 0.f), rstd = __builtin_amdgcn_rsqf(var + EPS), c0 = -mean * rstd;
#pragma unroll
    for (int j = 0; j < 4; ++j) { f32x4 m4 = *(const LAS f32x4*)(mulv + 4 * lane + 256 * j); const f32x4 a4 = *(const LAS f32x4*)(addv + 4 * lane + 256 * j);
        if (MOD) m4 = m4 + 1.f;
        v[j] = v[j] * (m4 * rstd) + (m4 * c0 + a4); }
}

__device__ __forceinline__ void r0_phase(const Ctx& F0) {
    const Ctx F = fresh(F0);
    const int gw = F.bid * NWAVES + F.wave, NGW = F.G * NWAVES;
    LAS float* vb = (LAS float*)F.lds;
    { const float* mod = (const float*)(F.ws + WS_MISC + M_MOD);
      for (int i = F.tid; i < 5 * 2048 / 4; i += NTHR) { const int f = i * 4, bt = f / 2048, c = f % 2048; *(LAS f32x4*)(vb + f) = *(const f32x4*)(mod + (size_t)bt * 6144 + c); } }
    __syncthreads();
    auto srcof = [&](int r) { return r < TL ? gin(F.a->in[I_X]) + (size_t)r * DM : gin(F.a->in[I_CTX]) + (size_t)(r - TL) * DM; };
    f32x4 va[4], vc[4]; int r = gw;
    if (r < TT) { row_load(va, srcof(r), F.lane);
      for (;;) {
        const int rb = r + NGW; if (rb < TT) row_load(vc, srcof(rb), F.lane);
        { const LAS float* md = vb + batch_of(r) * 2048; row_ln_fused_l<true>(va, md + 1024, md, F.lane); row_store_bf(va, ((bf16_t*)(F.ws + WS_H)) + (size_t)r * DM, F.lane); }
        if (rb >= TT) break;
        r = rb + NGW; if (r < TT) row_load(va, srcof(r), F.lane);
        { const LAS float* md = vb + batch_of(rb) * 2048; row_ln_fused_l<true>(vc, md + 1024, md, F.lane); row_store_bf(vc, ((bf16_t*)(F.ws + WS_H)) + (size_t)rb * DM, F.lane); }
        if (r >= TT) break; } }
}

#ifndef PG8_ALIGN_DEFAULT
#define PG8_ALIGN_DEFAULT true
#endif
namespace pg8 {
constexpr int BM = 256, BK = 64, HALF = 128, HTB = HALF * BK * 2, STAGE_BYTES = 8 * HTB, NXCD = 8, WGM = 8;
__device__ __forceinline__ int lds_byte(int r, int c) { const int st = (r >> 4) * 2 + (c >> 5), rr = r & 15, cc = c & 31, ob = rr * 64 + cc * 2; return st * 1024 + (ob ^ (((ob >> 9) & 1) << 5)); }
__device__ __forceinline__ void stage_rc(int b, int& R, int& C) { const int st = b / 1024, sb = b % 1024, swz = sb ^ (((sb >> 9) & 1) << 5); R = (st >> 1) * 16 + swz / 64; C = (st & 1) * 32 + (swz % 64) / 2; }
__device__ __forceinline__ int perm32(int rho) { const int n = rho >> 4, i = rho & 15; return 8 * (i >> 2) + 4 * n + (i & 3); }
struct Unit { int pm, pn, e, nvalid, base, idx; };
__device__ __forceinline__ int xcd_remap(int wgid, int nwg) { const int q = nwg / NXCD, r = nwg % NXCD, xcd = wgid % NXCD, off = wgid / NXCD; return (xcd < r ? xcd * (q + 1) : r * (q + 1) + (xcd - r) * q) + off; }
struct StaticOrder {
    int nM, nN, nwg, G, c;
    __device__ void init(int M, int N, int G_, int c_) { nM = M / BM; nN = N / BM; nwg = nM * nN; G = G_; c = c_; }
    __device__ void at(int L, int i, Unit& u) const {
        const int wgid = xcd_remap(L, nwg);
        const int nig = WGM * nN, gid = wgid / nig, fm = gid * WGM, gsz = (nM - fm) < WGM ? (nM - fm) : WGM;
        u.pm = fm + ((wgid % nig) % gsz); u.pn = (wgid % nig) / gsz; u.e = 0; u.nvalid = 256; u.base = 0; u.idx = i;
    }
    __device__ bool next(int i, Unit& u) const { const long L = (long)i * G + c; if (L >= nwg) return false; at((int)L, i, u); return true; }
    __device__ __forceinline__ void a_ready(const Unit&, int) const {}
    __device__ __forceinline__ int ktiles(const Unit&, int nt) const { return nt; }
    __device__ __forceinline__ void done(const Unit&) const {}
};
struct DualOrder {
    StaticOrder A, B; int G, c;
    __device__ bool next(int i, Unit& u) const { const long L = (long)i * G + c; if (L >= A.nwg + B.nwg) return false;
        if (L < A.nwg) { A.at((int)L, i, u); u.e = 0; } else { B.at((int)L - A.nwg, i, u); u.e = 1; } return true; }
    __device__ __forceinline__ void a_ready(const Unit&, int) const {}
    __device__ __forceinline__ int ktiles(const Unit&, int nt) const { return nt; }
    __device__ __forceinline__ void done(const Unit&) const {}
};
struct StaticOrderPub : StaticOrder { int l;
    __device__ __forceinline__ void done(const Unit& u) const {
        if (u.pn < 2) { asm volatile("s_waitcnt vmcnt(0)" ::: "memory");
            unsigned zl; asm volatile("v_mov_b32 %0, 0" : "=v"(zl));
            if (__builtin_amdgcn_mbcnt_hi(~0u, __builtin_amdgcn_mbcnt_lo(~0u, zl)) == 0u) {
                (void)__hip_atomic_fetch_add(&g_rdy1[l][16 * u.pm], 1u, __ATOMIC_RELAXED, __HIP_MEMORY_SCOPE_AGENT); } }
    } };
struct DualOrderGated { StaticOrder A, B; int G, c, l; unsigned ldsb; mutable int skip;
    static constexpr int SK = 3;
    __device__ bool next(int i, Unit& u) const { const int r1 = ((TT / 256) * (PW / 256)) % G, Gl = G - r1;
        int L; if (c >= r1) L = i < SK ? i * Gl + (c - r1) : SK * Gl + (i - SK) * G + c; else L = SK * Gl + i * G + c;
        if (L >= A.nwg + B.nwg) return false;
        if (L < A.nwg) { A.at(L, i, u); u.e = 0; } else { B.at(L - A.nwg, i, u); u.e = 1; } return true; }
    __device__ __forceinline__ void a_ready(const Unit& u, int wid) const {
        if (skip) return;
        volatile LAS unsigned* flag = (volatile LAS unsigned*)(uintptr_t)(ldsb + (unsigned)LDS_FLAG);
        if (wid == 0) { const unsigned* w = &g_rdy1[l][16 * u.pm]; unsigned polls = 0u;
            while ((unsigned)__builtin_amdgcn_readfirstlane(__hip_atomic_load(w, __ATOMIC_RELAXED, __HIP_MEMORY_SCOPE_AGENT)) < 16u) { __builtin_amdgcn_s_sleep(2); if (++polls > (1u << 21)) break; }
            const unsigned gd = (unsigned)__builtin_amdgcn_readfirstlane(__hip_atomic_load(&g_rdy1[l][GDONE_IN_RDY1], __ATOMIC_RELAXED, __HIP_MEMORY_SCOPE_AGENT));
            __builtin_amdgcn_fence(__ATOMIC_ACQUIRE, "agent");
            asm volatile("s_waitcnt vmcnt(0)" ::: "memory");
            if (gd >= (unsigned)G) flag[0] = 1u;
            asm volatile("s_waitcnt lgkmcnt(0)" ::: "memory"); }
        asm volatile("" ::: "memory"); __builtin_amdgcn_s_barrier(); asm volatile("" ::: "memory");
        skip = (int)__builtin_amdgcn_readfirstlane(flag[0]);
    }
    __device__ __forceinline__ void done(const Unit&) const {}
    __device__ __forceinline__ int ktiles(const Unit& u, int nt) const { return u.e == 0 ? 2 : nt; }
};
struct StaticOrderPub4 : StaticOrder { int l, nearly;
    __device__ bool next(int i, Unit& u) const { const long L = (long)i * G + c; if (L >= nwg) return false;
        if (L < nearly) { StaticOrder E = *this; E.nM = nearly / nN; E.nwg = nearly; E.at((int)L, i, u); }
        else { const int x = (int)L - nearly; u.pm = nearly / nN + x / nN; u.pn = x % nN; u.e = 0; u.nvalid = 256; u.base = 0; u.idx = i; }
        return true; }
    __device__ __forceinline__ void done(const Unit& u) const {
        asm volatile("s_waitcnt vmcnt(0)" ::: "memory");
        unsigned zl; asm volatile("v_mov_b32 %0, 0" : "=v"(zl));
        if (__builtin_amdgcn_mbcnt_hi(~0u, __builtin_amdgcn_mbcnt_lo(~0u, zl)) == 0u) (void)__hip_atomic_fetch_add(&g_rdy4[l][16 * u.pm], 1u, __ATOMIC_RELAXED, __HIP_MEMORY_SCOPE_AGENT);
    } };
struct ExpertOrder {
    const LAS int* tl; const LAS int* cnt; const LAS int* te; int nN, nwg, G, c;
    __device__ void init(const LAS int* tl_, const LAS int* cnt_, const LAS int* te_, int nN_, int G_, int c_) { tl = tl_; cnt = cnt_; te = te_; nN = nN_; nwg = __builtin_amdgcn_readfirstlane(tl_[33]) * nN_; G = G_; c = c_; }
    __device__ void at(int L, int i, Unit& u) const {
        const int wgid = xcd_remap(L, nwg), mt = wgid / nN;
        const int e = __builtin_amdgcn_readfirstlane(te[mt]);
        const int te_ = __builtin_amdgcn_readfirstlane(tl[e]), ce = __builtin_amdgcn_readfirstlane(cnt[e]);
        u.e = e; u.pm = mt - te_; u.pn = wgid % nN; u.nvalid = ce - u.pm * 256; u.base = te_ * 256; u.idx = i;
    }
    __device__ bool next(int i, Unit& u) const { const long L = (long)i * G + c; if (L >= nwg) return false; at((int)L, i, u); return true; }
    __device__ __forceinline__ void a_ready(const Unit&, int) const {}
    __device__ __forceinline__ int ktiles(const Unit&, int nt) const { return nt; }
    __device__ __forceinline__ void done(const Unit&) const {}
};
struct ExpertOrderPub : ExpertOrder { int l;
    __device__ __forceinline__ void done(const Unit& u) const {
        asm volatile("s_waitcnt vmcnt(0)" ::: "memory");
        unsigned zl; asm volatile("v_mov_b32 %0, 0" : "=v"(zl));
        if (__builtin_amdgcn_mbcnt_hi(~0u, __builtin_amdgcn_mbcnt_lo(~0u, zl)) == 0u) {
            (void)__hip_atomic_fetch_add(&g_rdy[l][16 * ((u.base >> 8) + u.pm)], 1u, __ATOMIC_RELAXED, __HIP_MEMORY_SCOPE_AGENT); }
    } };
struct ExpertOrderGated : ExpertOrder { int l; mutable int skip;
    static constexpr int SK = 3;
    __device__ bool next(int i, Unit& u) const {
        const int nwg5 = __builtin_amdgcn_readfirstlane(tl[33]) * 2, r5 = nwg5 % G, Gl = G - r5;
        int L; if (c >= r5) L = i < SK ? i * Gl + (c - r5) : SK * Gl + (i - SK) * G + c; else L = SK * Gl + i * G + c;
        if (L >= nwg) return false; at(L, i, u); return true; }
    __device__ __forceinline__ void a_ready(const Unit& u, int wid) const {
        if (skip) return;
        volatile LAS unsigned* flag = (volatile LAS unsigned*)((const LAS char*)tl + (LDS_FLAG - LDS_ET));
        if (wid == 0) { const unsigned* w = &g_rdy[l][16 * ((u.base >> 8) + u.pm)]; unsigned polls = 0u;
            while ((unsigned)__builtin_amdgcn_readfirstlane(__hip_atomic_load(w, __ATOMIC_RELAXED, __HIP_MEMORY_SCOPE_AGENT)) < 16u) { __builtin_amdgcn_s_sleep(2); if (++polls > (1u << 21)) break; }
            const unsigned gd = (unsigned)__builtin_amdgcn_readfirstlane(__hip_atomic_load(&g_rdy[l][GDONE_IN_RDY], __ATOMIC_RELAXED, __HIP_MEMORY_SCOPE_AGENT));
            __builtin_amdgcn_fence(__ATOMIC_ACQUIRE, "agent");
            asm volatile("s_waitcnt vmcnt(0)" ::: "memory");
            if (gd >= (unsigned)G) flag[0] = 1u;
            asm volatile("s_waitcnt lgkmcnt(0)" ::: "memory"); }
        asm volatile("" ::: "memory"); __builtin_amdgcn_s_barrier(); asm volatile("" ::: "memory");
        skip = (int)__builtin_amdgcn_readfirstlane(flag[0]);
    } };
__device__ __forceinline__ unsigned cvt_pk_bf16(float lo, float hi) { unsigned r; asm volatile("v_cvt_pk_bf16_f32 %0, %1, %2" : "=v"(r) : "v"(lo), "v"(hi)); return r; }
__device__ __forceinline__ u32x4 pack8(const f32x4& v0, const f32x4& v1) { u32x4 w; w.x = cvt_pk_bf16(v0[0], v0[1]); w.y = cvt_pk_bf16(v0[2], v0[3]); w.z = cvt_pk_bf16(v1[0], v1[1]); w.w = cvt_pk_bf16(v1[2], v1[3]); return w; }

template <bool GATHER, bool ALIGN_EPI = PG8_ALIGN_DEFAULT, class Sched, class AOff, class BPtr, class Epi>
__device__ __forceinline__ void gemm256(LAS unsigned char* lds, int tid, const char* Abase, int pitch, int K, const Sched& S, const AOff& aoff, const BPtr& bptr, const Epi& E) {
    const int wid = __builtin_amdgcn_readfirstlane(tid >> 6), lane = tid & 63, wr = wid >> 2, wc = wid & 3, fr = lane & 15, fq = lane >> 4;
    const int nt = K / BK;
    int sR, sC; stage_rc(tid * 16, sR, sC);
    const unsigned voffB = (unsigned)(((sR & ~31) + perm32(sR & 31)) * K + sC) * 2u;
    const unsigned laneA = (unsigned)sR * (unsigned)pitch + (unsigned)sC * 2u;
    const size_t kstep = (size_t)(BK * 2);
    const size_t hstepB = (size_t)HALF * K * 2, pstepB = (size_t)64 * K * 2;
    const size_t hstepA = (size_t)HALF * pitch, pstepA = (size_t)64 * pitch;
    const unsigned ldsw = (unsigned)wid * 1024u;
    const int loffl = lds_byte(fr, fq * 8), aoffu = 8192 * wr, boffu = 4096 * wc;
#define PG8_SA(b, h) (((b) * 2 + (h)) * HTB)
#define PG8_SB(b, h) ((4 + (b) * 2 + (h)) * HTB)
#define PG8_STAGEB(bufoff, gbase) do { _Pragma("unroll") for (int _i = 0; _i < 2; ++_i) \
        __builtin_amdgcn_global_load_lds((const unsigned*)((const char*)(gbase) + _i * pstepB + voffB), (LAS unsigned*)(lds + (bufoff) + ldsw + _i * 8192), 16, 0, 0); } while (0)
#define PG8_STAGEA(bufoff, TP, OFFS, h, kb) do { _Pragma("unroll") for (int _i = 0; _i < 2; ++_i) { \
        const char* _p; if constexpr (GATHER) _p = Abase + (size_t)(OFFS)[h][_i] + (kb); else _p = (TP) + ((h) * hstepA + _i * pstepA + (kb)) + laneA; \
        __builtin_amdgcn_global_load_lds((const unsigned*)_p, (LAS unsigned*)(lds + (bufoff) + ldsw + _i * 8192), 16, 0, 0); } } while (0)
#define PG8_LDA(dst, b, h) do { int _ao; asm volatile("v_add_u32 %0, %1, %2" : "=v"(_ao) : "s"(aoffu), "v"(loffl)); _Pragma("unroll") for (int m = 0; m < 4; ++m) _Pragma("unroll") for (int k = 0; k < 2; ++k) dst[m][k] = *(const LAS bf16x8*)(lds + PG8_SA(b, h) + _ao + m * 2048 + k * 1024); } while (0)
#define PG8_LDB(dst, b, h) do { int _bo; asm volatile("v_add_u32 %0, %1, %2" : "=v"(_bo) : "s"(boffu), "v"(loffl)); _Pragma("unroll") for (int n = 0; n < 2; ++n) _Pragma("unroll") for (int k = 0; k < 2; ++k) dst[n][k] = *(const LAS bf16x8*)(lds + PG8_SB(b, h) + _bo + n * 2048 + k * 1024); } while (0)
#define PG8_MMA(ai, bj, At, Bt) do { __builtin_amdgcn_s_setprio(1); _Pragma("unroll") for (int m = 0; m < 4; ++m) _Pragma("unroll") for (int n = 0; n < 2; ++n) _Pragma("unroll") for (int k = 0; k < 2; ++k) \
        acc[ai][bj][m][n] = __builtin_amdgcn_mfma_f32_16x16x32_bf16(Bt[n][k], At[m][k], acc[ai][bj][m][n], 0, 0, 0); __builtin_amdgcn_s_setprio(0); } while (0)
#define PG8_WAIT_V(n) asm volatile("s_waitcnt vmcnt(" #n ")" ::: "memory")
#define PG8_WAIT_L(n) asm volatile("s_waitcnt lgkmcnt(" #n ")" ::: "memory")
#define PG8_BAR __builtin_amdgcn_s_barrier()
#define PG8_SCHED __builtin_amdgcn_sched_barrier(0)
#define PG8_AOFFS(dst, tp, u) do { if constexpr (GATHER) { _Pragma("unroll") for (int _h = 0; _h < 2; ++_h) _Pragma("unroll") for (int _i = 0; _i < 2; ++_i) dst[_h][_i] = aoff(u, _h * 128 + _i * 64 + sR) + (unsigned)sC * 2u; } \
        else tp = aoff(u); } while (0)
    Unit cur, nxt; int ui = 0;
    if (!S.next(0, cur)) return;
    f32x4 acc[2][2][4][2];
#pragma unroll
    for (int a = 0; a < 2; ++a)
#pragma unroll
        for (int b = 0; b < 2; ++b)
#pragma unroll
            for (int m = 0; m < 4; ++m)
#pragma unroll
                for (int n = 0; n < 2; ++n) acc[a][b][m][n] = (f32x4){0.f, 0.f, 0.f, 0.f};
    bf16x8 At[4][2], B0[2][2], B1[2][2];
    unsigned cA[2][2] = {{0u, 0u}, {0u, 0u}}, nA[2][2] = {{0u, 0u}, {0u, 0u}}; const char* cTP = Abase; const char* nTP = Abase;
    PG8_AOFFS(cA, cTP, cur);
    const char* cB = bptr(cur);
    S.a_ready(cur, wid);
    PG8_STAGEB(PG8_SB(0, 0), cB); PG8_STAGEB(PG8_SB(0, 1), cB + hstepB); PG8_STAGEA(PG8_SA(0, 0), cTP, cA, 0, 0); PG8_STAGEA(PG8_SA(0, 1), cTP, cA, 1, 0);
    if (wr == 1) PG8_BAR;
    PG8_WAIT_V(2); PG8_BAR;
    PG8_STAGEB(PG8_SB(1, 0), cB + kstep); PG8_STAGEA(PG8_SA(1, 0), cTP, cA, 0, kstep); PG8_STAGEB(PG8_SB(1, 1), cB + hstepB + kstep);
    PG8_WAIT_V(6); PG8_BAR;
    for (;;) {
        const bool has_next = S.next(ui + 1, nxt);
        const char* nB = cB; nTP = cTP;
        if (has_next) { PG8_AOFFS(nA, nTP, nxt); nB = bptr(nxt); }
        else { if constexpr (GATHER) {
#pragma unroll
            for (int h = 0; h < 2; ++h)
#pragma unroll
                for (int i = 0; i < 2; ++i) nA[h][i] = cA[h][i]; } }
        const int ntu = S.ktiles(cur, nt);
        for (int t = 0; t < ntu; t += 2) {
            const bool last = (t == ntu - 2);
            const size_t k1 = (size_t)(t + 1) * kstep;
            if (last && has_next) S.a_ready(nxt, wid);
            unsigned a2o[2][2] = {{0u, 0u}, {0u, 0u}};
            if constexpr (GATHER) {
#pragma unroll
                for (int h = 0; h < 2; ++h)
#pragma unroll
                    for (int i = 0; i < 2; ++i) a2o[h][i] = last ? nA[h][i] : cA[h][i]; }
            const char* t2p = last ? nTP : cTP;
            const size_t k2 = last ? 0 : (size_t)(t + 2) * kstep, k3 = k2 + kstep;
            const char* b2 = last ? nB : cB + (size_t)(t + 2) * kstep; const char* b3 = b2 + kstep;
            PG8_LDB(B0, 0, 0); PG8_LDB(B1, 0, 1); PG8_SCHED; PG8_LDA(At, 0, 0); PG8_STAGEA(PG8_SA(1, 1), cTP, cA, 1, k1);
            PG8_WAIT_V(8); PG8_WAIT_L(0); PG8_BAR; PG8_MMA(0, 0, At, B0); PG8_MMA(0, 1, At, B1); PG8_BAR; PG8_SCHED;
            PG8_LDA(At, 0, 1); PG8_STAGEB(PG8_SB(0, 0), b2); PG8_STAGEB(PG8_SB(0, 1), b2 + hstepB); PG8_STAGEA(PG8_SA(0, 0), t2p, a2o, 0, k2);
            PG8_WAIT_V(8); PG8_WAIT_L(0); PG8_BAR; PG8_MMA(1, 0, At, B0); PG8_MMA(1, 1, At, B1); PG8_BAR; PG8_SCHED;
            PG8_LDB(B0, 1, 0); PG8_LDB(B1, 1, 1); PG8_SCHED; PG8_LDA(At, 1, 0); PG8_STAGEA(PG8_SA(0, 1), t2p, a2o, 1, k2);
            PG8_WAIT_V(8); PG8_WAIT_L(0); PG8_BAR; PG8_MMA(0, 0, At, B0); PG8_MMA(0, 1, At, B1); PG8_BAR; PG8_SCHED;
            PG8_LDA(At, 1, 1); PG8_STAGEB(PG8_SB(1, 0), b3); PG8_STAGEB(PG8_SB(1, 1), b3 + hstepB); PG8_STAGEA(PG8_SA(1, 0), t2p, a2o, 0, k3);
            PG8_WAIT_V(8); PG8_WAIT_L(0); PG8_BAR; PG8_MMA(1, 0, At, B0); PG8_MMA(1, 1, At, B1); PG8_BAR; PG8_SCHED;
        }
        if constexpr (ALIGN_EPI) { if (wr == 0) PG8_BAR; }
        { unsigned zl; asm volatile("v_mov_b32 %0, 0" : "=v"(zl)); const int l2 = (int)__builtin_amdgcn_mbcnt_hi(~0u, __builtin_amdgcn_mbcnt_lo(~0u, zl)); E(acc, cur, wr, wc, l2 & 15, l2 >> 4); S.done(cur); }
        if (!has_next) break;
#pragma unroll
        for (int a = 0; a < 2; ++a)
#pragma unroll
            for (int b = 0; b < 2; ++b)
#pragma unroll
                for (int m = 0; m < 4; ++m)
#pragma unroll
                    for (int n = 0; n < 2; ++n) acc[a][b][m][n] = (f32x4){0.f, 0.f, 0.f, 0.f};
        cur = nxt; cB = nB; cTP = nTP; ++ui;
        if constexpr (GATHER) {
#pragma unroll
            for (int h = 0; h < 2; ++h)
#pragma unroll
                for (int i = 0; i < 2; ++i) cA[h][i] = nA[h][i]; }
        if constexpr (ALIGN_EPI) { if (wr == 1) PG8_BAR; }
    }
    PG8_WAIT_V(0);
    if constexpr (!ALIGN_EPI) { if (wr == 0) PG8_BAR; }
    PG8_BAR;
#undef PG8_SA
#undef PG8_SB
#undef PG8_STAGEA
#undef PG8_STAGEB
#undef PG8_LDA
#undef PG8_LDB
#undef PG8_MMA
#undef PG8_WAIT_V
#undef PG8_WAIT_L
#undef PG8_BAR
#undef PG8_SCHED
#undef PG8_AOFFS
}
}

#define FP8C(x) __builtin_amdgcn_fmed3f((x), -440.f, 440.f)
__device__ __forceinline__ u32x2 pack8_fp8(const f32x4& v0, const f32x4& v1) { u32x2 w; int p = __builtin_amdgcn_cvt_pk_fp8_f32(FP8C(v0[0]), FP8C(v0[1]), 0, false); p = __builtin_amdgcn_cvt_pk_fp8_f32(FP8C(v0[2]), FP8C(v0[3]), p, true); w.x = (unsigned)p;
    p = __builtin_amdgcn_cvt_pk_fp8_f32(FP8C(v1[0]), FP8C(v1[1]), 0, false); p = __builtin_amdgcn_cvt_pk_fp8_f32(FP8C(v1[2]), FP8C(v1[3]), p, true); w.y = (unsigned)p; return w; }
struct EpiStore { bf16_t* O; int ldc;
    __device__ __forceinline__ void operator()(const f32x4 (&acc)[2][2][4][2], const pg8::Unit& u, int wr, int wc, int fr, int fq) const {
        bf16_t* base = O + (size_t)(u.pm * 256 + wr * 64 + fr) * ldc + u.pn * 256 + wc * 32 + 8 * fq;
#pragma unroll
        for (int ai = 0; ai < 2; ++ai)
#pragma unroll
            for (int m = 0; m < 4; ++m) { bf16_t* rowp = base + (size_t)(ai * 128 + m * 16) * ldc;
#pragma unroll
                for (int bj = 0; bj < 2; ++bj) *(u32x4*)(rowp + bj * 128) = pg8::pack8(acc[ai][bj][m][0], acc[ai][bj][m][1]);
                asm volatile("" ::: "memory"); } } };
constexpr int LDS_ROPE = 151040;
static_assert(LDS_ROPE + 8192 <= LDS_XB, "LDS rope table");
__device__ __forceinline__ void rope_to_lds(const Ctx& F) { *(LAS f32x4*)(F.lds + LDS_ROPE + F.tid * 16) = *(const f32x4*)((const float*)(F.ws + WS_MISC + M_ROPE) + F.tid * 4); __syncthreads(); }
struct EpiQ { bf16_t* Q; bf16_t* QR; const float* rs; const LAS float* rope;
    __device__ __forceinline__ void operator()(const f32x4 (&acc)[2][2][4][2], const pg8::Unit& u, int wr, int wc, int fr, int fq) const {
        float rs8[2][4];
#pragma unroll
        for (int ai = 0; ai < 2; ++ai)
#pragma unroll
            for (int m = 0; m < 4; ++m) { const f32x4 q4 = *(const f32x4*)(rs + (size_t)(u.pm * 256 + ai * 128 + wr * 64 + m * 16 + fr) * 8); rs8[ai][m] = __builtin_amdgcn_rsqf(((q4[0] + q4[1]) + (q4[2] + q4[3])) * (1.f / 256.f) + EPS); }
#pragma unroll
        for (int ai = 0; ai < 2; ++ai)
#pragma unroll
            for (int m = 0; m < 4; ++m) { const int r = u.pm * 256 + ai * 128 + wr * 64 + m * 16 + fr; const float sc = rs8[ai][m] * (ATTN_SCALE * 1.4426950408889634f); const int s = r & (SEQ - 1);
#pragma unroll
                for (int bj = 0; bj < 2; ++bj) { const int col0 = u.pn * 256 + bj * 128 + wc * 32 + 8 * fq, hh = col0 / 96, cw = col0 - hh * 96;
                    f32x4 v0 = acc[ai][bj][m][0] * sc, v1 = acc[ai][bj][m][1] * sc; f32x4 p0, p1;
#pragma unroll
                    for (int i = 0; i < 4; ++i) { float o; const float a = swap16_f(v0[i], o); p0[i] = (fq & 1) ? a : o; const float c = swap16_f(v1[i], o); p1[i] = (fq & 1) ? c : o; }
                    if (cw >= 64 && r < TL) { const int c2 = cw - 64, pos = (c2 & 16) ? (s & 63) : (s >> 6); const bool second = (c2 & 8) != 0; const LAS float* tb = rope + pos * 16;
                        *(u32x4*)(QR + (size_t)r * 256 + hh * 32 + c2) = pg8::pack8(v0, v1);
                        const f32x4 cs0 = *(const LAS f32x4*)tb, cs1 = *(const LAS f32x4*)(tb + 4), sn0 = *(const LAS f32x4*)(tb + 8), sn1 = *(const LAS f32x4*)(tb + 12);
                        if (second) { v0 = v0 * cs0 + p0 * sn0; v1 = v1 * cs1 + p1 * sn1; } else { v0 = v0 * cs0 - p0 * sn0; v1 = v1 * cs1 - p1 * sn1; } }
                    *(u32x4*)(Q + (size_t)r * 768 + col0) = pg8::pack8(v0, v1); }
                asm volatile("" ::: "memory"); } } };
struct EpiKV { bf16_t* KV; const float* rs;
    __device__ __forceinline__ void operator()(const f32x4 (&acc)[2][2][4][2], const pg8::Unit& u, int wr, int wc, int fr, int fq) const {
        float rs8[2][4];
#pragma unroll
        for (int ai = 0; ai < 2; ++ai)
#pragma unroll
            for (int m = 0; m < 4; ++m) { const f32x4 q4 = *(const f32x4*)(rs + (size_t)(u.pm * 256 + ai * 128 + wr * 64 + m * 16 + fr) * 8 + 4); rs8[ai][m] = __builtin_amdgcn_rsqf(((q4[0] + q4[1]) + (q4[2] + q4[3])) * (1.f / 128.f) + EPS); }
#pragma unroll
        for (int ai = 0; ai < 2; ++ai)
#pragma unroll
            for (int m = 0; m < 4; ++m) { const int r = u.pm * 256 + ai * 128 + wr * 64 + m * 16 + fr; const float sc = rs8[ai][m]; const int kr = kvrow_of(r), key = kr & 63;
                bf16_t* rowp = KV + ((size_t)(kr >> 6) * 8 + u.pn * 2) * 8192 + (wc < 2 ? ((wc * 4 + fq) * 64 + key) * 8 : 4096 + ((((wc - 2) * 4 + (key >> 4)) * 16 + (key & 15)) * 4 + fq) * 8);
#pragma unroll
                for (int bj = 0; bj < 2; ++bj) *(u32x4*)(rowp + bj * 8192) = pg8::pack8(acc[ai][bj][m][0] * sc, acc[ai][bj][m][1] * sc);
                asm volatile("" ::: "memory"); } } };
struct EpiQKV { EpiKV ekv; EpiQ eq;
    __device__ __forceinline__ void operator()(const f32x4 (&acc)[2][2][4][2], const pg8::Unit& u, int wr, int wc, int fr, int fq) const { if (u.e == 0) ekv(acc, u, wr, wc, fr, fq); else eq(acc, u, wr, wc, fr, fq); } };
__device__ __forceinline__ void g23_stream(const Ctx& F, int l) {
    pg8::DualOrderGated S; S.A.init(TT, 1024, F.G, F.bid); S.B.init(TT, 768, F.G, F.bid); S.G = F.G; S.c = F.bid; S.skip = 0; S.ldsb = (unsigned)(uintptr_t)F.lds;
    const char* Abq = (const char*)(F.ws + WS_P);
    auto aoff = [&](const pg8::Unit& u) { return Abq + (size_t)(u.e == 0 ? OFF_KV * 2 : 0) + (size_t)u.pm * 256 * PW * 2; };
    const char* Wb = (const char*)(F.ws + WS_W);
    S.l = l;
    auto bptr = [&](const pg8::Unit& u) { return Wb + (size_t)(u.e == 0 ? W_WKV : W_WQ) + (size_t)u.pn * 256 * 256 * 2; };
    EpiQKV E{EpiKV{(bf16_t*)(F.ws + WS_KV), (const float*)(F.ws + WS_MISC + M_RS)}, EpiQ{(bf16_t*)(F.ws + WS_Q), (bf16_t*)(F.ws + WS_QR), (const float*)(F.ws + WS_MISC + M_RS), (const LAS float*)(F.lds + LDS_ROPE)}};
    pg8::gemm256<false>(F.lds, F.tid, Abq, PW * 2, 256, S, aoff, bptr, E);
}
struct EpiG1 { __amdgpu_buffer_rsrc_t Pr; float* rs; bf16_t* KR; const LAS float* rope;
    __device__ __forceinline__ void operator()(const f32x4 (&acc)[2][2][4][2], const pg8::Unit& u, int wr, int wc, int fr, int fq) const {
        const unsigned base = (unsigned)(((u.pm * 256 + wr * 64 + fr) * PW + u.pn * 256 + wc * 32 + 8 * fq) * 2);
#pragma unroll
        for (int ai = 0; ai < 2; ++ai)
#pragma unroll
            for (int m = 0; m < 4; ++m) { const unsigned rowo = base + (unsigned)((ai * 128 + m * 16) * PW * 2);
#pragma unroll
                for (int bj = 0; bj < 2; ++bj) __builtin_amdgcn_raw_buffer_store_b128(pg8::pack8(acc[ai][bj][m][0], acc[ai][bj][m][1]), Pr, rowo + bj * 256, 0, 16);
                asm volatile("" ::: "memory"); }
        if (u.pn < 2) {
#pragma unroll
            for (int ai = 0; ai < 2; ++ai)
#pragma unroll
                for (int m = 0; m < 4; ++m) { const int r = u.pm * 256 + ai * 128 + wr * 64 + m * 16 + fr;
                    const f32x4 a0 = acc[ai][0][m][0], a1 = acc[ai][0][m][1], b0 = acc[ai][1][m][0], b1 = acc[ai][1][m][1];
                    float ss = (a0[0] * a0[0] + a0[1] * a0[1]) + (a0[2] * a0[2] + a0[3] * a0[3]) + (a1[0] * a1[0] + a1[1] * a1[1]) + (a1[2] * a1[2] + a1[3] * a1[3]);
                    if (u.pn == 0) ss += (b0[0] * b0[0] + b0[1] * b0[1]) + (b0[2] * b0[2] + b0[3] * b0[3]) + (b1[0] * b1[0] + b1[1] * b1[1]) + (b1[2] * b1[2] + b1[3] * b1[3]);
                    { float o; const float a = swap16_f(ss, o); ss = a + o; }
                    { auto rr = __builtin_amdgcn_permlane32_swap(__float_as_uint(ss), __float_as_uint(ss), false, false); ss = __uint_as_float(rr[0]) + __uint_as_float(rr[1]); }
                    if (fq == 0) __hip_atomic_store(rs + (size_t)r * 8 + u.pn * 4 + wc, ss, __ATOMIC_RELAXED, __HIP_MEMORY_SCOPE_AGENT);
                    if (u.pn == 1) {
                        f32x4 p0, p1;
#pragma unroll
                        for (int i = 0; i < 4; ++i) { float o; const float a = swap16_f(b0[i], o); p0[i] = (fq & 1) ? a : o; const float c = swap16_f(b1[i], o); p1[i] = (fq & 1) ? c : o; }
                        if (wc == 0) { f32x4 v0 = b0, v1 = b1;
                            if (r < TL) { const int sq = r & (SEQ - 1), pos = (fq & 2) ? (sq & 63) : (sq >> 6); const LAS float* tb = rope + pos * 16;
                                const f32x4 cs0 = *(const LAS f32x4*)tb, cs1 = *(const LAS f32x4*)(tb + 4), sn0 = *(const LAS f32x4*)(tb + 8), sn1 = *(const LAS f32x4*)(tb + 12);
                                if (fq & 1) { v0 = v0 * cs0 + p0 * sn0; v1 = v1 * cs1 + p1 * sn1; } else { v0 = v0 * cs0 - p0 * sn0; v1 = v1 * cs1 - p1 * sn1; } }
                            { const int kr = kvrow_of(r); *(u32x4*)(KR + ((size_t)(kr >> 6) * 4 + fq) * 512 + (kr & 63) * 8) = pg8::pack8(v0, v1); } } }
                    asm volatile("" ::: "memory"); } } } };
__device__ __forceinline__ void g1_phase(const Ctx& F0, int l) {
    const Ctx F = fresh(F0);
    pg8::StaticOrderPub S; S.init(TT, PW, F.G, F.bid);
    const char* Ab = (const char*)(F.ws + WS_H);
    auto aoff = [&](const pg8::Unit& u) { return Ab + (size_t)u.pm * 256 * DM * 2; };
    const char* Bt = (const char*)(F.ws + WS_W + W_WIN);
    S.l = l;
    auto bptr = [&](const pg8::Unit& u) { return Bt + (size_t)u.pn * 256 * DM * 2; };
    rope_to_lds(F);
    if (F.tid == 0) ((volatile LAS unsigned*)(F.lds + LDS_FLAG))[0] = 0u;
    EpiG1 E{__builtin_amdgcn_make_buffer_rsrc((void*)(F.ws + WS_P), 0, (int)(WS_Q - WS_P), 0x00020000), (float*)(F.ws + WS_MISC + M_RS), (bf16_t*)(F.ws + WS_KR), (const LAS float*)(F.lds + LDS_ROPE)};
    pg8::gemm256<false>(F.lds, F.tid, Ab, DM * 2, DM, S, aoff, bptr, E);
    if (F.tid == 0) (void)__hip_atomic_fetch_add(&g_rdy1[l][GDONE_IN_RDY1], 1u, __ATOMIC_RELAXED, __HIP_MEMORY_SCOPE_AGENT);
    __syncthreads();
    g23_stream(F, l);
}
struct EpiStore8 { __amdgpu_buffer_rsrc_t Or;
    __device__ __forceinline__ void operator()(const f32x4 (&acc)[2][2][4][2], const pg8::Unit& u, int wr, int wc, int fr, int fq) const {
        const unsigned base = (unsigned)((u.pm * 256 + wr * 64 + fr) * DM + u.pn * 256 + wc * 64 + 16 * fq);
#pragma unroll
        for (int ai = 0; ai < 2; ++ai)
#pragma unroll
            for (int m = 0; m < 4; ++m) { const u32x2 lo = pack8_fp8(acc[ai][0][m][0], acc[ai][0][m][1]), hi = pack8_fp8(acc[ai][1][m][0], acc[ai][1][m][1]);
                __builtin_amdgcn_raw_buffer_store_b128((u32x4){lo.x, lo.y, hi.x, hi.y}, Or, base + (unsigned)((ai * 128 + m * 16) * DM), 0, 16);
                asm volatile("" ::: "memory"); } } };
__device__ __forceinline__ void g4_phase(const Ctx& F0, int nrows, int l) {
    const Ctx F = fresh(F0);
    pg8::StaticOrderPub4 S; S.init(nrows, DM, F.G, F.bid); S.l = l; S.nearly = (S.nwg / F.G) * F.G;
    const char* Ab = (const char*)(F.ws + WS_MIX);
    auto aoff = [&](const pg8::Unit& u) { return Ab + (size_t)u.pm * 256 * DM * 2; };
    const char* Bt = (const char*)(F.ws + WS_W + W_WO);
    auto bptr = [&](const pg8::Unit& u) { return Bt + (size_t)u.pn * 256 * DM * 2; };
    EpiStore8 E{__builtin_amdgcn_make_buffer_rsrc((void*)(F.ws + WS_Y1), 0, (int)((size_t)TT * DM), 0x00020000)};
    pg8::gemm256<false>(F.lds, F.tid, Ab, DM * 2, DM, S, aoff, bptr, E);
}

constexpr int LDS_TE = LDS_ET + 512, LDS_RT = LDS_TE + 3072;
static_assert(LDS_RT + 8192 <= LDS_XB, "LDS tables");
__device__ __forceinline__ void expert_tables(const Ctx& F, int l, int nrows) {
    LAS int* tl = (LAS int*)(F.lds + LDS_ET); LAS int* cnt = tl + 64; LAS int* te = (LAS int*)(F.lds + LDS_TE);
    if (F.tid < 64) { const int e = F.tid; int c = 0;
        if (e < 32) c = (int)__hip_atomic_load(((unsigned*)(F.ws + WS_CTL)) + CW_GCNT + l * 64 + e, __ATOMIC_RELAXED, __HIP_MEMORY_SCOPE_AGENT); else if (e == 32) c = nrows;
        if (e < 33) cnt[e] = c;
        te[e] = (c + 255) / 256;
        LDS_WAIT(); asm volatile("" ::: "memory");
        int acc = 0;
        for (int j = 0; j < 33; ++j) { const int tj = te[j]; acc += j < e ? tj : 0; }
        if (e < 34) tl[e] = acc; }
    __syncthreads();
    const int nmt = tl[33];
    for (int mt = F.tid; mt < nmt && mt < 768; mt += NTHR) { int e = 0; while (e < 32 && mt >= tl[e + 1]) ++e; te[mt] = e; }
    __syncthreads();
}
struct EpiD { __amdgpu_buffer_rsrc_t wsr;
    __device__ __forceinline__ void operator()(const f32x4 (&acc)[2][2][4][2], const pg8::Unit& u, int wr, int wc, int fr, int fq) const {
        const unsigned ob = (u.e < 32 ? (unsigned)WS_YB + (unsigned)u.base * (unsigned)DM : (unsigned)WS_YS8) + (unsigned)(u.pm * 256) * (unsigned)DM + (unsigned)(u.pn * 256 + wc * 64);
#pragma unroll
        for (int ai = 0; ai < 2; ++ai)
#pragma unroll
            for (int m = 0; m < 4; ++m) { const int rl = ai * 128 + wr * 64 + m * 16 + fr;
                if (rl < u.nvalid) { const u32x2 lo = pack8_fp8(acc[ai][0][m][0], acc[ai][0][m][1]), hi = pack8_fp8(acc[ai][1][m][0], acc[ai][1][m][1]);
                    __builtin_amdgcn_raw_buffer_store_b128((u32x4){lo.x, lo.y, hi.x, hi.y}, wsr, (unsigned)(rl * DM + 16 * fq), ob, 0); }
                asm volatile("" ::: "memory"); } } };
__device__ __forceinline__ void g6_stream(const Ctx& F, int l, const LAS int* tl, const LAS int* cnt) {
    pg8::ExpertOrderGated S; S.init(tl, cnt, (const LAS int*)(F.lds + LDS_TE), 4, F.G, F.bid); S.skip = 0;
    const char* Ab = (const char*)(F.ws + WS_HB);
    auto aoff = [&](const pg8::Unit& u) { return Ab + (size_t)(u.base + u.pm * 256) * 512; };
    const char* Bt = (const char*)(F.ws + WS_W + W_WD);
    S.l = l;
    auto bptr = [&](const pg8::Unit& u) { return Bt + ((size_t)u.e * DM + (size_t)u.pn * 256) * 256 * 2; };
    EpiD E{__builtin_amdgcn_make_buffer_rsrc((void*)F.ws, 0, (int)WS_END, 0x00020000)};
    pg8::gemm256<false>(F.lds, F.tid, Ab, 512, 256, S, aoff, bptr, E);
}

struct EpiGU { __amdgpu_buffer_rsrc_t HBr; const LAS float* gatetab;
    __device__ __forceinline__ void operator()(const f32x4 (&acc)[2][2][4][2], const pg8::Unit& u, int wr, int wc, int fr, int fq) const {
#pragma unroll
        for (int ai = 0; ai < 2; ++ai)
#pragma unroll
            for (int m = 0; m < 4; ++m) { const int rl = ai * 128 + wr * 64 + m * 16 + fr;
                if (rl < u.nvalid) { f32x4 h0, h1; const float gt = gatetab[(u.idx & 7) * 256 + rl];
#pragma unroll
                    for (int i = 0; i < 4; ++i) { h0[i] = silu(acc[ai][0][m][0][i]) * (acc[ai][1][m][0][i] * gt); h1[i] = silu(acc[ai][0][m][1][i]) * (acc[ai][1][m][1][i] * gt); }
                    __builtin_amdgcn_raw_buffer_store_b128(pg8::pack8(h0, h1), HBr, (unsigned)(((u.base + u.pm * 256 + rl) * 256 + u.pn * 128 + wc * 32 + 8 * fq) * 2), 0,   16); }
                asm volatile("" ::: "memory"); } } };
__device__ __forceinline__ void g5_phase(const Ctx& F0, int l, int nrows) {
    const Ctx F = fresh(F0);
    expert_tables(F, l, nrows);
    const LAS int* tl = (const LAS int*)(F.lds + LDS_ET); const LAS int* cnt = tl + 64;
    pg8::ExpertOrderPub S; S.init(tl, cnt, (const LAS int*)(F.lds + LDS_TE), 2, F.G, F.bid);
    const int* list = (const int*)(F.ws + WS_MISC + M_LIST);
    LAS unsigned* rowtab = (LAS unsigned*)(F.lds + LDS_RT); LAS float* gatetab = (LAS float*)(F.lds + LDS_ROPE);
    const float* listw = (const float*)(F.ws + WS_MISC + M_LISTW);
    { pg8::Unit u; u.pm = 0; u.pn = 0; u.e = 0; u.nvalid = 256; u.base = 0; u.idx = 0;
      unsigned tk[8]; float gk[8];
#pragma unroll
      for (int i = 0; i < 8; ++i) { (void)S.next(i, u);
          int r = u.pm * 256 + (F.tid & 255); const int lastv = u.pm * 256 + u.nvalid - 1; r = r < lastv ? r : lastv;
          const int tok = list[(size_t)(u.e < 32 ? u.e : 0) * TT + r]; tk[i] = (unsigned)(u.e < 32 ? tok : r) * (unsigned)(DM * 2);
          const float gv = listw[(size_t)(u.e < 32 ? u.e : 0) * TT + r]; gk[i] = u.e < 32 ? gv : 1.f; }
#pragma unroll
      for (int i = 0; i < 8; ++i) if (F.tid < 256) { rowtab[i * 256 + F.tid] = tk[i]; gatetab[i * 256 + F.tid] = gk[i]; }
      __syncthreads(); }
    auto aoff = [&](const pg8::Unit& u, int R) { return rowtab[(u.idx & 7) * 256 + R]; };
    const char* Bt = (const char*)(F.ws + WS_W + W_WGU);
    S.l = l;
    auto bptr = [&](const pg8::Unit& u) { return Bt + ((size_t)u.e * 512 + (size_t)u.pn * 256) * DM * 2; };
    EpiGU E{__builtin_amdgcn_make_buffer_rsrc((void*)(F.ws + WS_HB), 0, (int)(WS_YB - WS_HB), 0x00020000), (const LAS float*)(F.lds + LDS_ROPE)};
    if (F.tid == 0) ((volatile LAS unsigned*)(F.lds + LDS_FLAG))[0] = 0u;
    pg8::gemm256<true>(F.lds, F.tid, (const char*)(F.ws + WS_H), DM * 2, DM, S, aoff, bptr, E);
    if (F.tid == 0) (void)__hip_atomic_fetch_add(&g_rdy[l][GDONE_IN_RDY], 1u, __ATOMIC_RELAXED, __HIP_MEMORY_SCOPE_AGENT);
    __syncthreads();
    g6_stream(F, l, tl, cnt);
}
namespace att2 {
typedef float f32x16 __attribute__((ext_vector_type(16)));
typedef short s16x4 __attribute__((ext_vector_type(4)));
constexpr int NW = 8, QBLK = 32, QB = 256, KVBLK = 64;
__device__ __forceinline__ int crow(int r, int hi) { return (r & 3) + 8 * (r >> 2) + 4 * hi; }
#define SBAR() __builtin_amdgcn_sched_barrier(0)
constexpr int SLOTB = 8192, RSLOTB = 4096;
constexpr int LDS_K = 0, LDS_V = 4 * SLOTB, LDS_R = 8 * SLOTB, LDS_WS = LDS_R + 4 * RSLOTB, LDS_OST = LDS_WS + NW * 64 * 4, LDS_BYTES_ATT = LDS_OST + NW * 4096;
static_assert(LDS_BYTES_ATT <= 131072, "attention LDS");
__device__ __forceinline__ void glds16s(const void* sbase, unsigned voff, unsigned lds_dst) { unsigned keep;
  asm volatile("s_mov_b32 %0, m0\n\ts_mov_b32 m0, %3\n\ts_nop 0\n\tglobal_load_lds_dwordx4 %1, %2\n\ts_mov_b32 m0, %0" : "=&s"(keep) : "v"(voff), "s"(sbase), "s"(lds_dst) : "memory"); }
__device__ __forceinline__ float max3f(float a, float b, float c) { float r; asm("v_max3_f32 %0, %1, %2, %3" : "=v"(r) : "v"(a), "v"(b), "v"(c)); return r; }
__device__ __forceinline__ float max2f(float a, float b) { float r; asm("v_max_f32_e32 %0, %1, %2" : "=v"(r) : "v"(a), "v"(b)); return r; }
__device__ __forceinline__ float fadd_s(float a, float b) { float r; asm("v_add_f32_e32 %0, %1, %2" : "=v"(r) : "v"(a), "v"(b)); return r; }
__device__ __forceinline__ float fsub_s(float a, float b) { float r; asm("v_sub_f32_e32 %0, %1, %2" : "=v"(r) : "v"(a), "v"(b)); return r; }
typedef float f32x2_t __attribute__((ext_vector_type(2))); typedef __bf16 bf16x2_t __attribute__((ext_vector_type(2)));
__device__ __forceinline__ unsigned cvtpk_s(float lo, float hi) { f32x2_t v = {lo, hi}; bf16x2_t b = __builtin_convertvector(v, bf16x2_t); return __builtin_bit_cast(unsigned, b); }
#define WAIT_BAR(N) asm volatile("s_waitcnt vmcnt(" #N ") lgkmcnt(0)\n\ts_barrier" ::: "memory")
#define WAIT_T() do { if (wid < 4) { WAIT_BAR(3); } else { WAIT_BAR(2); } } while (0)
typedef __attribute__((address_space(3))) const char* lds_cptr;
typedef short v4i16_t __attribute__((ext_vector_type(4)));
#define LDSF(p) (*(const __attribute__((address_space(3))) bf16x8*)(p))
#define KFRAG(kp, rp, j) ((j) < 8 ? LDSF((kp) + ((j) >> 1) * 2048 + ((j) & 1) * 512) : LDSF((rp) + (((j) - 8) >> 1) * 2048 + ((j) & 1) * 512))
__device__ __forceinline__ void qkt0(f32x16& p0, f32x16& p1, lds_cptr kp, lds_cptr rp, const bf16x8* qr, const f32x16& negm) {
#pragma unroll
  for (int d0 = 0; d0 < 6; ++d0) {
    const bf16x8 b0 = KFRAG(kp, rp, 2 * d0), b1 = KFRAG(kp, rp, 2 * d0 + 1);
    if (d0 == 0) { p0 = __builtin_amdgcn_mfma_f32_32x32x16_bf16(b0, qr[0], negm, 0, 0, 0); p1 = __builtin_amdgcn_mfma_f32_32x32x16_bf16(b1, qr[0], negm, 0, 0, 0); }
    else { p0 = __builtin_amdgcn_mfma_f32_32x32x16_bf16(b0, qr[d0], p0, 0, 0, 0); p1 = __builtin_amdgcn_mfma_f32_32x32x16_bf16(b1, qr[d0], p1, 0, 0, 0); } }
}
__device__ __forceinline__ s16x4 vtr(lds_cptr p) { return __builtin_bit_cast(s16x4, __builtin_amdgcn_ds_read_tr16_b64_v4i16((__attribute__((address_space(3))) v4i16_t*)p)); }
__device__ __forceinline__ float rowmax(const f32x16& p0, const f32x16& p1) {
  float a = max3f(p0[0], p0[1], p1[0]), b = max3f(p0[2], p0[3], p1[1]); a = max3f(a, p1[2], p1[3]);
#pragma unroll
  for (int r = 4; r < 16; r += 4) { a = max3f(a, p0[r], p0[r + 1]); b = max3f(b, p0[r + 2], p0[r + 3]); a = max3f(a, p1[r], p1[r + 1]); b = max3f(b, p1[r + 2], p1[r + 3]); }
  const float m = max2f(a, b);
  auto rr = __builtin_amdgcn_permlane32_swap(__float_as_uint(m), __float_as_uint(m), false, false);
  return max2f(__uint_as_float(rr[0]), __uint_as_float(rr[1]));
}
__device__ __forceinline__ void pv(f32x16* o, int vb, bf16x8 pa0, bf16x8 pa1, bf16x8 pa2, bf16x8 pa3) {
#pragma unroll
  for (int d0 = 0; d0 < 2; ++d0) { s16x4 lo[4], hi[4];
#pragma unroll
    for (int ks = 0; ks < 4; ++ks) {
      asm volatile("ds_read_b64_tr_b16 %0,%1 offset:%c2" : "=&v"(lo[ks]) : "v"(vb), "i"(d0 * 4096 + ks * 1024) : "memory");
      asm volatile("ds_read_b64_tr_b16 %0,%1 offset:%c2" : "=&v"(hi[ks]) : "v"(vb), "i"(d0 * 4096 + ks * 1024 + 512) : "memory"); }
    asm volatile("s_waitcnt lgkmcnt(0)" ::: "memory"); SBAR();
#define PK(k) (bf16x8){lo[k][0], lo[k][1], lo[k][2], lo[k][3], hi[k][0], hi[k][1], hi[k][2], hi[k][3]}
    o[d0] = __builtin_amdgcn_mfma_f32_32x32x16_bf16(pa0, PK(0), o[d0], 0, 0, 0);
    o[d0] = __builtin_amdgcn_mfma_f32_32x32x16_bf16(pa1, PK(1), o[d0], 0, 0, 0);
    o[d0] = __builtin_amdgcn_mfma_f32_32x32x16_bf16(pa2, PK(2), o[d0], 0, 0, 0);
    o[d0] = __builtin_amdgcn_mfma_f32_32x32x16_bf16(pa3, PK(3), o[d0], 0, 0, 0);
#undef PK
  }
}
template <int THRL, unsigned VAR = 0u> __device__ __forceinline__ void attn_unit(const bf16_t* Q, const bf16_t* QRb, const bf16_t* __restrict__ KV, const bf16_t* __restrict__ KR, bf16_t* O,
                                                             int qrow0, int h, int kvb, int NT, int NRAW, char* shm, int tid) {
  const int lane = tid & 63, r32 = lane & 31, hi = lane >> 5; const int wid = __builtin_amdgcn_readfirstlane(tid >> 6);
  const bf16_t* Qw = Q + (size_t)(qrow0 + wid * QBLK) * 768 + h * 96;
  const char* Kh = (const char*)(KV + ((size_t)(kvb >> 6) * 8 + h) * 8192) + wid * 1024; const char* Rh = (const char*)(KR + (size_t)(kvb >> 6) * 2048) + (wid & 3) * 1024;
  const unsigned lds0 = (unsigned)(uintptr_t)shm;
  float* wsf = (float*)(shm + LDS_WS) + wid * 64;
  const unsigned loff = (unsigned)lane * 16u;
  const unsigned kdst = lds0 + LDS_K + wid * 1024, vdst = lds0 + LDS_V + wid * 1024, rdst = lds0 + LDS_R + (wid & 3) * 1024;
#define DMA_T(t) do { const char* kb_ = Kh + (size_t)(t) * 131072; const char* rb_ = Rh + (size_t)(t) * 4096; \
                      glds16s(kb_, loff, (unsigned)__builtin_amdgcn_readfirstlane(kdst + ((t) & 3) * SLOTB)); \
                      if (wid < 4) glds16s(rb_, loff, (unsigned)__builtin_amdgcn_readfirstlane(rdst + ((t) & 3) * RSLOTB)); \
                      glds16s(kb_ + 8192, loff, (unsigned)__builtin_amdgcn_readfirstlane(vdst + ((t) & 3) * SLOTB)); } while (0)
  const int vb0 = (int)(lds0 + LDS_V) + ((lane >> 4) & 1) * 32 + (lane & 3) * 8 + (4 * hi + ((lane & 15) >> 2)) * 64;
  const lds_cptr shm3 = (lds_cptr)shm; const lds_cptr kp0 = shm3 + LDS_K + hi * 1024 + r32 * 16; const lds_cptr rp0 = shm3 + LDS_R + hi * 1024 + r32 * 16;
  const lds_cptr vp0 = shm3 + LDS_V + ((lane >> 4) & 1) * 32 + (lane & 3) * 8 + (4 * hi + ((lane & 15) >> 2)) * 64;
  bf16x8 qr[6];
#pragma unroll
  for (int d0 = 0; d0 < 4; ++d0) qr[d0] = *reinterpret_cast<const bf16x8*>(&Qw[(size_t)r32 * 768 + d0 * 16 + hi * 8]);
  { const bf16_t* qp = NRAW > 0 ? QRb + (size_t)(qrow0 + wid * QBLK + r32) * 256 + h * 32 + hi * 8 : Qw + (size_t)r32 * 768 + 64 + hi * 8;
    qr[4] = *reinterpret_cast<const bf16x8*>(qp); qr[5] = *reinterpret_cast<const bf16x8*>(qp + 16); }
  const lds_cptr qp0 = shm3 + LDS_OST + wid * 4096 + lane * 16;
#pragma unroll
  for (int d0 = 0; d0 < 4; ++d0) *(__attribute__((address_space(3))) bf16x8*)(shm3 + LDS_OST + wid * 4096 + lane * 16 + d0 * 1024) = qr[d0];
#define QF(d0) LDSF(qp0 + (d0) * 1024)
  DMA_T(0); DMA_T(1);
  float mhat = 0.f, l_reg = 0.f; f32x16 o[2], negm; { float z0 = 0.f; asm volatile("" : "+v"(z0));
#pragma unroll
    for (int r = 0; r < 16; ++r) { o[0][r] = z0; o[1][r] = z0; negm[r] = z0; } }
  asm volatile("" : "+v"(negm));
  bool resc = false;
#define START(P0, P1) do { const float rm = rowmax(P0, P1); resc = false; \
    { const float dl = rm; mhat = fadd_s(mhat, dl); \
      _Pragma("unroll") for (int r = 0; r < 16; ++r) { P0[r] = fsub_s(P0[r], dl); P1[r] = fsub_s(P1[r], dl); } \
      _Pragma("unroll") for (int r = 0; r < 16; ++r) negm[r] = -mhat; asm volatile("" : "+v"(negm)); } \
    _Pragma("unroll") for (int r = 0; r < 16; ++r) P0[r] = __builtin_amdgcn_exp2f(P0[r]); } while (0)
#define RESC() do { if (resc) { asm volatile("s_waitcnt lgkmcnt(0)" ::: "memory"); \
      _Pragma("unroll") for (int d_ = 0; d_ < 2; ++d_) _Pragma("unroll") for (int r = 0; r < 16; ++r) o[d_][r] *= wsf[crow(r, hi)]; } } while (0)
  f32x16 pA0, pA1, pB0, pB1;
  WAIT_T();
  qkt0(pA0, pA1, kp0, rp0, qr, negm); asm volatile("s_nop 15\n\ts_nop 7" : "+v"(pA0), "+v"(pA1));
  START(pA0, pA1);
  _Pragma("unroll") for (int r = 0; r < 16; ++r) pA1[r] = __builtin_amdgcn_exp2f(pA1[r]);
  DMA_T(2);
  WAIT_T();
  s16x4 vl0, vh0, vl1, vh1, vl2, vh2, vl3, vh3; u32x4 pw0, pw1, pw2, pw3; bf16x8 fa, fb, fc, fd;
#define PKW(P, B) cvtpk_s(P[B], P[B + 1])
#define PAF(k) __builtin_bit_cast(bf16x8, pw##k)
#define VFS(s) (bf16x8){vl##s[0], vl##s[1], vl##s[2], vl##s[3], vh##s[0], vh##s[1], vh##s[2], vh##s[3]}
#define PIN(x) asm volatile("" : "+v"(x))
#define MX3(a, b, c) __builtin_fmaxf(__builtin_fmaxf((a), (b)), (c))
#define GAPA(MF, A0, A1, A2, A3, W0, W1, PW) do { MF; if constexpr (!(VAR & 4u)) { sacc += A0; sacc += A1; sacc += A2; sacc += A3; PIN(sacc); W0; W1; PIN(PW); } SBAR(); } while (0)
#define GAPR(MF) do { MF; SBAR(); } while (0)
#define EX(v) ((VAR & 2u) ? (v) : __builtin_amdgcn_exp2f(v))
#define GAPB(MF, X, B) do { MF; X[B] = EX(X[B]); X[B + 1] = EX(X[B + 1]); X[B + 2] = EX(X[B + 2]); X[B + 3] = EX(X[B + 3]); PIN(X); SBAR(); } while (0)
#define VRD(s, i) do { vl##s = vtr(vp_ + (((i) >> 2) * 4096 + ((i) & 3) * 1024)); vh##s = vtr(vp_ + (((i) >> 2) * 4096 + ((i) & 3) * 1024 + 512)); } while (0)
#define MF32(A, B, C) ((VAR & 16u) ? (C) : __builtin_amdgcn_mfma_f32_32x32x16_bf16(A, B, C, 0, 0, 0))
#define STEP(C0, C1, P0, P1, t, GD) do { SBAR(); \
    const lds_cptr vp_ = vp0 + (((t) - 1) & 3) * SLOTB; const lds_cptr kp_ = kp0 + ((t) & 3) * SLOTB; const lds_cptr rp_ = rp0 + ((t) & 3) * RSLOTB; \
    fa = KFRAG(kp_, rp_, 0); fb = KFRAG(kp_, rp_, 1); fc = KFRAG(kp_, rp_, 2); fd = KFRAG(kp_, rp_, 3); \
    VRD(0, 0); SBAR(); float sacc = (P0[0] + P0[1]); \
    GAPA(C0 = MF32(fa, qr[0], negm), P0[2], P0[3], P0[4], P0[5],     pw0[0] = PKW(P0, 0), pw0[1] = PKW(P0, 2), pw0); fa = KFRAG(kp_, rp_, 4); \
    VRD(1, 4); SBAR(); GAPA(C1 = MF32(fb, qr[0], negm), P0[6], P0[7], P0[8], P0[9],     pw0[2] = PKW(P0, 4), pw0[3] = PKW(P0, 6), pw0); fb = KFRAG(kp_, rp_, 5); \
    VRD(2, 1); SBAR(); GAPA(C0 = MF32(fc, qr[1], C0),   P0[10], P0[11], P0[12], P0[13], pw1[0] = PKW(P0, 8), pw1[1] = PKW(P0, 10), pw1); fc = KFRAG(kp_, rp_, 6); \
    VRD(3, 5); SBAR(); GAPA(C1 = MF32(fd, qr[1], C1),   P0[14], P0[15], P1[0], P1[1],   pw1[2] = PKW(P0, 12), pw1[3] = PKW(P0, 14), pw1); fd = KFRAG(kp_, rp_, 7); \
    SBAR(); GAPA(C0 = MF32(fa, qr[2], C0),   P1[2], P1[3], P1[4], P1[5],     pw2[0] = PKW(P1, 0), pw2[1] = PKW(P1, 2), pw2); fa = KFRAG(kp_, rp_, 8); \
    SBAR(); GAPA(C1 = MF32(fb, qr[2], C1),   P1[6], P1[7], P1[8], P1[9],     pw2[2] = PKW(P1, 4), pw2[3] = PKW(P1, 6), pw2); fb = KFRAG(kp_, rp_, 9); \
    SBAR(); GAPA(C0 = MF32(fc, qr[3], C0),   P1[10], P1[11], P1[12], P1[13], pw3[0] = PKW(P1, 8), pw3[1] = PKW(P1, 10), pw3); fc = KFRAG(kp_, rp_, 10); \
    SBAR(); GAPA(C1 = MF32(fd, qr[3], C1),   P1[14], P1[15], 0.f, 0.f,       pw3[2] = PKW(P1, 12), pw3[3] = PKW(P1, 14), pw3); fd = KFRAG(kp_, rp_, 11); \
    SBAR(); GAPR(C0 = MF32(fa, qr[4], C0)); GAPR(C1 = MF32(fb, qr[4], C1)); GAPR(C0 = MF32(fc, qr[5], C0)); GAPR(C1 = MF32(fd, qr[5], C1)); \
    l_reg += sacc; \
    if constexpr (!(VAR & 1u)) { if (GD) { DMA_T((t) + 2); } } \
    { float a = MX3(C0[0], C0[1], C1[0]), b = MX3(C0[2], C0[3], C1[1]); a = MX3(a, C1[2], C1[3]); \
      _Pragma("unroll") for (int r = 4; r < 16; r += 4) { a = MX3(a, C0[r], C0[r + 1]); b = MX3(b, C0[r + 2], C0[r + 3]); a = MX3(a, C1[r], C1[r + 1]); b = MX3(b, C1[r + 2], C1[r + 3]); } \
      float rm = __builtin_fmaxf(a, b); { auto rr = __builtin_amdgcn_permlane32_swap(__float_as_uint(rm), __float_as_uint(rm), false, false); rm = __builtin_fmaxf(__uint_as_float(rr[0]), __uint_as_float(rr[1])); } \
      resc = false; \
      if (__builtin_expect(__any(rm > (float)THRL), 0)) { const float dl = __builtin_fmaxf(rm, 0.f); mhat += dl; \
        _Pragma("unroll") for (int r = 0; r < 16; ++r) { C0[r] -= dl; C1[r] -= dl; } \
        _Pragma("unroll") for (int r = 0; r < 16; ++r) negm[r] = -mhat; asm volatile("" : "+v"(negm)); \
        const float f = __builtin_amdgcn_exp2f(-dl); l_reg *= f; if (hi == 0) wsf[r32] = f; resc = true; } } \
    SBAR(); \
    GAPB(o[0] = MF32(PAF(0), VFS(0), o[0]), C0, 0); \
    GAPB(o[1] = MF32(PAF(0), VFS(1), o[1]), C0, 4); VRD(0, 2); VRD(1, 6); SBAR(); \
    GAPB(o[0] = MF32(PAF(1), VFS(2), o[0]), C0, 8); \
    GAPB(o[1] = MF32(PAF(1), VFS(3), o[1]), C0, 12); VRD(2, 3); VRD(3, 7); SBAR(); \
    GAPB(o[0] = MF32(PAF(2), VFS(0), o[0]), C1, 0); \
    GAPB(o[1] = MF32(PAF(2), VFS(1), o[1]), C1, 4); \
    GAPB(o[0] = MF32(PAF(3), VFS(2), o[0]), C1, 8); \
    GAPB(o[1] = MF32(PAF(3), VFS(3), o[1]), C1, 12); \
    } while (0)
#define QSW(tt) do { if ((tt) == NRAW) { qr[4] = *reinterpret_cast<const bf16x8*>(&Qw[(size_t)r32 * 768 + 64 + hi * 8]); qr[5] = *reinterpret_cast<const bf16x8*>(&Qw[(size_t)r32 * 768 + 80 + hi * 8]); } } while (0)
#define ENDW(tt) do { if ((tt) + 2 < NT) { WAIT_T(); } else { WAIT_BAR(0); } } while (0)
  int t = 1;
  for (; t + 3 < NT; t += 2) {
    STEP(pB0, pB1, pA0, pA1, t, true);     if constexpr (VAR & 8u) { asm volatile("s_waitcnt vmcnt(3) lgkmcnt(0)" ::: "memory"); } else { WAIT_T(); } RESC(); QSW(t + 1);
    STEP(pA0, pA1, pB0, pB1, t + 1, true); if constexpr (VAR & 8u) { asm volatile("s_waitcnt vmcnt(3) lgkmcnt(0)" ::: "memory"); } else { WAIT_T(); } RESC(); QSW(t + 2);
  }
  for (; t + 1 < NT; t += 2) {
    STEP(pB0, pB1, pA0, pA1, t, (t + 2 < NT));     ENDW(t);     RESC(); QSW(t + 1);
    STEP(pA0, pA1, pB0, pB1, t + 1, (t + 3 < NT)); ENDW(t + 1); RESC(); QSW(t + 2);
  }
  STEP(pB0, pB1, pA0, pA1, NT - 1, false); WAIT_BAR(0); RESC();
  { float sacc = pB0[0] + pB0[1]; _Pragma("unroll") for (int r = 2; r < 16; ++r) sacc += pB0[r]; _Pragma("unroll") for (int r = 0; r < 16; ++r) sacc += pB1[r]; l_reg += sacc;
    pw0 = (u32x4){PKW(pB0, 0), PKW(pB0, 2), PKW(pB0, 4), PKW(pB0, 6)}; pw1 = (u32x4){PKW(pB0, 8), PKW(pB0, 10), PKW(pB0, 12), PKW(pB0, 14)}; pw2 = (u32x4){PKW(pB1, 0), PKW(pB1, 2), PKW(pB1, 4), PKW(pB1, 6)}; pw3 = (u32x4){PKW(pB1, 8), PKW(pB1, 10), PKW(pB1, 12), PKW(pB1, 14)};
    SBAR(); pv(o, vb0 + ((NT - 1) & 3) * SLOTB, PAF(0), PAF(1), PAF(2), PAF(3)); }
#undef PKW
#undef PAF
#undef VFS
#undef PIN
#undef MX3
#undef GAPA
#undef GAPR
#undef GAPB
#undef EX
#undef VRD
#undef MF32
#undef STEP
#undef ENDW
#undef QSW
  { auto rr = __builtin_amdgcn_permlane32_swap(__float_as_uint(l_reg), __float_as_uint(l_reg), false, false); l_reg = __uint_as_float(rr[0]) + __uint_as_float(rr[1]); }
  if (hi == 0) wsf[32 + r32] = l_reg; asm volatile("s_waitcnt lgkmcnt(0)" ::: "memory");
  float rli[16];
#pragma unroll
  for (int r = 0; r < 16; ++r) rli[r] = __builtin_amdgcn_rcpf(wsf[32 + crow(r, hi)]);
  bf16_t* Ow = O + (size_t)(qrow0 + wid * QBLK) * DM + h * 64;
  { bf16_t* stg = (bf16_t*)(shm + LDS_OST) + wid * 2048;
#pragma unroll
    for (int r = 0; r < 16; ++r) { const int orow = crow(r, hi);
#pragma unroll
      for (int d0 = 0; d0 < 2; ++d0) stg[orow * 64 + d0 * 32 + r32] = (bf16_t)f2bf(o[d0][r] * rli[r]); }
    asm volatile("s_waitcnt lgkmcnt(0)" ::: "memory");
#pragma unroll
    for (int i = 0; i < 4; ++i) { const int row = i * 8 + (lane >> 3), ch = lane & 7; const u32x4 v = *(const u32x4*)(stg + row * 64 + ch * 8); *(u32x4*)(Ow + (size_t)row * DM + ch * 8) = v; } }
  asm volatile("s_waitcnt vmcnt(0) lgkmcnt(0)\n\ts_barrier" ::: "memory");
#undef DMA_T
#undef START
#undef RESC
#undef QF
}
#undef SBAR
#undef WAIT_BAR
#undef WAIT_T
#undef LDSF
#undef KFRAG
}
template <unsigned VAR = 0u> __device__ __forceinline__ void attn_mfma_phase(const Ctx& F0, bool with_ctx_queries) {
    const Ctx F = fresh(F0);
    const bf16_t* Qp = (const bf16_t*)(F.ws + WS_Q); const bf16_t* QRp = (const bf16_t*)(F.ws + WS_QR); const bf16_t* KVp = (const bf16_t*)(F.ws + WS_KV); const bf16_t* KRp = (const bf16_t*)(F.ws + WS_KR);
    bf16_t* Op = (bf16_t*)(F.ws + WS_MIX);
    char* shm = (char*)(unsigned char*)F.lds;
    const int xg = F.bid & 7, slot = F.bid >> 3;
    if (F.G == 256) {
        for (int i = 0; i < 4; ++i) { const int bh = 8 * i + xg, b = bh >> 3, h = bh & 7;
            att2::attn_unit<8, VAR>(Qp, QRp, KVp, KRp, Op, b * SEQ + slot * 256, h, b * KVS, KVS / 64, CTXL / 64, shm, F.tid); }
    } else {
        for (int u = F.bid; u < 1024; u += F.G) { const int bh = u >> 5, b = bh >> 3, h = bh & 7;
            att2::attn_unit<8, VAR>(Qp, QRp, KVp, KRp, Op, b * SEQ + (u & 31) * 256, h, b * KVS, KVS / 64, CTXL / 64, shm, F.tid); }
    }
    if (with_ctx_queries) for (int u = F.bid; u < 32; u += F.G) { const int b = u >> 3, h = u & 7;
        att2::attn_unit<8, VAR>(Qp, QRp, KVp, KRp, Op, TL + b * CTXL, h, b * KVS, CTXL / 64, 0, shm, F.tid); }
    __syncthreads();
}

template <int G> __device__ __forceinline__ void pool_pair(const LAS float* UP, bf16_t* mrow, int t0, int n, int p, int ch) {
    constexpr int W = 2 << G, LO = W >> 1, HI = W - 1 - LO;
    const int a = 2 * p; const LAS float* up = UP + (a + 8 - LO) * 256 + 64 * G + 8 * ch;
    f32x4 r0[W + 1], r1[W + 1];
#pragma unroll
    for (int d = 0; d <= W; ++d) { r0[d] = *(const LAS f32x4*)(up + d * 256); r1[d] = *(const LAS f32x4*)(up + d * 256 + 4); }
    f32x4 s0 = r0[0], s1 = r1[0];
#pragma unroll
    for (int d = 1; d < W; ++d) { s0 = s0 + r0[d]; s1 = s1 + r1[d]; }
    const f32x4 q0 = s0 - r0[0] + r0[W], q1 = s1 - r1[0] + r1[W];
    const int ta = t0 + a, tb = ta + 1;
    const int sta = ta - LO < 0 ? 0 : ta - LO, ena = ta + HI + 1 > n ? n : ta + HI + 1, stb = tb - LO < 0 ? 0 : tb - LO, enb = tb + HI + 1 > n ? n : tb + HI + 1;
    const float rca = __builtin_amdgcn_rcpf((float)(ena - sta)), rcb = __builtin_amdgcn_rcpf((float)(enb - stb));
    const f32x4 a0 = s0 * rca - r0[LO], a1 = s1 * rca - r1[LO], b0 = q0 * rcb - r0[LO + 1], b1 = q1 * rcb - r1[LO + 1];
    bf16_t* op = mrow + (size_t)a * DM + 64 * G + 8 * ch;
    *(u32x4*)op = (u32x4){pk2(a0.x, a0.y), pk2(a0.z, a0.w), pk2(a1.x, a1.y), pk2(a1.z, a1.w)};
    *(u32x4*)(op + DM) = (u32x4){pk2(b0.x, b0.y), pk2(b0.z, b0.w), pk2(b1.x, b1.y), pk2(b1.z, b1.w)};
}
__device__ __forceinline__ void mixers_phase(const Ctx& F0, int l, int nrows, unsigned var = 0u) {
    const Ctx F = fresh(F0);
    LAS float* U = (LAS float*)F.lds;
    LAS float* Y = U + 62 * 256;
    LAS float* UP = Y + 32 * 256;
    LAS float* GB = UP + 47 * 256;
    if (F.tid < 128) { const int q = F.tid >> 6, c4 = (F.tid & 63) * 4; *(LAS f32x4*)(GB + q * 256 + c4) = *(const f32x4*)((q ? gin(F.a->in[I_CLNB]) : gin(F.a->in[I_CLNG])) + l * 256 + c4); }
    const int c = F.tid & 255, hf = F.tid >> 8, tid = F.tid;
    const float* dwp = gin(F.a->in[I_CDW]) + (size_t)l * CONVK * 256 + c;
    float dw[CONVK];
#pragma unroll
    for (int k = 0; k < CONVK; ++k) dw[k] = dwp[k * 256];
    const float cb = gin(F.a->in[I_CB])[l * 256 + c];
    const bf16_t* Pp = (const bf16_t*)(F.ws + WS_P); bf16_t* MIXp = (bf16_t*)(F.ws + WS_MIX);
    const int nunits = nrows / 32, nfull = (nunits / F.G) * F.G, nrounds = (nunits + F.G - 1) / F.G;
    auto unit_of = [&](int i) { if (i * F.G < nfull) return i * F.G + F.bid; const int rem = nunits - nfull; if (F.G >= 64 && rem <= 32) return (F.bid >= 32 && F.bid < 32 + rem) ? nfull + F.bid - 32 : -1; const int u = i * F.G + F.bid; return u < nunits ? u : -1; };
    u32x4 ca[4], cg[4], pp[3];
    const u32x4 z4 = {0u, 0u, 0u, 0u};
#define MX_GEOM(u) const int r0 = (u) * 32; int rb, n; if (r0 < TL) { rb = r0 & ~(SEQ - 1); n = SEQ; } else { rb = TL + ((r0 - TL) & ~(CTXL - 1)); n = CTXL; } const int t0 = r0 - rb;
#define MX_ISSUE_CONV(u) do { MX_GEOM(u) _Pragma("unroll") for (int q = 0; q < 4; ++q) { const int i = tid + q * 512, tt = i >> 5, c8 = (i & 31) * 8, t = t0 - 15 + tt; ca[q] = z4; cg[q] = z4; \
        if (i < 62 * 32 && t >= 0 && t < n) { const bf16_t* p = Pp + (size_t)(rb + t) * PW + OFF_CONV + c8; ca[q] = *(const u32x4*)p; cg[q] = *(const u32x4*)(p + 256); } } } while (0)
#define MX_ISSUE_POOL(u) do { MX_GEOM(u) _Pragma("unroll") for (int q = 0; q < 3; ++q) { const int i = tid + q * 512, tt = i >> 5, c8 = (i & 31) * 8, t = t0 - 8 + tt; pp[q] = z4; \
        if (i < 47 * 32 && t >= 0 && t < n) pp[q] = *(const u32x4*)(Pp + (size_t)(rb + t) * PW + OFF_POOL + c8); } } while (0)
    int ucur = unit_of(0);
    if (ucur >= 0) { MX_ISSUE_CONV(ucur); MX_ISSUE_POOL(ucur); }
    for (int it = 0; it < nrounds; ++it) {
        if (ucur < 0) break;
        const int unext = (it + 1 < nrounds) ? unit_of(it + 1) : -1;
        MX_GEOM(ucur)
#pragma unroll
        for (int q = 0; q < 4; ++q) { const int i = tid + q * 512, tt = i >> 5, c8 = (i & 31) * 8;
            if (i < 62 * 32) { const unsigned aw[4] = {ca[q].x, ca[q].y, ca[q].z, ca[q].w}, gw[4] = {cg[q].x, cg[q].y, cg[q].z, cg[q].w}; float v[8];
#pragma unroll
                for (int x = 0; x < 4; ++x) { v[2 * x] = bf2f(aw[x] & 0xffffu) * sigm(bf2f(gw[x] & 0xffffu)); v[2 * x + 1] = bf2f(aw[x] >> 16) * sigm(bf2f(gw[x] >> 16)); }
                *(LAS f32x4*)(U + tt * 256 + c8) = (f32x4){v[0], v[1], v[2], v[3]}; *(LAS f32x4*)(U + tt * 256 + c8 + 4) = (f32x4){v[4], v[5], v[6], v[7]}; } }
#pragma unroll
        for (int q = 0; q < 3; ++q) { const int i = tid + q * 512, tt = i >> 5, c8 = (i & 31) * 8;
            if (i < 47 * 32) { const unsigned aw[4] = {pp[q].x, pp[q].y, pp[q].z, pp[q].w};
                *(LAS f32x4*)(UP + tt * 256 + c8) = (f32x4){bf2f(aw[0] & 0xffffu), bf2f(aw[0] >> 16), bf2f(aw[1] & 0xffffu), bf2f(aw[1] >> 16)};
                *(LAS f32x4*)(UP + tt * 256 + c8 + 4) = (f32x4){bf2f(aw[2] & 0xffffu), bf2f(aw[2] >> 16), bf2f(aw[3] & 0xffffu), bf2f(aw[3] >> 16)}; } }
        __syncthreads();
        if (unext >= 0) { MX_ISSUE_CONV(unext); MX_ISSUE_POOL(unext); }
        if (!(var & 1u)) { float acc[16];
#pragma unroll
          for (int j = 0; j < 16; ++j) acc[j] = cb;
#pragma unroll
          for (int i = 0; i < 46; ++i) { const float uv = U[(hf * 16 + i) * 256 + c];
#pragma unroll
              for (int j = 0; j < 16; ++j) if (i - j >= 0 && i - j < CONVK) acc[j] += uv * dw[i - j]; }
#pragma unroll
          for (int j = 0; j < 16; ++j) Y[(hf * 16 + j) * 256 + c] = acc[j]; }
        if (!(var & 2u)) {
          bf16_t* mrow = MIXp + (size_t)r0 * DM + 512; const int pr = 8 * (F.wave >> 2) + (F.lane >> 3), ch = F.lane & 7;
          switch (F.wave & 3) { case 0: pool_pair<0>(UP, mrow, t0, n, pr, ch); break; case 1: pool_pair<1>(UP, mrow, t0, n, pr, ch); break; case 2: pool_pair<2>(UP, mrow, t0, n, pr, ch); break; default: pool_pair<3>(UP, mrow, t0, n, pr, ch); break; } }
        __syncthreads();
        if (!(var & 4u)) { const int tk = 4 * F.wave + (F.lane >> 4), c0 = 16 * (F.lane & 15); f32x4 v[4];
#pragma unroll
          for (int k = 0; k < 4; ++k) v[k] = *(const LAS f32x4*)(Y + tk * 256 + c0 + 4 * k);
          float s1 = 0.f;
#pragma unroll
          for (int k = 0; k < 4; ++k) s1 += (v[k].x + v[k].y) + (v[k].z + v[k].w);
          const float mean = sum16(s1) * (1.f / 256.f); float s2 = 0.f;
#pragma unroll
          for (int k = 0; k < 4; ++k) { v[k] = v[k] - mean; s2 += (v[k].x * v[k].x + v[k].y * v[k].y) + (v[k].z * v[k].z + v[k].w * v[k].w); }
          const float rstd = __builtin_amdgcn_rsqf(sum16(s2) * (1.f / 256.f) + EPS);
          const LAS float* gp = GB + c0; const LAS float* bp = GB + 256 + c0; unsigned o[8];
#pragma unroll
          for (int k = 0; k < 4; ++k) { const f32x4 gg = *(const LAS f32x4*)(gp + 4 * k), bb = *(const LAS f32x4*)(bp + 4 * k); const f32x4 y = v[k] * rstd * gg + bb; o[2 * k] = pk2(silu(y.x), silu(y.y)); o[2 * k + 1] = pk2(silu(y.z), silu(y.w)); }
          bf16_t* op = MIXp + (size_t)(r0 + tk) * DM + 768 + c0;
          *(u32x4*)op = (u32x4){o[0], o[1], o[2], o[3]}; *(u32x4*)(op + 8) = (u32x4){o[4], o[5], o[6], o[7]}; }
        ucur = unext;
    }
#undef MX_GEOM
#undef MX_ISSUE_CONV
#undef MX_ISSUE_POOL
    __syncthreads();
}

constexpr int HS_LD = 1028;
__device__ __forceinline__ void r1_phase(const Ctx& F0, int l, int nrows, bool dry = false) {
    const Ctx F = fresh(F0);
    LAS float* Hs = (LAS float*)F.lds;
    LAS float* Part = (LAS float*)(F.lds + 65792);
    LAS float* Sc = (LAS float*)(F.lds + 82176);
    LAS int* lcount = (LAS int*)(F.lds + 84224); LAS int* gbase = lcount + 32; LAS int* tok_e = gbase + 32; LAS int* tok_r = tok_e + 140 * 4; LAS float* tok_w = (LAS float*)(tok_r + 140 * 4);
    const int lane = F.lane, w = F.wave, e = lane & 31;
    float Wm[32][2];
    { const float* rw = gin(F.a->in[I_RW]) + (size_t)l * DM * NE + (size_t)(128 * w + 32 * (lane >> 4)) * NE + (lane & 15);
#pragma unroll
      for (int s_ = 0; s_ < 32; ++s_) { Wm[s_][0] = rw[s_ * NE]; Wm[s_][1] = rw[s_ * NE + 16]; } }
    if (F.tid < 32) lcount[F.tid] = 0;
    const bool skew = (F.G == 256 && nrows == TT);
    int per = nrows / F.G, rbase = F.bid * per;
    if (skew) { if (F.bid < 16) { per = 64; rbase = TL + 64 * F.bid; } else { const int j = F.bid - 16; per = j < 128 ? 137 : 136; rbase = j < 128 ? 137 * j : 137 * 128 + 136 * (j - 128); } }
    const int nchunks = (per + 15) >> 4;
    if (F.wave == 0) {
        const int m0 = rbase >> 8, m1 = (rbase + per - 1) >> 8; unsigned polls = 0u;
        while ((unsigned)__builtin_amdgcn_readfirstlane(__hip_atomic_load(&g_rdy4[l][16 * m0], __ATOMIC_RELAXED, __HIP_MEMORY_SCOPE_AGENT)) < 32u ||
               (unsigned)__builtin_amdgcn_readfirstlane(__hip_atomic_load(&g_rdy4[l][16 * m1], __ATOMIC_RELAXED, __HIP_MEMORY_SCOPE_AGENT)) < 32u) { __builtin_amdgcn_s_sleep(2); if (++polls > (1u << 21)) break; }
        __builtin_amdgcn_fence(__ATOMIC_ACQUIRE, "agent");
        asm volatile("s_waitcnt vmcnt(0)" ::: "memory"); }
    LAS float* vb = (LAS float*)(F.lds + 91264); const int bt0 = batch_of(rbase);
    { const float* mod = (const float*)(F.ws + WS_MISC + M_MOD);
      for (int i = F.tid; i < 8192 / 4; i += NTHR) { const int f = i * 4; const float* src;
          if (f < 1024) src = gin(F.a->in[I_LN1G]) + l * DM + f; else if (f < 2048) src = gin(F.a->in[I_LN1B]) + l * DM + (f - 1024);
          else { const int q = f - 2048, bi = q / 3072; const int bt = bt0 + bi < 5 ? bt0 + bi : 4; src = mod + ((size_t)l * 5 + bt) * 6144 + 2048 + (q % 3072); }
          const bool isgate = f >= 2048 && ((f - 2048) % 3072) < 1024;
          *(LAS f32x4*)(vb + f) = *(const f32x4*)src * (isgate ? YB_INV : 1.f); } }
    __syncthreads();
    const float bias_e = gin(F.a->in[I_RB])[l * NE + e];
    f32x4 zr[2][4]; u32x2 zb[2][4]; unsigned yr[2][4];
    bf16_t* const Zp = (bf16_t*)(F.ws + WS_Z);
#define R1_ISSUE(cc) do { _Pragma("unroll") for (int q = 0; q < 2; ++q) R1_ISSUE_Q(cc, q); } while (0)
#define R1_ISSUE_Q(cc, q) do { { const int i = (cc) * 16 + w * 2 + q; \
        if (i < per) { const int r = rbase + i; \
            const unsigned char* yin = ((const unsigned char*)(F.ws + WS_Y1)) + (size_t)r * DM; \
            if (l == 0) { const float* zin = r < TL ? gin(F.a->in[I_X]) + (size_t)r * DM : gin(F.a->in[I_CTX]) + (size_t)(r - TL) * DM; \
                _Pragma("unroll") for (int j = 0; j < 4; ++j) zr[q][j] = *(const f32x4*)(zin + 4 * lane + 256 * j); } \
            else { const bf16_t* zin = Zp + (size_t)r * DM; \
                _Pragma("unroll") for (int j = 0; j < 4; ++j) zb[q][j] = *(const u32x2*)(zin + 4 * lane + 256 * j); } \
            _Pragma("unroll") for (int j = 0; j < 4; ++j) yr[q][j] = *(const unsigned*)(yin + 4 * lane + 256 * j); } } } while (0)
    R1_ISSUE(0);
    for (int c = 0; c < nchunks; ++c) {
#pragma unroll
        for (int q = 0; q < 2; ++q) { const int i = c * 16 + w * 2 + q;
            if (i < per && !(dry && (DRYVAR & 4u))) { const int r = rbase + i;
                const LAS float* md = vb + 2048 + (batch_of(r) - bt0) * 3072;
                f32x4 z[4];
#pragma unroll
                for (int j = 0; j < 4; ++j) { const f32x2 ylo = __builtin_amdgcn_cvt_pk_f32_fp8((int)yr[q][j], false), yhi = __builtin_amdgcn_cvt_pk_f32_fp8((int)yr[q][j], true); const f32x4 y = (f32x4){ylo.x, ylo.y, yhi.x, yhi.y};
                    const u32x2 zo = zb[q][j]; const f32x4 zv = (l == 0) ? zr[q][j] : (f32x4){bf2f(zo.x & 0xffffu), bf2f(zo.x >> 16), bf2f(zo.y & 0xffffu), bf2f(zo.y >> 16)};
                    const f32x4 g = *(const LAS f32x4*)(md + 4 * lane + 256 * j); z[j] = zv * ALPHA + g * y; }
                if (c + 1 < nchunks && !(dry && (DRYVAR & 8u))) R1_ISSUE_Q(c + 1, q);
                row_ln_fused_l<false>(z, vb, vb + 1024, lane); if (!dry) row_store_bf(z, Zp + (size_t)r * DM, lane);
                row_ln_fused_l<true>(z, md + 2048, md + 1024, lane); if (!dry) row_store_bf(z, ((bf16_t*)(F.ws + WS_H)) + (size_t)r * DM, lane);
#pragma unroll
                for (int j = 0; j < 4; ++j) *(LAS f32x4*)(Hs + (w * 2 + q) * HS_LD + 4 * lane + 256 * j) = z[j]; } }
        __syncthreads();
        if (!(dry && (DRYVAR & 1u))) { f32x4 acc0 = {0.f, 0.f, 0.f, 0.f}, acc1 = {0.f, 0.f, 0.f, 0.f};
          const LAS float* hp = Hs + (lane & 15) * HS_LD + 128 * w + 32 * (lane >> 4);
#pragma unroll
          for (int s4 = 0; s4 < 8; ++s4) { const f32x4 hv = *(const LAS f32x4*)(hp + 4 * s4);
#pragma unroll
              for (int x = 0; x < 4; ++x) { acc0 = __builtin_amdgcn_mfma_f32_16x16x4f32(hv[x], Wm[4 * s4 + x][0], acc0, 0, 0, 0); acc1 = __builtin_amdgcn_mfma_f32_16x16x4f32(hv[x], Wm[4 * s4 + x][1], acc1, 0, 0, 0); } }
#pragma unroll
          for (int j = 0; j < 4; ++j) { const int row = 4 * (lane >> 4) + j; Part[(w * 16 + row) * 32 + (lane & 15)] = acc0[j]; Part[(w * 16 + row) * 32 + 16 + (lane & 15)] = acc1[j]; } }
        __syncthreads();
        { const int r16 = F.tid >> 5; float lg = 0.f;
#pragma unroll
          for (int w2 = 0; w2 < 8; ++w2) lg += Part[(w2 * 16 + r16) * 32 + e];
          Sc[r16 * 32 + e] = sigm_exact(lg); }
        __syncthreads();
        if (!(dry && (DRYVAR & 2u))) { const int r16 = 2 * w + (lane >> 5), i = c * 16 + r16;
            const float sc = Sc[r16 * 32 + e], sel = sc + bias_e;
            const float m1 = max8(sel), m2 = max8(sel == m1 ? -INFINITY : sel), gs = m1 + m2;
            const float gA = dpp_f<DPP_RM>(gs);
            float t0, t1; t0 = swap16_f(gs, t1); const float gB = (lane & 16) ? t0 : t1; t0 = swap16_f(gA, t1); const float gC = (lane & 16) ? t0 : t1;
            const int g = e >> 3;
            const int rank = ((gA > gs || (gA == gs && (g ^ 1) < g)) ? 1 : 0) + ((gB > gs || (gB == gs && (g ^ 2) < g)) ? 1 : 0) + ((gC > gs || (gC == gs && (g ^ 3) < g)) ? 1 : 0);
            float cand = rank < 2 ? sel : -INFINITY;
            int ei[4]; float wv[4]; float wsum = 0.f;
#pragma unroll
            for (int k = 0; k < 4; ++k) { const float mx = max32(cand);
                const unsigned long long bal = __ballot(cand == mx); const unsigned hb = (lane & 32) ? (unsigned)(bal >> 32) : (unsigned)bal;
                const int widx = __ffs((int)hb) - 1; const bool win = (e == widx);
                const float wk = sum32(win ? sc : 0.f); cand = win ? -INFINITY : cand; ei[k] = widx; wv[k] = wk; wsum += wk; }
            if (e == 0 && i < per) {
#pragma unroll
                for (int k = 0; k < 4; ++k) { const int lr = __hip_atomic_fetch_add(lcount + ei[k], 1, __ATOMIC_RELAXED, __HIP_MEMORY_SCOPE_WORKGROUP); tok_e[i * 4 + k] = ei[k]; tok_r[i * 4 + k] = lr; tok_w[i * 4 + k] = wv[k] / wsum * ROUTED_SCALE; } }
        }
    }
#undef R1_ISSUE
#undef R1_ISSUE_Q
    __syncthreads();
    if (dry) return;
    if (F.tid < 32) gbase[F.tid] = (int)atomicAdd(((unsigned*)(F.ws + WS_CTL)) + CW_GCNT + l * 64 + F.tid, (unsigned)lcount[F.tid]);
    __syncthreads();
    for (int i = F.tid; i < per * 4; i += NTHR) { const int ex = tok_e[i], rank = gbase[ex] + tok_r[i], r = rbase + (i >> 2);
        ((int*)(F.ws + WS_MISC + M_LIST))[(size_t)ex * TT + rank] = r; ((float*)(F.ws + WS_MISC + M_LISTW))[(size_t)ex * TT + rank] = tok_w[i]; ((int*)(F.ws + WS_MISC + M_SELE))[(size_t)r * 4 + (i & 3)] = ex; ((int*)(F.ws + WS_MISC + M_SELR))[(size_t)r * 4 + (i & 3)] = rank; }
    __syncthreads();
}

struct R2Raw { u32x2 z[4]; unsigned y[5][4]; };
struct R2Idx { u32x4 ev, rv; };
__device__ __forceinline__ void r2_idx(R2Idx& x, const Ctx& F, int r) { x.ev = *(const u32x4*)(((int*)(F.ws + WS_MISC + M_SELE)) + (size_t)r * 4); x.rv = *(const u32x4*)(((int*)(F.ws + WS_MISC + M_SELR)) + (size_t)r * 4); }
__device__ __forceinline__ void r2_issue(R2Raw& w, const Ctx& F, const LAS int* tl, int r, int lane, const R2Idx& x) {
    const bf16_t* zrow = ((const bf16_t*)(F.ws + WS_Z)) + (size_t)r * DM;
    const u32x4 ev = x.ev, rv = x.rv;
    const unsigned char* p0 = ((const unsigned char*)(F.ws + WS_YS8)) + (size_t)r * DM;
    const unsigned char* YB = (const unsigned char*)(F.ws + WS_YB);
    const unsigned char* p1 = YB + (size_t)(tl[ev.x] * 256 + (int)rv.x) * DM; const unsigned char* p2 = YB + (size_t)(tl[ev.y] * 256 + (int)rv.y) * DM;
    const unsigned char* p3 = YB + (size_t)(tl[ev.z] * 256 + (int)rv.z) * DM; const unsigned char* p4 = YB + (size_t)(tl[ev.w] * 256 + (int)rv.w) * DM;
#pragma unroll
    for (int j = 0; j < 4; ++j) { const int o = 4 * lane + 256 * j; w.z[j] = *(const u32x2*)(zrow + o); w.y[4][j] = *(const unsigned*)(p0 + o); w.y[0][j] = *(const unsigned*)(p1 + o); w.y[1][j] = *(const unsigned*)(p2 + o); w.y[2][j] = *(const unsigned*)(p3 + o); w.y[3][j] = *(const unsigned*)(p4 + o); }
}
constexpr int R2V_BT = 2048, R2V_FLOATS = 2048 + 5 * 3072;
__device__ __forceinline__ void r2_part1(const R2Raw& w, f32x4 (&z)[4], const Ctx& F, int r, int lane) {
    const LAS float* vb = (const LAS float*)F.lds; const LAS float* md = vb + R2V_BT + batch_of(r) * 3072;
#pragma unroll
    for (int j = 0; j < 4; ++j) { f32x4 yr = {0.f, 0.f, 0.f, 0.f};
#pragma unroll
        for (int q = 0; q < 5; ++q) { const f32x2 lo = __builtin_amdgcn_cvt_pk_f32_fp8((int)w.y[q][j], false), hi = __builtin_amdgcn_cvt_pk_f32_fp8((int)w.y[q][j], true); yr = yr + (f32x4){lo.x, lo.y, hi.x, hi.y}; }
        const f32x4 y = yr;
        const u32x2 zo = w.z[j]; const f32x4 zv = {bf2f(zo.x & 0xffffu), bf2f(zo.x >> 16), bf2f(zo.y & 0xffffu), bf2f(zo.y >> 16)};
        const f32x4 g = *(const LAS f32x4*)(md + 4 * lane + 256 * j); z[j] = zv * ALPHA + g * y; }
#pragma unroll
    for (int j = 0; j < 4; ++j) asm volatile("" : "+v"(z[j]));
}
__device__ __forceinline__ void r2_part2(f32x4 (&z)[4], const Ctx& F, int l, int r, int lane, bool dry) {
    const bool last = (l == DEPTH - 1);
    const LAS float* vb = (const LAS float*)F.lds; const LAS float* md = vb + R2V_BT + batch_of(r) * 3072;
    row_ln_fused_l<false>(z, vb, vb + 1024, lane);
    if (!dry) { if (last) row_store(z, F.out + (size_t)r * DM, lane); else row_store_bf(z, ((bf16_t*)(F.ws + WS_Z)) + (size_t)r * DM, lane); }
    if (!last) { row_ln_fused_l<true>(z, md + 2048, md + 1024, lane); if (!dry) row_store_bf(z, ((bf16_t*)(F.ws + WS_H)) + (size_t)r * DM, lane); }
}
__device__ __forceinline__ void r2_phase(const Ctx& F0, int l, int nrows, bool dry = false) {
    const Ctx F = fresh(F0);
    { LAS float* vb = (LAS float*)F.lds; const float* mod = (const float*)(F.ws + WS_MISC + M_MOD); const bool lastl = (l == DEPTH - 1);
      for (int i = F.tid; i < R2V_FLOATS / 4; i += NTHR) { const int f = i * 4; const float* src;
          if (f < 1024) src = gin(F.a->in[I_LN2G]) + l * DM + f; else if (f < 2048) src = gin(F.a->in[I_LN2B]) + l * DM + (f - 1024);
          else { const int q = f - R2V_BT, bt = q / 3072, w3 = (q % 3072) >> 10, c = q & 1023; src = w3 == 0 ? mod + ((size_t)l * 5 + bt) * 6144 + 5120 + c : mod + ((size_t)(lastl ? l : l + 1) * 5 + bt) * 6144 + (w3 - 1) * 1024 + c; }
          const bool isgate = f >= R2V_BT && ((f - R2V_BT) % 3072) < 1024;
          *(LAS f32x4*)(vb + f) = *(const f32x4*)src * (isgate ? YB_INV : 1.f); } }
    expert_tables(F, l, nrows);
    const LAS int* tl = (const LAS int*)(F.lds + LDS_ET);
    const int gw = F.bid * NWAVES + F.wave, NGW = F.G * NWAVES, lane = F.lane;
    R2Idx ia, ib; R2Raw a, b;
    if (gw < nrows) { const int g2 = gw + NGW < nrows ? gw + NGW : gw;
        r2_idx(ia, F, gw); r2_idx(ib, F, g2); r2_issue(a, F, tl, gw, lane, ia); r2_issue(b, F, tl, g2, lane, ib);
        const int rn = gw + 2 * NGW; if (rn < nrows) { r2_idx(ia, F, rn); r2_idx(ib, F, rn + NGW < nrows ? rn + NGW : rn); } }
    for (int r = gw; r < nrows; r += 2 * NGW) {
        const int r2 = r + NGW; const bool two = r2 < nrows; const int rn = r + 2 * NGW, rn2 = rn + NGW < nrows ? rn + NGW : rn; const bool nx = rn < nrows;
        f32x4 z[4];
        r2_part1(a, z, F, r, lane); if (nx) r2_issue(a, F, tl, rn, lane, ia); r2_part2(z, F, l, r, lane, dry);
        r2_part1(b, z, F, two ? r2 : r, lane); if (nx) r2_issue(b, F, tl, rn2, lane, ib); if (two) r2_part2(z, F, l, r2, lane, dry);
        { const int rnn = rn + 2 * NGW; if (rnn < nrows) { r2_idx(ia, F, rnn); r2_idx(ib, F, rnn + NGW < nrows ? rnn + NGW : rnn); } }
    }
}

constexpr int PH_PER_LAYER = 8, N_PHASES = 2 + DEPTH * PH_PER_LAYER;
__global__ void __launch_bounds__(NTHR, 2) fwd(Args args) {
    extern __shared__ __attribute__((aligned(16))) unsigned char lds_raw[];
    Ctx F;
    F.lds = (LAS unsigned char*)lds_raw; F.tid = threadIdx.x; F.lane = F.tid & 63; F.wave = __builtin_amdgcn_readfirstlane(F.tid >> 6); F.G = gridDim.x; F.bid = blockIdx.x;
    F.a = &args; F.out = args.out; F.ws = args.ws;
    if (F.tid < 16) ((LAS unsigned*)(F.lds + LDS_XB))[F.tid] = 0u;
    __syncthreads();
    XcdBarrier bar; bar.bar = ((unsigned*)(F.ws + WS_CTL)) + CW_BAR; bar.x = 0; bar.st = nullptr;
    if (N_PHASE_LAUNCH == 0) bar = xcd_barrier_post(((unsigned*)(F.ws + WS_CTL)) + CW_BAR, (volatile LAS unsigned*)(F.lds + LDS_XB));
    const int lo = N_PHASE_LAUNCH == 0 ? 0 : args.ph_lo, hi = N_PHASE_LAUNCH == 0 ? N_PHASES : args.ph_hi;
#ifndef PH_MASK
#define PH_MASK 0xFFFFFFFFu
#endif
#define IN(k) (lo <= (k) && (k) < hi)
#define EN(b) ((PH_MASK >> (b)) & 1u)
#ifndef DUP_MASK
#define DUP_MASK 0u
#endif
#ifndef DRYVAR
#define DRYVAR 0u
#endif
#define REP(b) for (int _rep = 0; _rep < 1 + (int)((DUP_MASK >> (b)) & 1u); ++_rep)
#define SEAM(k) do { if (IN(k) && IN((k) + 1)) { XcdBarrier b2; b2.bar = launder_uniform(((unsigned*)(F.ws + WS_CTL)) + CW_BAR); b2.x = xb_xcc_id(); b2.st = (volatile LAS unsigned*)(F.lds + LDS_XB); xcd_barrier(b2, F.wave); } } while (0)
    if (IN(0)) { const int gt = F.bid * NTHR + F.tid, ng = F.G * NTHR;
        for (int i = gt; i < DEPTH * 768 * 16; i += ng) __hip_atomic_store(&g_rdy[0][0] + i, 0u, __ATOMIC_RELAXED, __HIP_MEMORY_SCOPE_AGENT);
        for (int i = gt; i < DEPTH * 256 * 16; i += ng) { __hip_atomic_store(&g_rdy1[0][0] + i, 0u, __ATOMIC_RELAXED, __HIP_MEMORY_SCOPE_AGENT); __hip_atomic_store(&g_rdy4[0][0] + i, 0u, __ATOMIC_RELAXED, __HIP_MEMORY_SCOPE_AGENT); } }
    if (EN(0) && IN(0)) REP(0) { prep_layer(F, 0); __syncthreads(); mods_phase(F); __syncthreads(); }
    SEAM(0);
    if (EN(1) && IN(1)) REP(1) r0_phase(F);
    SEAM(1);
    for (int l = 0; l < DEPTH; ++l) {
        const int p0 = 2 + l * PH_PER_LAYER; const bool last = (l == DEPTH - 1); const int nrows = last ? TL : TT;
        if (EN(2) && IN(p0 + 0)) g1_phase(F, l);
        SEAM(p0 + 1);
        if (IN(p0 + 2)) { if (EN(5)) { if ((DUP_MASK >> 5) & 1u) mixers_phase(F, l, nrows, DRYVAR); mixers_phase(F, l, nrows); } if (EN(6)) { if ((DUP_MASK >> 6) & 1u) attn_mfma_phase<DRYVAR>(F, !last); attn_mfma_phase<0u>(F, !last); } }
        SEAM(p0 + 2);
        if (EN(7) && IN(p0 + 3)) g4_phase(F, nrows, l);
        if (EN(8) && IN(p0 + 4)) { if ((DUP_MASK >> 8) & 1u) { r1_phase(F, l, nrows, args.ph_hi > 0); __syncthreads(); } r1_phase(F, l, nrows); }
        SEAM(p0 + 4);
        if (EN(9) && IN(p0 + 5)) g5_phase(F, l, nrows);
        SEAM(p0 + 6);
        if (EN(11) && IN(p0 + 7)) { if ((DUP_MASK >> 11) & 1u) { r2_phase(F, l, nrows, args.ph_hi > 0); __syncthreads(); } r2_phase(F, l, nrows); if (!last) { if ((DUP_MASK >> 12) & 1u) { __syncthreads(); prep_layer(F, l + 1, DRYVAR); } __syncthreads(); prep_layer(F, l + 1); } }
        SEAM(p0 + 7);
    }
#undef IN
#undef SEAM
}

extern "C" void kernel_launch(void* const* d_in, const int* in_sizes, int n_in, void* d_out, int out_size, void* d_ws, size_t ws_size, hipStream_t stream) {
    static int grid = 0;
    if (grid == 0) {
        if (n_in != 31 || out_size != TL * DM || ws_size < WS_END) { fprintf(stderr, "kernel_launch: unexpected shapes (n_in %d out %d ws %zu)\n", n_in, out_size, ws_size); grid = -1; return; }
        int dev = 0, cus = 0, per_cu = 0;
        if (hipGetDevice(&dev) != hipSuccess || hipDeviceGetAttribute(&cus, hipDeviceAttributeMultiprocessorCount, dev) != hipSuccess) { grid = -1; return; }
        if (hipFuncSetAttribute((const void*)fwd, hipFuncAttributeMaxDynamicSharedMemorySize, LDS_BYTES) != hipSuccess) { fprintf(stderr, "kernel_launch: hipFuncSetAttribute failed\n"); grid = -1; return; }
        if (hipOccupancyMaxActiveBlocksPerMultiprocessor(&per_cu, (const void*)fwd, NTHR, LDS_BYTES) != hipSuccess || per_cu < 1) fprintf(stderr, "kernel_launch: occupancy query reports %d\n", per_cu);
        (void)hipGetLastError();
        grid = cus;
    }
    if (grid < 0) return;
    (void)hipMemsetAsync((char*)d_ws + WS_CTL, 0, CTL_ZERO_BYTES, stream);
    Args a{};
    for (int i = 0; i < 31; ++i) a.in[i] = (const float*)d_in[i];
    a.out = (float*)d_out; a.ws = (unsigned char*)d_ws;
    if (N_PHASE_LAUNCH == 0) { a.ph_lo = 0; a.ph_hi = N_PHASES; hipLaunchKernelGGL(fwd, dim3(grid), dim3(NTHR), LDS_BYTES, stream, a); }
    else for (int p = 0; p < N_PHASES; ++p) { a.ph_lo = p; a.ph_hi = p + 1; hipLaunchKernelGGL(fwd, dim3(grid), dim3(NTHR), LDS_BYTES, stream, a); }
}
```
